# Optimizing an MI355X kernel written in HIP

```python
import math
import jax
import jax.numpy as jnp
from jax import lax
import numpy as np

D_MODEL = 1024
BATCH = 8
SEQ = 2048
DEPTH = 2

LRU_WIDTH = D_MODEL
LRU_BLOCKS = 16
LRU_BLOCK = LRU_WIDTH // LRU_BLOCKS
LRU_C = 8.0
CONV_WIDTH = 4
RET_HEADS = 4
RET_QK_DIM = D_MODEL // RET_HEADS
RET_V_DIM = D_MODEL // RET_HEADS
RET_CHUNK = 128
ROPE_BASE = 10000.0
EVEN_IN = 2 * LRU_WIDTH + RET_HEADS * (2 * RET_QK_DIM + 2 * RET_V_DIM)
EVEN_MIX = LRU_WIDTH + RET_HEADS * RET_V_DIM
SSM_INNER = 2 * D_MODEL
SSM_HEAD_DIM = 64
SSM_HEADS = SSM_INNER // SSM_HEAD_DIM
SSM_GROUPS = 4
SSM_STATE = 128
SSM_CHUNK = 128
SSM_CONV_DIM = SSM_INNER + 2 * SSM_GROUPS * SSM_STATE
SSM_IN = SSM_INNER + SSM_CONV_DIM + SSM_HEADS
PEER_HEADS = 8
PEER_KEYS = 128
PEER_EXPERTS = PEER_KEYS * PEER_KEYS
PEER_TOPK = 16
PEER_KEY_DIM = 128
PEER_TOKEN_BLOCK = 128

EPS = 1e-6
N_EVEN = (DEPTH + 1) // 2
N_ODD = DEPTH // 2

kernel_name = 'hybrid_lru_retention_ssd_peer'


def rmsnorm(x, g):
    xf = x.astype(jnp.float32)
    y = xf * lax.rsqrt(jnp.mean(xf * xf, axis=-1, keepdims=True) + EPS)
    return (y * g.astype(jnp.float32)).astype(x.dtype)


def causal_conv(x, w, b):
    y = lax.conv_general_dilated(x, w[:, None, :].astype(x.dtype), window_strides=(1,),
                                 padding=[(CONV_WIDTH - 1, 0)],
                                 dimension_numbers=('NWC', 'WIO', 'NWC'),
                                 feature_group_count=x.shape[-1])
    return y + b.astype(x.dtype)


def rope(x):
    s_, d_ = x.shape[2], x.shape[3]
    half = d_ // 2
    inv = ROPE_BASE ** (-jnp.arange(half, dtype=jnp.float32) * (2.0 / d_))
    ang = jnp.arange(s_, dtype=jnp.float32)[:, None] * inv[None, :]
    cos, sin = jnp.cos(ang), jnp.sin(ang)
    xf = x.astype(jnp.float32)
    x1, x2 = xf[..., :half], xf[..., half:]
    return jnp.concatenate([x1 * cos - x2 * sin, x1 * sin + x2 * cos], axis=-1)


def rg_lru(x, w_a, b_a, w_i, b_i, lam):
    b_, s_, _ = x.shape
    xb = x.reshape(b_, s_, LRU_BLOCKS, LRU_BLOCK)
    r = jax.nn.sigmoid(jnp.einsum('bshi,hij->bshj', xb, w_a).reshape(b_, s_, LRU_WIDTH) + b_a)
    i = jax.nn.sigmoid(jnp.einsum('bshi,hij->bshj', xb, w_i).reshape(b_, s_, LRU_WIDTH) + b_i)
    log_a = (-LRU_C * r.astype(jnp.float32)) * jax.nn.softplus(-lam.astype(jnp.float32))
    a = jnp.exp(log_a)
    u = jnp.sqrt(-jnp.expm1(2.0 * log_a)) * (i * x).astype(jnp.float32)

    def combine(left, right):
        a1, u1 = left
        a2, u2 = right
        return a1 * a2, a2 * u1 + u2

    _, h = lax.associative_scan(combine, (a, u), axis=1)
    return h.astype(x.dtype)


def retention(q, k, v):
    b_, h_, s_, dk = q.shape
    dv = v.shape[-1]
    c = RET_CHUNK
    n = s_ // c
    log_gamma = jnp.log1p(-jnp.exp2(-5.0 - jnp.arange(h_, dtype=jnp.float32)))
    idx = jnp.arange(c, dtype=jnp.float32)
    rel = idx[:, None] - idx[None, :]
    decay_in = jnp.where(rel >= 0, jnp.exp(log_gamma[:, None, None] * jnp.maximum(rel, 0.0)), 0.0)
    qc = q.reshape(b_, h_, n, c, dk) * (dk ** -0.5)
    kc = k.reshape(b_, h_, n, c, dk)
    vc = v.astype(jnp.float32).reshape(b_, h_, n, c, dv)
    scores = jnp.einsum('bhnid,bhnjd->bhnij', qc, kc) * decay_in[None, :, None]
    y_in = jnp.einsum('bhnij,bhnje->bhnie', scores, vc)
    k_decay = jnp.exp(log_gamma[:, None] * (c - 1.0 - idx)[None, :])
    chunk_kv = jnp.einsum('bhnjd,hj,bhnje->nbhde', kc, k_decay, vc)
    chunk_decay = jnp.exp(log_gamma * c)

    def step(state, kv):
        return state * chunk_decay[None, :, None, None] + kv, state

    _, prev = lax.scan(step, jnp.zeros((b_, h_, dk, dv), jnp.float32), chunk_kv)
    q_decay = jnp.exp(log_gamma[:, None] * (idx + 1.0)[None, :])
    y_cross = jnp.einsum('bhnid,hi,nbhde->bhnie', qc, q_decay, prev)
    y = (y_in + y_cross).reshape(b_, h_, s_, dv)
    y = y * lax.rsqrt(jnp.mean(y * y, axis=-1, keepdims=True) + EPS)
    return y.transpose(0, 2, 1, 3).reshape(b_, s_, h_ * dv)


def lru_retention_mixer(h, w_in, lru_conv_w, lru_conv_b, lru_w_a, lru_b_a, lru_w_i, lru_b_i,
                        lru_lambda, w_out):
    b_, s_, _ = h.shape
    proj = h @ w_in
    o1 = LRU_WIDTH
    o2 = o1 + LRU_WIDTH
    o3 = o2 + RET_HEADS * RET_QK_DIM
    o4 = o3 + RET_HEADS * RET_QK_DIM
    o5 = o4 + RET_HEADS * RET_V_DIM
    gate_a, xa = proj[..., :o1], proj[..., o1:o2]
    q, k, v, gate_b = proj[..., o2:o3], proj[..., o3:o4], proj[..., o4:o5], proj[..., o5:]
    xa = causal_conv(xa, lru_conv_w, lru_conv_b)
    ya = jax.nn.gelu(gate_a) * rg_lru(xa, lru_w_a, lru_b_a, lru_w_i, lru_b_i, lru_lambda)
    qh = rope(q.reshape(b_, s_, RET_HEADS, RET_QK_DIM).transpose(0, 2, 1, 3))
    kh = rope(k.reshape(b_, s_, RET_HEADS, RET_QK_DIM).transpose(0, 2, 1, 3))
    vh = v.reshape(b_, s_, RET_HEADS, RET_V_DIM).transpose(0, 2, 1, 3)
    yb = (jax.nn.silu(gate_b.astype(jnp.float32)) * retention(qh, kh, vh)).astype(h.dtype)
    return jnp.concatenate([ya.astype(h.dtype), yb], axis=-1) @ w_out


def ssd(x, dt, a_neg, bm, cm):
    b_, s_, h_, p_ = x.shape
    c = SSM_CHUNK
    n = s_ // c
    g = SSM_GROUPS
    r = h_ // g
    xc = (x * dt[..., None]).reshape(b_, n, c, g, r, p_)
    a = (dt * a_neg).reshape(b_, n, c, g, r)
    a_cum = jnp.cumsum(a, axis=2)
    bc = bm.reshape(b_, n, c, g, SSM_STATE)
    cc = cm.reshape(b_, n, c, g, SSM_STATE)
    mask = jnp.tril(jnp.ones((c, c), dtype=bool))
    seg = a_cum[:, :, :, None] - a_cum[:, :, None, :]
    lmat = jnp.exp(jnp.where(mask[None, None, :, :, None, None], seg, -jnp.inf))
    cb = jnp.einsum('bnlgk,bnsgk->bnlsg', cc, bc)
    y_diag = jnp.einsum('bnlsg,bnlsgr,bnsgrp->bnlgrp', cb, lmat, xc)
    decay_states = jnp.exp(a_cum[:, :, -1:] - a_cum)
    states = jnp.einsum('bnsgk,bnsgr,bnsgrp->nbgrpk', bc, decay_states, xc)
    chunk_decay = jnp.moveaxis(jnp.exp(a_cum[:, :, -1]), 1, 0)

    def step(state, inp):
        dec, st = inp
        return state * dec[..., None, None] + st, state

    init = jnp.zeros((b_, g, r, p_, SSM_STATE), jnp.float32)
    _, prev = lax.scan(step, init, (chunk_decay, states))
    y_off = jnp.einsum('bnlgk,nbgrpk,bnlgr->bnlgrp', cc, prev, jnp.exp(a_cum))
    return (y_diag + y_off).reshape(b_, s_, h_, p_)


def mamba2_mixer(h, w_in, conv_w, conv_b, dt_bias, a_log, d_skip, norm_g, w_out):
    b_, s_, _ = h.shape
    proj = h @ w_in
    z = proj[..., :SSM_INNER]
    xbc = proj[..., SSM_INNER:SSM_INNER + SSM_CONV_DIM]
    dt_raw = proj[..., SSM_INNER + SSM_CONV_DIM:]
    xbc = jax.nn.silu(causal_conv(xbc, conv_w, conv_b)).astype(jnp.float32)
    xs = xbc[..., :SSM_INNER].reshape(b_, s_, SSM_HEADS, SSM_HEAD_DIM)
    bm = xbc[..., SSM_INNER:SSM_INNER + SSM_GROUPS * SSM_STATE].reshape(b_, s_, SSM_GROUPS, SSM_STATE)
    cm = xbc[..., SSM_INNER + SSM_GROUPS * SSM_STATE:].reshape(b_, s_, SSM_GROUPS, SSM_STATE)
    dt = jax.nn.softplus(dt_raw.astype(jnp.float32) + dt_bias.astype(jnp.float32))
    a_neg = -jnp.exp(a_log.astype(jnp.float32))
    y = ssd(xs, dt, a_neg, bm, cm) + d_skip.astype(jnp.float32)[:, None] * xs
    y = y.reshape(b_, s_, SSM_INNER) * jax.nn.silu(z.astype(jnp.float32))
    y = rmsnorm(y, norm_g).astype(h.dtype)
    return y @ w_out


def peer(h, w_q, sub_keys, u_emb, v_emb):
    b_, s_, d_ = h.shape
    t = h.reshape(-1, d_)
    n_tok = t.shape[0]
    q = (t @ w_q).reshape(n_tok, PEER_HEADS, 2, PEER_KEY_DIM // 2)
    scores = jnp.einsum('thpk,hpnk->thpn', q, sub_keys).astype(jnp.float32)
    s_top, i_top = lax.top_k(scores, PEER_TOPK)
    cand = s_top[:, :, 0, :, None] + s_top[:, :, 1, None, :]
    cand_idx = i_top[:, :, 0, :, None] * PEER_KEYS + i_top[:, :, 1, None, :]
    cand = cand.reshape(n_tok, PEER_HEADS, PEER_TOPK * PEER_TOPK)
    cand_idx = cand_idx.reshape(n_tok, PEER_HEADS, PEER_TOPK * PEER_TOPK)
    best, pos = lax.top_k(cand, PEER_TOPK)
    expert = jnp.take_along_axis(cand_idx, pos, axis=-1)
    gates = jax.nn.softmax(best, axis=-1).astype(h.dtype)
    nb = n_tok // PEER_TOKEN_BLOCK

    def block(args):
        tb, eb, gb = args
        u = u_emb[eb]
        act = jax.nn.gelu(jnp.einsum('td,thkd->thk', tb, u)) * gb
        return jnp.einsum('thk,thkd->td', act, v_emb[eb])

    out = lax.map(block, (t.reshape(nb, PEER_TOKEN_BLOCK, d_),
                          expert.reshape(nb, PEER_TOKEN_BLOCK, PEER_HEADS, PEER_TOPK),
                          gates.reshape(nb, PEER_TOKEN_BLOCK, PEER_HEADS, PEER_TOPK)))
    return out.reshape(b_, s_, d_).astype(h.dtype)


def setup_inputs(seed: int = 0) -> dict:
    key = jax.random.key(seed)
    keys = jax.random.split(key, 40)
    cnt = [0]
    f32 = jnp.float32

    def nk():
        k_ = keys[cnt[0]]
        cnt[0] += 1
        return k_

    def nrm(shape, scale):
        return jax.random.normal(nk(), shape, f32) * scale

    def gain(shape):
        return 1.0 + 0.02 * jax.random.normal(nk(), shape, f32)

    x = nrm((BATCH, SEQ, D_MODEL), 1.0)
    mix_norm = gain((DEPTH, D_MODEL))
    ffn_norm = gain((DEPTH, D_MODEL))
    final_norm = gain((D_MODEL,))
    even_w_in = nrm((N_EVEN, D_MODEL, EVEN_IN), D_MODEL ** -0.5)
    lru_conv_w = nrm((N_EVEN, CONV_WIDTH, LRU_WIDTH), CONV_WIDTH ** -0.5)
    lru_conv_b = nrm((N_EVEN, LRU_WIDTH), 0.01)
    lru_w_a = nrm((N_EVEN, LRU_BLOCKS, LRU_BLOCK, LRU_BLOCK), LRU_BLOCK ** -0.5)
    lru_b_a = nrm((N_EVEN, LRU_WIDTH), 0.01)
    lru_w_i = nrm((N_EVEN, LRU_BLOCKS, LRU_BLOCK, LRU_BLOCK), LRU_BLOCK ** -0.5)
    lru_b_i = nrm((N_EVEN, LRU_WIDTH), 0.01)
    a_pow_c = jax.random.uniform(nk(), (N_EVEN, LRU_WIDTH), f32, 0.9, 0.999)
    p = a_pow_c ** (1.0 / LRU_C)
    lru_lambda = jnp.log(p) - jnp.log1p(-p)
    even_w_out = nrm((N_EVEN, EVEN_MIX, D_MODEL), EVEN_MIX ** -0.5)
    ssm_w_in = nrm((N_ODD, D_MODEL, SSM_IN), D_MODEL ** -0.5)
    ssm_conv_w = nrm((N_ODD, CONV_WIDTH, SSM_CONV_DIM), CONV_WIDTH ** -0.5)
    ssm_conv_b = nrm((N_ODD, SSM_CONV_DIM), 0.01)
    dt0 = jnp.exp(jax.random.uniform(nk(), (N_ODD, SSM_HEADS), f32, math.log(1e-3), math.log(1e-1)))
    ssm_dt_bias = dt0 + jnp.log(-jnp.expm1(-dt0))
    ssm_a_log = jnp.log(jax.random.uniform(nk(), (N_ODD, SSM_HEADS), f32, 1.0, 16.0))
    ssm_d = gain((N_ODD, SSM_HEADS))
    ssm_norm = gain((N_ODD, SSM_INNER))
    ssm_w_out = nrm((N_ODD, SSM_INNER, D_MODEL), SSM_INNER ** -0.5)
    peer_w_q = nrm((DEPTH, D_MODEL, PEER_HEADS * PEER_KEY_DIM), D_MODEL ** -0.5)
    peer_sub_keys = nrm((DEPTH, PEER_HEADS, 2, PEER_KEYS, PEER_KEY_DIM // 2), (PEER_KEY_DIM // 2) ** -0.5)
    peer_u = nrm((DEPTH, PEER_EXPERTS, D_MODEL), D_MODEL ** -0.5)
    peer_v = nrm((DEPTH, PEER_EXPERTS, D_MODEL), (PEER_HEADS * PEER_TOPK) ** -0.5)
    return {'x': x, 'mix_norm': mix_norm, 'ffn_norm': ffn_norm, 'final_norm': final_norm,
            'even_w_in': even_w_in, 'lru_conv_w': lru_conv_w, 'lru_conv_b': lru_conv_b,
            'lru_w_a': lru_w_a, 'lru_b_a': lru_b_a, 'lru_w_i': lru_w_i, 'lru_b_i': lru_b_i,
            'lru_lambda': lru_lambda, 'even_w_out': even_w_out,
            'ssm_w_in': ssm_w_in, 'ssm_conv_w': ssm_conv_w, 'ssm_conv_b': ssm_conv_b,
            'ssm_dt_bias': ssm_dt_bias, 'ssm_a_log': ssm_a_log, 'ssm_d': ssm_d,
            'ssm_norm': ssm_norm, 'ssm_w_out': ssm_w_out,
            'peer_w_q': peer_w_q, 'peer_sub_keys': peer_sub_keys, 'peer_u': peer_u, 'peer_v': peer_v}


def reference(x, mix_norm, ffn_norm, final_norm, even_w_in, lru_conv_w, lru_conv_b, lru_w_a,
              lru_b_a, lru_w_i, lru_b_i, lru_lambda, even_w_out, ssm_w_in, ssm_conv_w, ssm_conv_b,
              ssm_dt_bias, ssm_a_log, ssm_d, ssm_norm, ssm_w_out, peer_w_q, peer_sub_keys,
              peer_u, peer_v):
    for layer in range(DEPTH):
        j = layer // 2
        hn = rmsnorm(x, mix_norm[layer])
        if layer % 2 == 0:
            x = x + lru_retention_mixer(hn, even_w_in[j], lru_conv_w[j], lru_conv_b[j], lru_w_a[j],
                                        lru_b_a[j], lru_w_i[j], lru_b_i[j], lru_lambda[j],
                                        even_w_out[j])
        else:
            x = x + mamba2_mixer(hn, ssm_w_in[j], ssm_conv_w[j], ssm_conv_b[j], ssm_dt_bias[j],
                                 ssm_a_log[j], ssm_d[j], ssm_norm[j], ssm_w_out[j])
        hn = rmsnorm(x, ffn_norm[layer])
        x = x + peer(hn, peer_w_q[layer], peer_sub_keys[layer], peer_u[layer], peer_v[layer])
    return rmsnorm(x, final_norm)
```

```cpp
#include <hip/hip_runtime.h>
#include <cstdio>
#include <cstdint>

#ifndef DBG_REF
#define DBG_REF 0
#endif
#ifndef REPEAT_MASK
#define REPEAT_MASK 0
#endif
#define REP(k) for (int rep_ = 0; rep_ < ((((REPEAT_MASK) >> (k)) & 1) + 1); ++rep_)
#ifndef DBG_SKIP
#define DBG_SKIP 0
#endif
#ifndef PEER_VSLICE
#define PEER_VSLICE 1
#endif
#ifndef PEER_OWNED
#define PEER_OWNED 1
#endif
#ifndef PEER_SPLIT
#define PEER_SPLIT 1
#endif
#ifndef LOCAL_SEAMS
#define LOCAL_SEAMS ((1<<1)|(1<<2)|(1<<3)|(1<<4)|(1<<5)|(1<<9)|(1<<10)|(1<<13)|(1<<14))
#endif
#define DI __device__ __forceinline__
#define LAS __attribute__((address_space(3)))
typedef unsigned short bf16_t;
typedef short bf16x8 __attribute__((ext_vector_type(8)));
typedef short s16x4 __attribute__((ext_vector_type(4)));
typedef float f32x4 __attribute__((ext_vector_type(4)));
typedef float f32x2 __attribute__((ext_vector_type(2)));
typedef unsigned u32x4 __attribute__((ext_vector_type(4)));
typedef unsigned u32x2 __attribute__((ext_vector_type(2)));
typedef __bf16 bf2_t __attribute__((ext_vector_type(2)));

constexpr int T = 16384, D = 1024, SEQ = 2048, NB = 8, NCH = 16, CH = 128;
constexpr int EVEN_IN = 6144, SSM_IN = 5152, SSM_N = 5120;
constexpr float EPS = 1e-6f;
constexpr int NWAVES = 8, NTHR = 512;

constexpr size_t MiB = 1u << 20;
constexpr size_t WS_CTL = 0, CTL_ZERO_BYTES = 1 * MiB;
constexpr size_t WS_RSTD = 1 * MiB;
constexpr size_t WS_SLOTS = 2 * MiB;
constexpr size_t WS_YSLOTS = 3 * MiB;
constexpr size_t WS_ROPE = 5 * MiB;
constexpr size_t WS_LRUW = 7 * MiB;
constexpr size_t WS_KEYS = 7 * MiB + 512 * 1024;
constexpr size_t WS_WDT = 8 * MiB + 512 * 1024;
constexpr size_t WS_DT = 9 * MiB;
constexpr size_t WS_CDEC = 11 * MiB;
constexpr size_t WS_WIN0 = 16 * MiB;
constexpr size_t WS_WOUT0 = 28 * MiB;
constexpr size_t WS_WIN1 = 32 * MiB;
constexpr size_t WS_WOUT1 = 42 * MiB;
constexpr size_t WS_WQ0 = 46 * MiB, WS_WQ1 = 48 * MiB;
constexpr size_t WS_UB = 52 * MiB, WS_VB = 84 * MiB;
constexpr size_t WS_XB = 468 * MiB;
#ifndef SSD_FUSED
#define SSD_FUSED 1
#endif
#define TCONV0_IN_TOPK (PEER_SPLIT && PEER_VSLICE && PEER_OWNED)
#define TCONV_IN_SSD (SSD_FUSED && PEER_SPLIT && PEER_VSLICE && PEER_OWNED)
constexpr size_t WS_XBC = SSD_FUSED ? 340 * MiB : 52 * MiB;
constexpr size_t WS_PROJ = 148 * MiB;
constexpr size_t WS_Q = SSD_FUSED ? 92 * MiB : 148 * MiB;
constexpr size_t WS_EIDX = SSD_FUSED ? 124 * MiB : 180 * MiB;
constexpr size_t WS_GATE = SSD_FUSED ? 132 * MiB : 188 * MiB;
constexpr size_t WS_STATES = 340 * MiB;
constexpr size_t WS_END = 500 * MiB;

constexpr int CW_TMO = 0, CW_CODE = 1, CW_GRPX = 2048  , CW_BAR = 4096;

constexpr int LDS_BYTES = 147456, MISC_OFF = LDS_BYTES - 256;

DI unsigned pk2(float lo, float hi) { const f32x2 v = {lo, hi}; return __builtin_bit_cast(unsigned, __builtin_convertvector(v, bf2_t)); }
DI unsigned f2bf(float f) { return pk2(f, f) & 0xffffu; }

DI float bf2f(unsigned short h) { return __builtin_bit_cast(float, (unsigned)h << 16); }
DI float bflo(unsigned w) { return __builtin_bit_cast(float, w << 16); }
DI float bfhi(unsigned w) { return __builtin_bit_cast(float, w & 0xffff0000u); }
DI float dot2bf(unsigned a, unsigned b, float c) { return __builtin_amdgcn_fdot2_f32_bf16(__builtin_bit_cast(bf2_t, a), __builtin_bit_cast(bf2_t, b), c, false); }
DI float row16_sum(float v) {
    v += __builtin_bit_cast(float, __builtin_amdgcn_update_dpp(0, __builtin_bit_cast(int, v), 0xB1, 0xf, 0xf, false));
    v += __builtin_bit_cast(float, __builtin_amdgcn_update_dpp(0, __builtin_bit_cast(int, v), 0x4E, 0xf, 0xf, false));
    v += __builtin_bit_cast(float, __builtin_amdgcn_update_dpp(0, __builtin_bit_cast(int, v), 0x141, 0xf, 0xf, false));
    v += __builtin_bit_cast(float, __builtin_amdgcn_update_dpp(0, __builtin_bit_cast(int, v), 0x140, 0xf, 0xf, false));
    return v;
}
DI float wave_sum(float v) {
#pragma unroll
    for (int o = 1; o < 64; o <<= 1) v += __shfl_xor(v, o);
    return v;
}
DI float frcp(float x) { return __builtin_amdgcn_rcpf(x); }
DI float sigmoidf_(float x) { return frcp(1.f + __expf(-x)); }
DI float siluf_(float x) { return x * frcp(1.f + __expf(-x)); }
DI float gelu_tanh(float x) { const float y = 0.7978845608028654f * (x + 0.044715f * x * x * x); const float e = __expf(2.f * y); const float th = 1.f - 2.f * frcp(e + 1.f); return 0.5f * x * (1.f + th); }
DI float softplusf_(float x) { return x > 0.f ? x + log1pf(expf(-x)) : log1pf(expf(x)); }

DI bf16x8 frag_row(const LAS short* img, int ld, int row0, int k0, int lane) {
    return *(const LAS bf16x8*)(img + (row0 + (lane & 15)) * ld + k0 + 8 * (lane >> 4));
}
DI bf16x8 frag_tr(const LAS short* img, int ld, int x0, int k0, int lane) {
    const int g = lane >> 4, q = (lane & 15) >> 2, p = lane & 3;
    const LAS short* a = img + (k0 + 8 * g + q) * ld + x0 + 4 * p;
    const s16x4 lo = __builtin_amdgcn_ds_read_tr16_b64_v4i16((LAS s16x4*)a);
    const s16x4 hi = __builtin_amdgcn_ds_read_tr16_b64_v4i16((LAS s16x4*)(a + 4 * ld));
    return __builtin_shufflevector(lo, hi, 0, 1, 2, 3, 4, 5, 6, 7);
}
#define MFMA16(a, b, c) __builtin_amdgcn_mfma_f32_16x16x32_bf16((a), (b), (c), 0, 0, 0)
template <int N> DI void pin(f32x4 (&a)[N]) {
#pragma unroll
    for (int i = 0; i < N; ++i) asm volatile("" : "+v"(a[i]));
}

namespace pg8 {
#define PG8_LAS __attribute__((address_space(3)))
constexpr int BM = 256, BK = 64, HALF = 128, HTB = HALF * BK * 2, STAGE_BYTES = 8 * HTB, NXCD = 8, WGM = 8;
__host__ __device__ __forceinline__ int lds_byte(int r, int c) { const int st = (r >> 4) * 2 + (c >> 5), rr = r & 15, cc = c & 31, ob = rr * 64 + cc * 2; return st * 1024 + (ob ^ (((ob >> 9) & 1) << 5)); }
__host__ __device__ __forceinline__ void stage_rc(int b, int& R, int& C) { const int st = b / 1024, sb = b % 1024, swz = sb ^ (((sb >> 9) & 1) << 5); R = (st >> 1) * 16 + swz / 64; C = (st & 1) * 32 + (swz % 64) / 2; }
__host__ __device__ __forceinline__ int perm32(int rho) { const int n = rho >> 4, i = rho & 15; return 8 * (i >> 2) + 4 * n + (i & 3); }
struct Unit { int pm, pn; };
struct Gemm { const bf16_t* A; const bf16_t* Bt; int M, N, K, lda; };
struct StaticOrder {
    int nM, nN, nwg, G, c;
    __host__ __device__ void init(int M, int N, int G_, int c_) { nM = M / BM; nN = N / BM; nwg = nM * nN; G = G_; c = c_; }
    __host__ __device__ bool next(int i, Unit& u) const {
        const long L = (long)i * G + c; if (L >= nwg) return false;
        int wgid = (int)L; { const int q = nwg / NXCD, r = nwg % NXCD, xcd = wgid % NXCD, off = wgid / NXCD; wgid = (xcd < r ? xcd * (q + 1) : r * (q + 1) + (xcd - r) * q) + off; }
        const int nig = WGM * nN, gid = wgid / nig, fm = gid * WGM, gsz = (nM - fm) < WGM ? (nM - fm) : WGM;
        u.pm = fm + ((wgid % nig) % gsz); u.pn = (wgid % nig) / gsz; return true;
    }
};
DI unsigned cvt_pk_bf16(float lo, float hi) { return pk2(lo, hi); }

struct Epi {
    static constexpr bool PERM = true;
    bf16_t* O; int ldo;
    float* F32; const float* RES; const bf16_t* RESB;
    const float* rs; int rs_mode;
    float* ssq;
    const f32x2* rope; int rope_lo, rope_hi, q_hi;
    DI void operator()(const f32x4 (&acc)[2][2][4][2], const Unit& u, int wr, int wc, int fr, int fq) const {
        const bool do_rope = rope != nullptr && u.pn >= rope_lo && u.pn < rope_hi;
        const float qs = (do_rope && u.pn < q_hi) ? 0.0625f : 1.f;
        const int col0 = u.pn * BM + wc * 32 + 8 * fq;
#pragma unroll
        for (int ai = 0; ai < 2; ++ai)
#pragma unroll
            for (int m = 0; m < 4; ++m) {
                const int row = u.pm * BM + ai * HALF + wr * 64 + m * 16 + fr;
                float sc = 1.f;
                if (rs_mode == 1) sc = rs[row];
                else if (rs_mode == 2) { const f32x4 v = *(const f32x4*)(rs + (size_t)row * 16 + 4 * fq); float s = (v[0] + v[1]) + (v[2] + v[3]); s += __shfl_xor(s, 16); s += __shfl_xor(s, 32); sc = rsqrtf(s * (1.f / 1024.f) + EPS); }
                else if (rs_mode == 3) { const f32x4 v = *(const f32x4*)(rs + (size_t)row * 32 + 8 * fq), w = *(const f32x4*)(rs + (size_t)row * 32 + 8 * fq + 4); float s = ((v[0] + v[1]) + (v[2] + v[3])) + ((w[0] + w[1]) + (w[2] + w[3])); s += __shfl_xor(s, 16); s += __shfl_xor(s, 32); sc = rsqrtf(s * (1.f / 2048.f) + EPS); }
                f32x4 v[2][2];
#pragma unroll
                for (int bj = 0; bj < 2; ++bj)
#pragma unroll
                    for (int n = 0; n < 2; ++n) v[bj][n] = acc[ai][bj][m][n] * sc;
                if (do_rope) {
                    const int pos = row & (SEQ - 1);
                    const f32x2* tp = rope + (size_t)pos * 128 + wc * 32 + 8 * fq;
#pragma unroll
                    for (int n = 0; n < 2; ++n)
#pragma unroll
                        for (int j = 0; j < 4; ++j) { const f32x2 cs = tp[4 * n + j]; const float x1 = v[0][n][j], x2 = v[1][n][j]; v[0][n][j] = (x1 * cs.x - x2 * cs.y) * qs; v[1][n][j] = (x1 * cs.y + x2 * cs.x) * qs; }
                }
                if (RES || RESB) {
                    float s = 0.f;
#pragma unroll
                    for (int bj = 0; bj < 2; ++bj)
#pragma unroll
                        for (int n = 0; n < 2; ++n) { const size_t off = (size_t)row * 1024 + col0 + bj * HALF + 4 * n; f32x4 r;
                            if (RES) r = *(const f32x4*)(RES + off);
                            else { const u32x2 rb = *(const u32x2*)(RESB + off); r = (f32x4){bflo(rb.x), bfhi(rb.x), bflo(rb.y), bfhi(rb.y)}; }
                            v[bj][n] = v[bj][n] + r; if (F32) *(f32x4*)(F32 + off) = v[bj][n];
                            s += (v[bj][n][0] * v[bj][n][0] + v[bj][n][1] * v[bj][n][1]) + (v[bj][n][2] * v[bj][n][2] + v[bj][n][3] * v[bj][n][3]); }
                    if (ssq) { s += __shfl_xor(s, 16); s += __shfl_xor(s, 32); if (fq == 0) ssq[(size_t)row * 16 + u.pn * 4 + wc] = s; }
                }
                if (O) {
#pragma unroll
                    for (int bj = 0; bj < 2; ++bj) { u32x4 w; w.x = cvt_pk_bf16(v[bj][0][0], v[bj][0][1]); w.y = cvt_pk_bf16(v[bj][0][2], v[bj][0][3]); w.z = cvt_pk_bf16(v[bj][1][0], v[bj][1][1]); w.w = cvt_pk_bf16(v[bj][1][2], v[bj][1][3]);
                        *(u32x4*)(O + (size_t)row * ldo + col0 + bj * HALF) = w; }
                }
            }
    }
};

template <class EpiT, class Sched, bool ALIGN_EPI>
DI void gemm_phase(PG8_LAS unsigned char* lds, const Gemm g, const Sched& S, const EpiT& E) {
    const int tid = threadIdx.x, wid = __builtin_amdgcn_readfirstlane(tid >> 6), lane = tid & 63, wr = wid >> 2, wc = wid & 3, fr = lane & 15, fq = lane >> 4;
    const int K = g.K, nt = K / BK, lda = g.lda;
    unsigned voffA[2], voffB[2];
#pragma unroll
    for (int i = 0; i < 2; ++i) { int R, C; stage_rc(tid * 16 + i * 8192, R, C); const int Rb = EpiT::PERM ? ((R & ~31) + perm32(R & 31)) : R;
        voffA[i] = (unsigned)(R * lda + C) * 2u; voffB[i] = (unsigned)(Rb * K + C) * 2u; }
    const size_t kstep = (size_t)(BK * 2);
    const size_t hstepA = (size_t)HALF * lda * 2, tstepA = 2 * hstepA;
    const size_t hstepB = (size_t)HALF * K * 2, tstepB = 2 * hstepB;
    const unsigned ldsw = (unsigned)wid * 1024u;
    const int aoff = lds_byte(wr * 64 + fr, fq * 8), boff = lds_byte(wc * 32 + fr, fq * 8);
#define PG8_SA(b, h) (((b) * 2 + (h)) * HTB)
#define PG8_SB(b, h) ((4 + (b) * 2 + (h)) * HTB)
#define PG8_STAGE(bufoff, gbase, voff) do { _Pragma("unroll") for (int _i = 0; _i < 2; ++_i) \
        __builtin_amdgcn_global_load_lds((const unsigned*)((const char*)(gbase) + (voff)[_i]), (PG8_LAS unsigned*)(lds + (bufoff) + ldsw + _i * 8192), 16, 0, 0); } while (0)
#define PG8_LDA(dst, b, h) do { _Pragma("unroll") for (int m = 0; m < 4; ++m) _Pragma("unroll") for (int k = 0; k < 2; ++k) dst[m][k] = *(const PG8_LAS bf16x8*)(lds + PG8_SA(b, h) + aoff + m * 2048 + k * 1024); } while (0)
#define PG8_LDB(dst, b, h) do { _Pragma("unroll") for (int n = 0; n < 2; ++n) _Pragma("unroll") for (int k = 0; k < 2; ++k) dst[n][k] = *(const PG8_LAS bf16x8*)(lds + PG8_SB(b, h) + boff + n * 2048 + k * 1024); } while (0)
#define PG8_MMA(ai, bj, At, Bt) do { __builtin_amdgcn_s_setprio(1); _Pragma("unroll") for (int m = 0; m < 4; ++m) _Pragma("unroll") for (int n = 0; n < 2; ++n) _Pragma("unroll") for (int k = 0; k < 2; ++k) \
        acc[ai][bj][m][n] = __builtin_amdgcn_mfma_f32_16x16x32_bf16(Bt[n][k], At[m][k], acc[ai][bj][m][n], 0, 0, 0); __builtin_amdgcn_s_setprio(0); } while (0)
#define PG8_WAIT_V(n) asm volatile("s_waitcnt vmcnt(" #n ")" ::: "memory")
#define PG8_WAIT_L(n) asm volatile("s_waitcnt lgkmcnt(" #n ")" ::: "memory")
#define PG8_BAR __builtin_amdgcn_s_barrier()
#define PG8_SCHED __builtin_amdgcn_sched_barrier(0)
    Unit cur, nxt; int ui = 0;
    if (!S.next(0, cur)) return;
    f32x4 acc[2][2][4][2];
#pragma unroll
    for (int a = 0; a < 2; ++a)
#pragma unroll
        for (int b = 0; b < 2; ++b)
#pragma unroll
            for (int m = 0; m < 4; ++m)
#pragma unroll
                for (int n = 0; n < 2; ++n) acc[a][b][m][n] = (f32x4){0.f, 0.f, 0.f, 0.f};
    bf16x8 At[4][2], B0[2][2], B1[2][2];
    const char* cA = (const char*)g.A + (size_t)cur.pm * tstepA; const char* cB = (const char*)g.Bt + (size_t)cur.pn * tstepB;
    PG8_STAGE(PG8_SB(0, 0), cB, voffB); PG8_STAGE(PG8_SB(0, 1), cB + hstepB, voffB); PG8_STAGE(PG8_SA(0, 0), cA, voffA); PG8_STAGE(PG8_SA(0, 1), cA + hstepA, voffA);
    if (wr == 1) PG8_BAR;
    PG8_WAIT_V(2); PG8_BAR;
    PG8_STAGE(PG8_SB(1, 0), cB + kstep, voffB); PG8_STAGE(PG8_SA(1, 0), cA + kstep, voffA); PG8_STAGE(PG8_SB(1, 1), cB + hstepB + kstep, voffB);
    PG8_WAIT_V(6); PG8_BAR;
    for (;;) {
        const bool has_next = S.next(ui + 1, nxt);
        const char* nA = has_next ? (const char*)g.A + (size_t)nxt.pm * tstepA : cA; const char* nB = has_next ? (const char*)g.Bt + (size_t)nxt.pn * tstepB : cB;
        for (int t = 0; t < nt; t += 2) {
            const bool last = (t == nt - 2);
            const char* a1 = cA + (size_t)(t + 1) * kstep;
            const char* a2 = last ? nA : cA + (size_t)(t + 2) * kstep; const char* b2 = last ? nB : cB + (size_t)(t + 2) * kstep;
            const char* a3 = a2 + kstep; const char* b3 = b2 + kstep;
            PG8_LDB(B0, 0, 0); PG8_LDB(B1, 0, 1); PG8_SCHED; PG8_LDA(At, 0, 0); PG8_STAGE(PG8_SA(1, 1), a1 + hstepA, voffA);
            PG8_WAIT_V(8); PG8_WAIT_L(0); PG8_BAR; PG8_MMA(0, 0, At, B0); PG8_MMA(0, 1, At, B1); PG8_BAR; PG8_SCHED;
            PG8_LDA(At, 0, 1); PG8_STAGE(PG8_SB(0, 0), b2, voffB); PG8_STAGE(PG8_SB(0, 1), b2 + hstepB, voffB); PG8_STAGE(PG8_SA(0, 0), a2, voffA);
            PG8_WAIT_V(8); PG8_WAIT_L(0); PG8_BAR; PG8_MMA(1, 0, At, B0); PG8_MMA(1, 1, At, B1); PG8_BAR; PG8_SCHED;
            PG8_LDB(B0, 1, 0); PG8_LDB(B1, 1, 1); PG8_SCHED; PG8_LDA(At, 1, 0); PG8_STAGE(PG8_SA(0, 1), a2 + hstepA, voffA);
            PG8_WAIT_V(8); PG8_WAIT_L(0); PG8_BAR; PG8_MMA(0, 0, At, B0); PG8_MMA(0, 1, At, B1); PG8_BAR; PG8_SCHED;
            PG8_LDA(At, 1, 1); PG8_STAGE(PG8_SB(1, 0), b3, voffB); PG8_STAGE(PG8_SB(1, 1), b3 + hstepB, voffB); PG8_STAGE(PG8_SA(1, 0), a3, voffA);
            PG8_WAIT_V(8); PG8_WAIT_L(0); PG8_BAR; PG8_MMA(1, 0, At, B0); PG8_MMA(1, 1, At, B1); PG8_BAR; PG8_SCHED;
        }
        if constexpr (ALIGN_EPI) { if (wr == 0) PG8_BAR; }
        E(acc, cur, wr, wc, fr, fq);
        if (!has_next) break;
#pragma unroll
        for (int a = 0; a < 2; ++a)
#pragma unroll
            for (int b = 0; b < 2; ++b)
#pragma unroll
                for (int m = 0; m < 4; ++m)
#pragma unroll
                    for (int n = 0; n < 2; ++n) acc[a][b][m][n] = (f32x4){0.f, 0.f, 0.f, 0.f};
        cur = nxt; cA = nA; cB = nB; ++ui;
        if constexpr (ALIGN_EPI) { if (wr == 1) PG8_BAR; }
    }
    PG8_WAIT_V(0);
    if constexpr (!ALIGN_EPI) { if (wr == 0) PG8_BAR; }
    PG8_BAR;
#undef PG8_SA
#undef PG8_SB
#undef PG8_STAGE
#undef PG8_LDA
#undef PG8_LDB
#undef PG8_MMA
#undef PG8_WAIT_V
#undef PG8_WAIT_L
#undef PG8_BAR
#undef PG8_SCHED
}
}

#define RLX_AGENT __ATOMIC_RELAXED, __HIP_MEMORY_SCOPE_AGENT
#define XB_TMO      128
#define XB_XCNT(j)  (256  + 64 * (j))
#define XB_XSUB(j)  (1280 + 64 * (j))
#define XB_XGEN(j)  (2304 + 64 * (j))
#define XB_TOP      3328
#define XB_TOPGEN   3392
#define XCD_BAR_WORDS 3456
#define XB_SPIN_CAP (1u << 18)
DI unsigned xb_ld(unsigned* p)              { return __hip_atomic_load(p, __ATOMIC_RELAXED, __HIP_MEMORY_SCOPE_AGENT); }
DI unsigned xb_add(unsigned* p, unsigned v) { return __hip_atomic_fetch_add(p, v, __ATOMIC_RELAXED, __HIP_MEMORY_SCOPE_AGENT); }
DI unsigned xb_xcc_id() { return (unsigned)__builtin_amdgcn_s_getreg((3 << 11) | 20) & 0xFu; }
#define XB_SPIN(cond, bar) do { unsigned _sp = 0; while (cond) { __builtin_amdgcn_s_sleep(1); \
    if ((++_sp & 255u) == 0u) { if (xb_ld(&(bar)[XB_TMO])) break; if (_sp > XB_SPIN_CAP) { atomicAdd(&(bar)[XB_TMO], 1u); break; } } } } while (0)
struct XcdBarrier { unsigned* bar; unsigned x; volatile LAS unsigned* st; };
DI XcdBarrier xcd_barrier_post(unsigned* bar, volatile LAS unsigned* st) {
    XcdBarrier b; b.bar = bar; b.x = xb_xcc_id(); b.st = st;
    if (threadIdx.x == 0) (void)xb_add(&bar[XB_XCNT(b.x)], 1u);
    return b;
}
DI void xcd_barrier_complete(unsigned* bar, unsigned x, unsigned& nloc, unsigned& nx) {
    const unsigned G = gridDim.x * gridDim.y * gridDim.z;
    unsigned sum, cnt, mine, sp = 0u;
    for (;;) {
        sum = 0u; cnt = 0u; mine = 0u;
#pragma unroll
        for (unsigned j = 0; j < 16; ++j) { const unsigned c = xb_ld(&bar[XB_XCNT(j)]); sum += c; cnt += (c > 0u) ? 1u : 0u; mine = (j == x) ? c : mine; }
        if (sum == G) break;
        __builtin_amdgcn_s_sleep(1);
        if ((++sp & 255u) == 0u) { if (xb_ld(&bar[XB_TMO])) break; if (sp > XB_SPIN_CAP) { atomicAdd(&bar[XB_TMO], 1u); break; } }
    }
    nloc = mine > 0u ? mine : 1u; nx = cnt > 0u ? cnt : 1u;
}
DI void xcd_barrier(const XcdBarrier& b, bool local = false) {
    asm volatile("s_waitcnt vmcnt(0)" ::: "memory");
    __syncthreads();
    if (threadIdx.x == 0) {
        unsigned* bar = b.bar;
        __builtin_amdgcn_s_waitcnt(0);
        unsigned nloc = b.st[0], nx = b.st[1];
        if (nloc == 0u) { xcd_barrier_complete(bar, b.x, nloc, nx); b.st[0] = nloc; b.st[1] = nx; }
        const unsigned old = xb_add(&bar[XB_XSUB(b.x)], 1u);
        const unsigned gen = old / nloc;
        if (old + 1u == (gen + 1u) * nloc) {
            __builtin_amdgcn_fence(__ATOMIC_RELEASE, "agent");
            asm volatile("s_waitcnt vmcnt(0)" ::: "memory");
            if (!local) {
            const unsigned og = xb_add(&bar[XB_TOP], 1u);
            const unsigned tg = og / nx;
            if (og + 1u == (tg + 1u) * nx) xb_add(&bar[XB_TOPGEN], 1u);
            else XB_SPIN(xb_ld(&bar[XB_TOPGEN]) == tg, bar);
            }
            __builtin_amdgcn_fence(__ATOMIC_ACQUIRE, "agent");
            xb_add(&bar[XB_XGEN(b.x)], 1u);
            asm volatile("s_waitcnt vmcnt(0)" ::: "memory");
        } else {
            XB_SPIN(xb_ld(&bar[XB_XGEN(b.x)]) == gen, bar);
            __builtin_amdgcn_fence(__ATOMIC_ACQUIRE, "agent");
            asm volatile("s_waitcnt vmcnt(0)" ::: "memory");
        }
    }
    __syncthreads();
}

struct Args { const float* in[25]; float* out; unsigned char* ws; int ph_lo, ph_hi; };
struct Frame {
    LAS unsigned char* lds;
    int tid, lane, wave, vcu, G, gw, NGW;
    const float* const* in;
    float* out; unsigned char* ws;
};
#define WSP(type, off) ((type*)(F.ws + (off)))

DI void p0_transpose_item(const float* W, int K, int N, bf16_t* WT, int out_row0, int n0, int k0, const float* gain, LAS float* scr, int lane) {
#pragma unroll
    for (int hb = 0; hb < 2; ++hb) {
        float wv[16];
#pragma unroll
        for (int i = 0; i < 16; ++i) { const int kk = 2 * (16 * hb + i) + (lane >> 5); wv[i] = W[(size_t)(k0 + kk) * N + n0 + (lane & 31)]; }
        asm volatile("" ::: "memory");
#pragma unroll
        for (int i = 0; i < 16; ++i) { const int kk = 2 * (16 * hb + i) + (lane >> 5); float w = wv[i]; if (gain) w *= gain[k0 + kk]; scr[kk * 33 + (lane & 31)] = w; }
    }
    asm volatile("s_waitcnt lgkmcnt(0)" ::: "memory");
    const int c = lane & 7;
#pragma unroll
    for (int j = 0; j < 4; ++j) { const int n = (lane >> 3) + 8 * j; const LAS float* s = scr + (8 * c) * 33 + n;
        u32x4 o; o.x = pk2(s[0 * 33], s[1 * 33]); o.y = pk2(s[2 * 33], s[3 * 33]); o.z = pk2(s[4 * 33], s[5 * 33]); o.w = pk2(s[6 * 33], s[7 * 33]);
        *(u32x4*)(WT + (size_t)(out_row0 + n) * K + k0 + 8 * c) = o; }
    asm volatile("s_waitcnt lgkmcnt(0)" ::: "memory");
}
DI void row_cvt(const float* src, bf16_t* dst, const float* gain, float* rstd_out, int lane) {
    const f32x4* s4 = (const f32x4*)src + lane;
    f32x4 v[4]; float ss = 0.f;
#pragma unroll
    for (int j = 0; j < 4; ++j) { v[j] = s4[64 * j]; ss += (v[j][0] * v[j][0] + v[j][1] * v[j][1]) + (v[j][2] * v[j][2] + v[j][3] * v[j][3]); }
    if (rstd_out) { const float tot = wave_sum(ss); if (lane == 0) *rstd_out = rsqrtf(tot * (1.f / 1024.f) + EPS); }
    if (gain) {
#pragma unroll
        for (int j = 0; j < 4; ++j) v[j] = v[j] * ((const f32x4*)gain + lane)[64 * j];
    }
    u32x2* o8 = (u32x2*)dst + lane;
#pragma unroll
    for (int j = 0; j < 4; ++j) { u32x2 w; w.x = pk2(v[j][0], v[j][1]); w.y = pk2(v[j][2], v[j][3]); o8[64 * j] = w; }
}
DI void row_cvt8(const float* src, unsigned char* dst, const float* gain, float scale, int lane) {
    const f32x4* s4 = (const f32x4*)src + lane; unsigned* d4 = (unsigned*)dst + lane;
#pragma unroll
    for (int j = 0; j < 4; ++j) { f32x4 v = s4[64 * j] * scale; if (gain) v = v * ((const f32x4*)gain + lane)[64 * j];
        int w = 0; w = __builtin_amdgcn_cvt_pk_fp8_f32(v[0], v[1], w, false); w = __builtin_amdgcn_cvt_pk_fp8_f32(v[2], v[3], w, true); d4[64 * j] = (unsigned)w; }
}
template <bool SLICED = false>
DI void row_cvt4(const float* src, unsigned char* dst, const float* gain, float scale, int lane, int e = 0) {
    const f32x4* s4 = (const f32x4*)src + 2 * lane; unsigned* d4 = SLICED ? (unsigned*)(dst + (size_t)(lane >> 5) * (16384 * 128) + (size_t)e * 128 + 4 * (lane & 31)) : (unsigned*)dst + lane;
#pragma unroll
    for (int j = 0; j < 2; ++j) { f32x4 a = s4[128 * j] * scale, b = s4[128 * j + 1] * scale;
        if (gain) { a = a * ((const f32x4*)gain + 2 * lane)[128 * j]; b = b * ((const f32x4*)gain + 2 * lane)[128 * j + 1]; }
        unsigned w = 0;
        w = __builtin_amdgcn_cvt_scalef32_pk_fp4_f32(w, a[0], a[1], 1.0f, 0); w = __builtin_amdgcn_cvt_scalef32_pk_fp4_f32(w, a[2], a[3], 1.0f, 1);
        w = __builtin_amdgcn_cvt_scalef32_pk_fp4_f32(w, b[0], b[1], 1.0f, 2); w = __builtin_amdgcn_cvt_scalef32_pk_fp4_f32(w, b[2], b[3], 1.0f, 3);
        d4[SLICED ? j * (2 * 16384 * 32) : 64 * j] = w; }
}
#ifndef PEER_FP4
#define PEER_FP4 1
#endif
constexpr float PEER_SU = PEER_FP4 ? 64.f : 256.f, PEER_SV = PEER_FP4 ? 22.63f : 64.f;
DI void convert_tables(const Frame& F, int layer) {
    const float* u = F.in[23] + (size_t)layer * 16384 * 1024; const float* v = F.in[24] + (size_t)layer * 16384 * 1024; const float* g = F.in[2] + layer * 1024;
    unsigned char* UB = WSP(unsigned char, WS_UB); unsigned char* VB = WSP(unsigned char, WS_VB);
    for (int r = F.gw; r < 32768; r += F.NGW) {
        if (PEER_FP4) { if (r < 16384) { if (PEER_SPLIT) row_cvt4<true>(u + (size_t)r * 1024, UB, g, PEER_SU, F.lane, r); else row_cvt4(u + (size_t)r * 1024, UB + (size_t)r * 512, g, PEER_SU, F.lane); }
                        else { if (PEER_SPLIT && PEER_VSLICE && (layer == 0 || T == 8 * F.NGW)) row_cvt4<true>(v + (size_t)(r - 16384) * 1024, VB, nullptr, PEER_SV, F.lane, r - 16384); else row_cvt4(v + (size_t)(r - 16384) * 1024, VB + (size_t)(r - 16384) * 512, nullptr, PEER_SV, F.lane); } }
        else { if (r < 16384) row_cvt8(u + (size_t)r * 1024, UB + (size_t)r * 1024, g, PEER_SU, F.lane);
               else row_cvt8(v + (size_t)(r - 16384) * 1024, VB + (size_t)(r - 16384) * 1024, nullptr, PEER_SV, F.lane); }
    }
}
DI void p0_prologue(const Frame& F) {
    LAS float* scr = (LAS float*)(F.lds + F.wave * 16384);
    constexpr int I_IN0 = 16 * 192, I_OUT = 32 * 32, I_IN1 = 16 * 161, I_Q = 16 * 32;
    constexpr int NIT = I_IN0 + I_OUT + I_IN1 + I_OUT + 2 * I_Q;
    for (int it = F.gw; it < NIT; it += F.NGW) {
        int r = it;
        if (r < I_IN0) { const int kb = r / 192, nb = r % 192, n0 = nb * 32, seg = n0 >> 10;
            const int omap = (seg == 0) ? 0 : (seg == 5 ? 1 : seg + 1);
            p0_transpose_item(F.in[4], 1024, EVEN_IN, WSP(bf16_t, WS_WIN0), omap * 1024 + (n0 & 1023) , n0, kb * 64, F.in[1], scr, F.lane); continue; }
        r -= I_IN0;
        if (r < I_OUT) { const int kb = r / 32, nb = r % 32; p0_transpose_item(F.in[12], 2048, 1024, WSP(bf16_t, WS_WOUT0), nb * 32, nb * 32, kb * 64, nullptr, scr, F.lane); continue; }
        r -= I_OUT;
        if (r < I_IN1) { const int kb = r / 161, nb = r % 161, n0 = nb * 32;
            if (n0 < SSM_N) p0_transpose_item(F.in[13], 1024, SSM_IN, WSP(bf16_t, WS_WIN1), n0, n0, kb * 64, F.in[1] + 1024, scr, F.lane);
            else p0_transpose_item(F.in[13], 1024, SSM_IN, WSP(bf16_t, WS_WDT), 0, n0, kb * 64, F.in[1] + 1024, scr, F.lane);
            continue; }
        r -= I_IN1;
        if (r < I_OUT) { const int kb = r / 32, nb = r % 32; p0_transpose_item(F.in[20], 2048, 1024, WSP(bf16_t, WS_WOUT1), nb * 32, nb * 32, kb * 64, F.in[19], scr, F.lane); continue; }
        r -= I_OUT;
        { const int l = r / I_Q; r -= l * I_Q; const int kb = r / 32, nb = r % 32;
          p0_transpose_item(F.in[21] + (size_t)l * 1024 * 1024, 1024, 1024, WSP(bf16_t, l ? WS_WQ1 : WS_WQ0), nb * 32, nb * 32, kb * 64, F.in[2] + l * 1024, scr, F.lane); }
    }
    for (int r = F.gw; r < T; r += F.NGW) row_cvt(F.in[0] + (size_t)r * 1024, WSP(bf16_t, WS_XB) + (size_t)r * 1024, nullptr, WSP(float, WS_RSTD) + r, F.lane);
    if (!(TCONV0_IN_TOPK && F.G == 256 && !(DBG_REF & 8))) convert_tables(F, 0);
    const int gt = F.gw * 64 + F.lane, NGT = F.NGW * 64;
    for (int i = gt; i < 2048 * 128; i += NGT) { const int pos = i >> 7, d = i & 127;
        const float inv = (float)exp(-(double)d * (9.210340371976184 / 128.0));
        const float ang = (float)pos * inv; float sn, cs; sincosf(ang, &sn, &cs);
        WSP(f32x2, WS_ROPE)[i] = (f32x2){cs, sn}; }
    for (int i = gt; i < 16 * 128 * 64; i += NGT) { const int blk = i >> 13, jj = (i >> 6) & 127, ii = i & 63;
        const float w = (jj < 64) ? F.in[7][(blk * 64 + ii) * 64 + jj] : F.in[9][(blk * 64 + ii) * 64 + (jj - 64)];
        WSP(bf16_t, WS_LRUW)[i] = (bf16_t)f2bf(w); }
    for (int i = gt; i < 2 * 8 * 2 * 128 * 64; i += NGT) WSP(bf16_t, WS_KEYS)[i] = (bf16_t)f2bf(F.in[22][i]);
}

constexpr int P0_GA = 0, P0_GB = 1024, P0_XA = 2048, P0_Q = 3072, P0_K = 4096, P0_V = 5120;
constexpr int LDQ = 264;
DI float ret_lg(int h) { return log1pf(-exp2f(-5.f - (float)h)); }

DI void stage_128x256(LAS short* img, const bf16_t* src, int ldg, int tid, const LAS float* rowscale) {
    u32x4 v[8];
#pragma unroll
    for (int i = 0; i < 8; ++i) { const unsigned c = (unsigned)tid + 512u * i, row = c >> 5, ch = c & 31u; v[i] = *(const u32x4*)(src + (row * (unsigned)ldg + ch * 8u)); }
#pragma unroll
    for (int i = 0; i < 8; ++i) { const unsigned c = (unsigned)tid + 512u * i, row = c >> 5, ch = c & 31u;
        u32x4 w = v[i];
        if (rowscale) { const float s = rowscale[row];
            w.x = pk2(bflo(w.x) * s, bfhi(w.x) * s); w.y = pk2(bflo(w.y) * s, bfhi(w.y) * s); w.z = pk2(bflo(w.z) * s, bfhi(w.z) * s); w.w = pk2(bflo(w.w) * s, bfhi(w.w) * s); }
        *(LAS u32x4*)(img + row * LDQ + ch * 8) = w; }
    asm volatile("" ::: "memory");
}
DI void ret_kv_unit(const Frame& F, int unit) {
    const int b = unit >> 6, h = (unit >> 4) & 3, n = unit & 15;
    const int tok0 = b * SEQ + n * CH;
    const bf16_t* proj = WSP(bf16_t, WS_PROJ);
    LAS short* Kimg = (LAS short*)F.lds; LAS short* Vimg = Kimg + 128 * LDQ;
    LAS float* kdec = (LAS float*)(F.lds + 2 * 128 * LDQ * 2);
    const float lg = ret_lg(h);
    if (F.tid < 128) kdec[F.tid] = expf(lg * (float)(127 - F.tid));
    __syncthreads();
    stage_128x256(Kimg, proj + (size_t)tok0 * EVEN_IN + P0_K + h * 256, EVEN_IN, F.tid, nullptr);
    stage_128x256(Vimg, proj + (size_t)tok0 * EVEN_IN + P0_V + h * 256, EVEN_IN, F.tid, kdec);
    __syncthreads();
    const int w = F.wave, lane = F.lane, dm = w >> 2, en = w & 3, fr = lane & 15, fq = lane >> 4;
    float* st = WSP(float, WS_STATES) + (size_t)unit * 65536;
#pragma unroll 1
    for (int mh = 0; mh < 2; ++mh) {
        f32x4 acc[4][4];
#pragma unroll
        for (int m = 0; m < 4; ++m)
#pragma unroll
            for (int nn = 0; nn < 4; ++nn) acc[m][nn] = (f32x4){0.f, 0.f, 0.f, 0.f};
#pragma unroll
        for (int ks = 0; ks < 4; ++ks) {
            bf16x8 bfr[4];
#pragma unroll
            for (int nn = 0; nn < 4; ++nn) bfr[nn] = frag_tr(Vimg, LDQ, 64 * en + 16 * nn, 32 * ks, lane);
#pragma unroll
            for (int m = 0; m < 4; ++m) { const bf16x8 a = frag_tr(Kimg, LDQ, 128 * dm + 64 * mh + 16 * m, 32 * ks, lane);
#pragma unroll
                for (int nn = 0; nn < 4; ++nn) acc[m][nn] = MFMA16(a, bfr[nn], acc[m][nn]); }
        }
#pragma unroll
        for (int m = 0; m < 4; ++m)
#pragma unroll
            for (int nn = 0; nn < 4; ++nn)
#pragma unroll
                for (int r = 0; r < 4; ++r) st[(128 * dm + 64 * mh + 16 * m + 4 * fq + r) * 256 + 64 * en + 16 * nn + fr] = acc[m][nn][r];
    }
    __syncthreads();
}

template <bool DRY = false>
DI void lru_unit(const Frame& F, int unit) {
    const int b = unit >> 4, blk = unit & 15, c = F.lane, s = F.wave, ch = blk * 64 + c, lane = F.lane, fr = lane & 15, fq = lane >> 4;
    bf16_t* proj = WSP(bf16_t, WS_PROJ);
    LAS short* Aimg = (LAS short*)(F.lds + s * 12288);
    LAS float* PRE = (LAS float*)(F.lds + s * 12288 + 2560);
    LAS float* EXCH = (LAS float*)(F.lds + 8 * 12288);
    const float* cw = F.in[5]; const float cw0 = cw[ch], cw1 = cw[1024 + ch], cw2 = cw[2048 + ch], cw3 = cw[3072 + ch], cb = F.in[6][ch];
    const float ba = F.in[8][ch], bi = F.in[10][ch], sp = softplusf_(-F.in[11][ch]);
    bf16x8 bw[8][2];
    const bf16_t* Bt = WSP(bf16_t, WS_LRUW) + blk * 128 * 64;
#pragma unroll
    for (int nf = 0; nf < 8; ++nf)
#pragma unroll
        for (int ks = 0; ks < 2; ++ks) bw[nf][ks] = *(const bf16x8*)(Bt + (16 * nf + fr) * 64 + 32 * ks + 8 * fq);
    float hchunk = 0.f;
    for (int n = 0; n < NCH; ++n) {
        const int t0 = b * SEQ + n * CH + 16 * s;
        float xr[19];
#pragma unroll
        for (int i = 0; i < 19; ++i) { const int tt = t0 - 3 + i; const bool ok = (i >= 3) || (n > 0) || (s > 0);
            xr[i] = ok ? bf2f(proj[(size_t)tt * EVEN_IN + P0_XA + ch]) : 0.f; }
        float xc[16];
#pragma unroll
        for (int t = 0; t < 16; ++t) { xc[t] = cb + cw0 * xr[t] + cw1 * xr[t + 1] + cw2 * xr[t + 2] + cw3 * xr[t + 3]; Aimg[t * 72 + c] = (short)f2bf(xc[t]); }
        f32x4 acc[8];
#pragma unroll
        for (int nf = 0; nf < 8; ++nf) acc[nf] = (f32x4){0.f, 0.f, 0.f, 0.f};
#pragma unroll
        for (int ks = 0; ks < 2; ++ks) { const bf16x8 a = *(const LAS bf16x8*)(Aimg + fr * 72 + 32 * ks + 8 * fq);
#pragma unroll
            for (int nf = 0; nf < 8; ++nf) acc[nf] = MFMA16(a, bw[nf][ks], acc[nf]); }
#pragma unroll
        for (int nf = 0; nf < 8; ++nf)
#pragma unroll
            for (int r = 0; r < 4; ++r) PRE[((nf >> 2) * 16 + 4 * fq + r) * 65 + 16 * (nf & 3) + fr] = acc[nf][r];
        float hl[16], pp[16]; float P = 1.f, hh = 0.f;
#pragma unroll
        for (int t = 0; t < 16; ++t) {
            const float rg = sigmoidf_(PRE[t * 65 + c] + ba), ig = sigmoidf_(PRE[(16 + t) * 65 + c] + bi);
            const float la = -8.f * rg * sp, a = expf(la), mult = sqrtf(-expm1f(2.f * la)), u = mult * (ig * xc[t]);
            hh = a * hh + u; P = P * a; hl[t] = hh; pp[t] = P;
        }
        LAS float* ex = EXCH + (n & 1) * 1024;
        ex[(s * 64 + c) * 2] = P; ex[(s * 64 + c) * 2 + 1] = hh;
        __syncthreads();
        float carry = hchunk, run = hchunk;
#pragma unroll
        for (int s2 = 0; s2 < 8; ++s2) { const float A2 = ex[(s2 * 64 + c) * 2], H2 = ex[(s2 * 64 + c) * 2 + 1]; run = A2 * run + H2; if (s2 + 1 == s) carry = run; }
        if (s == 0) carry = hchunk;
        hchunk = run;
#pragma unroll
        for (int t = 0; t < 16; ++t) { const float hv = hl[t] + pp[t] * carry; bf16_t* gp = proj + (size_t)(t0 + t) * EVEN_IN + P0_GA + ch;
            const float ga = bf2f(*gp); const float yv = gelu_tanh(ga) * hv; if (!DRY || yv == 1.2345e30f) *gp = (bf16_t)f2bf(yv); }
    }
    __syncthreads();
}

template <bool DRY = false>
DI void lru2_unit(const Frame& F, int unit) {
    const int half = unit & 1, blk = (unit >> 1) & 15, b = unit >> 5;
    const int lane = F.lane, c32 = lane & 31, th = lane >> 5, s = F.wave, fr = lane & 15, fq = lane >> 4, seg = 2 * s + th;
    const int chA = blk * 64 + c32, chB = chA + 32, cho = blk * 64 + half * 32 + c32;
    bf16_t* proj = WSP(bf16_t, WS_PROJ);
    LAS short* Aimg = (LAS short*)(F.lds + s * 16384);
    LAS float* PRE = (LAS float*)(F.lds + s * 16384 + 4608);
    LAS float* EXCH = (LAS float*)(F.lds + 8 * 16384);
    const float* cw = F.in[5];
    const float wA0 = cw[chA], wA1 = cw[1024 + chA], wA2 = cw[2048 + chA], wA3 = cw[3072 + chA], bA = F.in[6][chA];
    const float wB0 = cw[chB], wB1 = cw[1024 + chB], wB2 = cw[2048 + chB], wB3 = cw[3072 + chB], bB = F.in[6][chB];
    const float ba = F.in[8][cho], bi = F.in[10][cho], sp8 = -8.f * softplusf_(-F.in[11][cho]);
    bf16x8 bw[4][2];
    const bf16_t* Bt = WSP(bf16_t, WS_LRUW) + blk * 128 * 64;
#pragma unroll
    for (int nf = 0; nf < 4; ++nf)
#pragma unroll
        for (int ks = 0; ks < 2; ++ks) bw[nf][ks] = *(const bf16x8*)(Bt + ((nf >> 1) * 64 + half * 32 + 16 * (nf & 1) + fr) * 64 + 32 * ks + 8 * fq);
    unsigned short rA[19], rB[19], rG[16];
#define LRU2_LOAD(n_) do { const int t0_ = b * SEQ + (n_) * 256 + 32 * s + 16 * th; const bool first_ = ((n_) == 0) && (seg == 0); \
        _Pragma("unroll") for (int i = 0; i < 19; ++i) { const bf16_t* p_ = proj + (size_t)(t0_ - 3 + i) * EVEN_IN + P0_XA; const bool ok_ = (i >= 3) || !first_; rA[i] = ok_ ? p_[chA] : (unsigned short)0; rB[i] = ok_ ? p_[chB] : (unsigned short)0; } \
        _Pragma("unroll") for (int t = 0; t < 16; ++t) rG[t] = proj[(size_t)(t0_ + t) * EVEN_IN + P0_GA + cho]; } while (0)
    LRU2_LOAD(0);
    float hchunk = 0.f;
#pragma unroll 1
    for (int n = 0; n < 8; ++n) {
        const int t0 = b * SEQ + n * 256 + 32 * s + 16 * th;
        float xa[19], xb[19], ga[16];
#pragma unroll
        for (int i = 0; i < 19; ++i) { xa[i] = bf2f(rA[i]); xb[i] = bf2f(rB[i]); }
#pragma unroll
        for (int t = 0; t < 16; ++t) ga[t] = bf2f(rG[t]);
        if (n + 1 < 8) LRU2_LOAD(n + 1);
        float xc[16];
#pragma unroll
        for (int t = 0; t < 16; ++t) { const float ca = bA + wA0 * xa[t] + wA1 * xa[t + 1] + wA2 * xa[t + 2] + wA3 * xa[t + 3], cb2 = bB + wB0 * xb[t] + wB1 * xb[t + 1] + wB2 * xb[t + 2] + wB3 * xb[t + 3];
            Aimg[(th * 16 + t) * 72 + c32] = (short)f2bf(ca); Aimg[(th * 16 + t) * 72 + 32 + c32] = (short)f2bf(cb2); xc[t] = half ? cb2 : ca; }
#pragma unroll
        for (int tile = 0; tile < 2; ++tile) {
            f32x4 acc[4];
#pragma unroll
            for (int nf = 0; nf < 4; ++nf) acc[nf] = (f32x4){0.f, 0.f, 0.f, 0.f};
#pragma unroll
            for (int ks = 0; ks < 2; ++ks) { const bf16x8 a = *(const LAS bf16x8*)(Aimg + (tile * 16 + fr) * 72 + 32 * ks + 8 * fq);
#pragma unroll
                for (int nf = 0; nf < 4; ++nf) acc[nf] = MFMA16(a, bw[nf][ks], acc[nf]); }
#pragma unroll
            for (int nf = 0; nf < 4; ++nf)
#pragma unroll
                for (int r = 0; r < 4; ++r) PRE[((tile * 2 + (nf >> 1)) * 16 + 4 * fq + r) * 33 + 16 * (nf & 1) + fr] = acc[nf][r];
        }
        float hl[16], pp[16]; float P = 1.f, hh = 0.f;
#pragma unroll
        for (int t = 0; t < 16; ++t) {
            const float rg = sigmoidf_(PRE[((th * 2 + 0) * 16 + t) * 33 + c32] + ba), ig = sigmoidf_(PRE[((th * 2 + 1) * 16 + t) * 33 + c32] + bi);
            const float a = __expf(rg * sp8), mult = __builtin_amdgcn_sqrtf(fmaxf(1.f - a * a, 0.f)), u = mult * (ig * xc[t]);
            hh = a * hh + u; P = P * a; hl[t] = hh; pp[t] = P;
        }
        LAS float* ex = EXCH + (n & 1) * 1024;
        ex[(seg * 32 + c32) * 2] = P; ex[(seg * 32 + c32) * 2 + 1] = hh;
        __syncthreads();
        float carry = hchunk, run = hchunk;
#pragma unroll
        for (int s2 = 0; s2 < 16; ++s2) { const float A2 = ex[(s2 * 32 + c32) * 2], H2 = ex[(s2 * 32 + c32) * 2 + 1]; carry = (s2 == seg) ? run : carry; run = A2 * run + H2; }
        hchunk = run;
#pragma unroll
        for (int t = 0; t < 16; ++t) { const float hv = hl[t] + pp[t] * carry; const float yv = gelu_tanh(ga[t]) * hv;
            if (!DRY || yv == 1.2345e30f) proj[(size_t)(t0 + t) * EVEN_IN + P0_GA + cho] = (bf16_t)f2bf(yv); }
    }
#undef LRU2_LOAD
    __syncthreads();
}

template <bool DRY = false>
DI void ret_scan(const Frame& F) {
    f32x4* st = WSP(f32x4, WS_STATES);
    const int gt = F.gw * 64 + F.lane, NGT = F.NGW * 64;
    for (int i = gt; i < 32 * 16384; i += NGT) {
        const int bh = i >> 14, e = i & 16383, h = bh & 3;
        const float cd = expf(ret_lg(h) * 128.f);
        f32x4 run = (f32x4){0.f, 0.f, 0.f, 0.f};
        f32x4* p = st + (size_t)bh * 16 * 16384 + e;
        f32x4 tmp[16];
#pragma unroll
        for (int n = 0; n < 16; ++n) tmp[n] = p[(size_t)n * 16384];
#pragma unroll
        for (int n = 0; n < 16; ++n) { if (!DRY || run[0] == 1.2345e30f) p[(size_t)n * 16384] = run; run = run * cd + tmp[n]; }
    }
}

template <bool DRY = false>
DI void ret_out_unit(const Frame& F, int unit) {
    const int b = unit >> 6, h = (unit >> 4) & 3, n = unit & 15;
    const int tok0 = b * SEQ + n * CH;
    bf16_t* proj = WSP(bf16_t, WS_PROJ);
    LAS short* R0 = (LAS short*)F.lds; LAS short* R1 = R0 + 128 * LDQ;
    int tid = F.tid; asm volatile("" : "+v"(tid));
    const int w = F.wave, lane = tid & 63, fr = lane & 15, fq = lane >> 4;
    const float lg = ret_lg(h);
    stage_128x256(R0, proj + (size_t)tok0 * EVEN_IN + P0_Q + h * 256, EVEN_IN, tid, nullptr);
    stage_128x256(R1, proj + (size_t)tok0 * EVEN_IN + P0_K + h * 256, EVEN_IN, tid, nullptr);
    __syncthreads();
    f32x4 accS[8];
#pragma unroll
    for (int nf = 0; nf < 8; ++nf) accS[nf] = (f32x4){0.f, 0.f, 0.f, 0.f};
#pragma unroll
    for (int ks = 0; ks < 8; ++ks) { const bf16x8 a = frag_row(R0, LDQ, 16 * w, 32 * ks, lane);
#pragma unroll
        for (int nf = 0; nf < 8; ++nf) { const bf16x8 bb = frag_row(R1, LDQ, 16 * nf, 32 * ks, lane); accS[nf] = MFMA16(a, bb, accS[nf]); }
        pin(accS); }
    __syncthreads();
    f32x4 accY[16];
#pragma unroll
    for (int nf = 0; nf < 16; ++nf) accY[nf] = (f32x4){0.f, 0.f, 0.f, 0.f};
    const float* prev = WSP(float, WS_STATES) + (size_t)unit * 65536;
    for (int half = 0; half < 2; ++half) {
#pragma unroll
        for (int i = 0; i < 16; ++i) { const int cidx = tid + 512 * i, row = cidx >> 6, c4 = cidx & 63;
            const f32x4 v = *(const f32x4*)(prev + (size_t)(128 * half + row) * 256 + c4 * 4);
            u32x2 o; o.x = pk2(v[0], v[1]); o.y = pk2(v[2], v[3]); *(LAS u32x2*)(R1 + row * LDQ + c4 * 4) = o;
            if ((i & 7) == 7) asm volatile("" ::: "memory"); }
        __syncthreads();
#pragma unroll
        for (int ks = 0; ks < 4; ++ks) { const bf16x8 a = frag_row(R0, LDQ, 16 * w, 128 * half + 32 * ks, lane);
#pragma unroll
            for (int nf = 0; nf < 16; ++nf) { const bf16x8 bb = frag_tr(R1, LDQ, 16 * nf, 32 * ks, lane); accY[nf] = MFMA16(a, bb, accY[nf]); }
            pin(accY); }
        __syncthreads();
    }
    LAS short* Simg = R0;
#pragma unroll
    for (int nf = 0; nf < 8; ++nf) { const int j = 16 * nf + fr; const float dj = expf(-lg * (float)(j + 1));
#pragma unroll
        for (int r = 0; r < 4; ++r) { const int i = 16 * w + 4 * fq + r; const float v = (j <= i) ? accS[nf][r] * dj : 0.f; Simg[i * 136 + j] = (short)f2bf(v); } }
    stage_128x256(R1, proj + (size_t)tok0 * EVEN_IN + P0_V + h * 256, EVEN_IN, tid, nullptr);
    __syncthreads();
#pragma unroll
    for (int ks = 0; ks < 4; ++ks) { const bf16x8 a = frag_row(Simg, 136, 16 * w, 32 * ks, lane);
#pragma unroll
        for (int nf = 0; nf < 16; ++nf) { const bf16x8 bb = frag_tr(R1, LDQ, 16 * nf, 32 * ks, lane); accY[nf] = MFMA16(a, bb, accY[nf]); }
        pin(accY); }
#pragma unroll
    for (int r = 0; r < 4; ++r) { const int i = 16 * w + 4 * fq + r; const float di = expf(lg * (float)(i + 1));
        float ss = 0.f;
#pragma unroll
        for (int nf = 0; nf < 16; ++nf) { const float v = accY[nf][r] * di; accY[nf][r] = v; ss += v * v; }
        ss = row16_sum(ss);
        const float rn = rsqrtf(ss * (1.f / 256.f) + EPS);
        bf16_t* gp = proj + (size_t)(tok0 + i) * EVEN_IN + P0_GB + h * 256 + fr;
#pragma unroll
        for (int nf = 0; nf < 16; ++nf) { const float gb = bf2f(gp[16 * nf]); const float yv = siluf_(gb) * accY[nf][r] * rn; if (!DRY || yv == 1.2345e30f) gp[16 * nf] = (bf16_t)f2bf(yv); } }
    __syncthreads();
}


#define LBAR() do { asm volatile("s_waitcnt lgkmcnt(0)" ::: "memory"); __builtin_amdgcn_s_barrier(); asm volatile("" ::: "memory"); } while (0)
struct Tile { u32x4 v[8]; };
DI void tile_issue(Tile& T, const bf16_t* src, unsigned ldg, int tid) {
#pragma unroll
    for (int i = 0; i < 8; ++i) { const unsigned c = (unsigned)tid + 512u * i; T.v[i] = *(const u32x4*)(src + ((c >> 5) * ldg + (c & 31u) * 8u)); }
}
DI void tile_commit(LAS short* img, const Tile& T, int tid) {
#pragma unroll
    for (int i = 0; i < 8; ++i) { const unsigned c = (unsigned)tid + 512u * i; *(LAS u32x4*)(img + (c >> 5) * LDQ + (c & 31u) * 8) = T.v[i]; }
}
DI void tile_commit_scaled(LAS short* img, const Tile& T, int tid, float lg) {
#pragma unroll
    for (int i = 0; i < 8; ++i) { const unsigned c = (unsigned)tid + 512u * i; const float s = __expf(lg * (float)(127 - (int)(c >> 5))); u32x4 w = T.v[i];
        w.x = pk2(bflo(w.x) * s, bfhi(w.x) * s); w.y = pk2(bflo(w.y) * s, bfhi(w.y) * s); w.z = pk2(bflo(w.z) * s, bfhi(w.z) * s); w.w = pk2(bflo(w.w) * s, bfhi(w.w) * s);
        *(LAS u32x4*)(img + (c >> 5) * LDQ + (c & 31u) * 8) = w; }
}
constexpr size_t WS_KV16 = WS_STATES, WS_PREV16 = WS_STATES + 64 * MiB;
DI void ret_kv2_phase(const Frame& F) {
    const bf16_t* proj = WSP(bf16_t, WS_PROJ);
    LAS short* Kimg = (LAS short*)F.lds; LAS short* Vimg = Kimg + 128 * LDQ;
    int tid = F.tid; asm volatile("" : "+v"(tid));
    const int w = F.wave, lane = tid & 63, dm = w >> 2, en = w & 3, fr = lane & 15, fq = lane >> 4;
    Tile TK, TV;
    const bool al = (F.G == 256); int rnd = 0;
#define RKV_UNIT(r_) (al ? ((F.vcu >> 5) * 64 + (F.vcu & 31) + 32 * (r_)) : (F.vcu + F.G * (r_)))
#define RKV_MORE(r_) (al ? ((r_) < 2) : (F.vcu + F.G * (r_) < 512))
    int unit = RKV_UNIT(0);
    if (!RKV_MORE(0)) return;
    { const int b = unit >> 6, h = (unit >> 4) & 3, n = unit & 15; const bf16_t* base = proj + (size_t)(b * SEQ + n * CH) * EVEN_IN + h * 256;
      tile_issue(TK, base + P0_K, EVEN_IN, tid); tile_issue(TV, base + P0_V, EVEN_IN, tid); }
    for (;;) {
        const int h = (unit >> 4) & 3;
        tile_commit(Kimg, TK, tid); tile_commit_scaled(Vimg, TV, tid, ret_lg(h));
        LBAR();
        const bool more = RKV_MORE(rnd + 1); const int nxt = RKV_UNIT(rnd + 1);
        if (more) { const int b = nxt >> 6, h2 = (nxt >> 4) & 3, n = nxt & 15; const bf16_t* base = proj + (size_t)(b * SEQ + n * CH) * EVEN_IN + h2 * 256;
            tile_issue(TK, base + P0_K, EVEN_IN, tid); tile_issue(TV, base + P0_V, EVEN_IN, tid); }
        bf16_t* st = WSP(bf16_t, WS_KV16) + (size_t)unit * 65536;
#pragma unroll 1
        for (int mh = 0; mh < 2; ++mh) {
            f32x4 acc[4][4];
#pragma unroll
            for (int m = 0; m < 4; ++m)
#pragma unroll
                for (int nn = 0; nn < 4; ++nn) acc[m][nn] = (f32x4){0.f, 0.f, 0.f, 0.f};
#pragma unroll
            for (int ks = 0; ks < 4; ++ks) {
                bf16x8 bfr[4];
#pragma unroll
                for (int nn = 0; nn < 4; ++nn) bfr[nn] = frag_tr(Vimg, LDQ, 64 * en + 16 * nn, 32 * ks, lane);
#pragma unroll
                for (int m = 0; m < 4; ++m) { const bf16x8 a = frag_tr(Kimg, LDQ, 128 * dm + 64 * mh + 16 * m, 32 * ks, lane);
#pragma unroll
                    for (int nn = 0; nn < 4; ++nn) acc[m][nn] = MFMA16(a, bfr[nn], acc[m][nn]); }
            }
#pragma unroll
            for (int m = 0; m < 4; ++m)
#pragma unroll
                for (int nn = 0; nn < 4; ++nn) { u32x2 o; o.x = pk2(acc[m][nn][0], acc[m][nn][1]); o.y = pk2(acc[m][nn][2], acc[m][nn][3]);
                    *(u32x2*)(st + (64 * en + 16 * nn + fr) * 256 + 128 * dm + 64 * mh + 16 * m + 4 * fq) = o; }
        }
        if (!more) break;
        unit = nxt; ++rnd;
        LBAR();
    }
    LBAR();
#undef RKV_UNIT
#undef RKV_MORE
}
template <bool DRY = false>
DI void ret_scan2(const Frame& F) {
    const u32x4* kv = WSP(u32x4, WS_KV16); u32x4* pv = WSP(u32x4, WS_PREV16);
    const bool al = (F.G == 256);
    const int gt = al ? (F.vcu >> 5) * 32768 + ((F.vcu & 31) * NWAVES + F.wave) * 64 + F.lane : F.gw * 64 + F.lane, NGT = al ? 16384 : F.NGW * 64, iend = al ? ((F.vcu >> 5) + 1) * 32768 : 32 * 8192;
    for (int i = gt; i < iend; i += NGT) {
        const int bh = i >> 13, e = i & 8191, h = bh & 3;
        const float cd = expf(ret_lg(h) * 128.f);
        float run[8];
#pragma unroll
        for (int k = 0; k < 8; ++k) run[k] = 0.f;
        const size_t base = (size_t)bh * 16 * 8192 + e;
        u32x4 tmp[16];
#pragma unroll
        for (int n = 0; n < 16; ++n) tmp[n] = kv[base + (size_t)n * 8192];
#pragma unroll
        for (int n = 0; n < 16; ++n) { u32x4 o; o.x = pk2(run[0], run[1]); o.y = pk2(run[2], run[3]); o.z = pk2(run[4], run[5]); o.w = pk2(run[6], run[7]);
            if (!DRY || run[0] == 1.2345e30f) pv[base + (size_t)n * 8192] = o;
            const u32x4 t = tmp[n];
            run[0] = run[0] * cd + bflo(t.x); run[1] = run[1] * cd + bfhi(t.x); run[2] = run[2] * cd + bflo(t.y); run[3] = run[3] * cd + bfhi(t.y);
            run[4] = run[4] * cd + bflo(t.z); run[5] = run[5] * cd + bfhi(t.z); run[6] = run[6] * cd + bflo(t.w); run[7] = run[7] * cd + bfhi(t.w); }
    }
}
template <bool DRY = false>
DI void ret_out2_unit(const Frame& F, int unit) {
    const int b = unit >> 6, h = (unit >> 4) & 3, n = unit & 15;
    const int tok0 = b * SEQ + n * CH;
    bf16_t* proj = WSP(bf16_t, WS_PROJ);
    LAS short* R0 = (LAS short*)F.lds; LAS short* R1 = R0 + 128 * LDQ;
    int tid = F.tid; asm volatile("" : "+v"(tid));
    const int w = F.wave, lane = tid & 63, fr = lane & 15, fq = lane >> 4;
    const float lg = ret_lg(h);
    const bf16_t* pbase = proj + (size_t)tok0 * EVEN_IN + h * 256;
    const bf16_t* prevT = WSP(bf16_t, WS_PREV16) + (size_t)unit * 65536;
    Tile TA, TB;
    tile_issue(TA, pbase + P0_Q, EVEN_IN, tid); tile_issue(TB, pbase + P0_K, EVEN_IN, tid);
    tile_commit(R0, TA, tid); tile_commit(R1, TB, tid);
    LBAR();
    tile_issue(TA, prevT, 256, tid);
    f32x4 accS[8];
#pragma unroll
    for (int nf = 0; nf < 8; ++nf) accS[nf] = (f32x4){0.f, 0.f, 0.f, 0.f};
#pragma unroll
    for (int ks = 0; ks < 8; ++ks) { const bf16x8 a = frag_row(R0, LDQ, 16 * w, 32 * ks, lane);
#pragma unroll
        for (int nf = 0; nf < 8; ++nf) { const bf16x8 bb = frag_row(R1, LDQ, 16 * nf, 32 * ks, lane); accS[nf] = MFMA16(a, bb, accS[nf]); }
        pin(accS); }
    LBAR();
    tile_commit(R1, TA, tid);
    LBAR();
    tile_issue(TA, prevT + 128 * 256, 256, tid);
    f32x4 accY[16];
#pragma unroll
    for (int nf = 0; nf < 16; ++nf) accY[nf] = (f32x4){0.f, 0.f, 0.f, 0.f};
#pragma unroll
    for (int ks = 0; ks < 8; ++ks) { const bf16x8 a = frag_row(R0, LDQ, 16 * w, 32 * ks, lane);
#pragma unroll
        for (int nf = 0; nf < 8; ++nf) { const bf16x8 bb = frag_row(R1, LDQ, 16 * nf, 32 * ks, lane); accY[nf] = MFMA16(a, bb, accY[nf]); }
        pin(accY); }
    LBAR();
    tile_commit(R1, TA, tid);
    LBAR();
    tile_issue(TA, pbase + P0_V, EVEN_IN, tid);
#pragma unroll
    for (int ks = 0; ks < 8; ++ks) { const bf16x8 a = frag_row(R0, LDQ, 16 * w, 32 * ks, lane);
#pragma unroll
        for (int nf = 0; nf < 8; ++nf) { const bf16x8 bb = frag_row(R1, LDQ, 16 * nf, 32 * ks, lane); accY[8 + nf] = MFMA16(a, bb, accY[8 + nf]); }
        pin(accY); }
    LBAR();
    LAS short* Simg = R0;
#pragma unroll
    for (int nf = 0; nf < 8; ++nf) { const int j = 16 * nf + fr; const float dj = __expf(-lg * (float)(j + 1));
#pragma unroll
        for (int r = 0; r < 4; ++r) { const int i = 16 * w + 4 * fq + r; const float v = (j <= i) ? accS[nf][r] * dj : 0.f; Simg[i * 136 + j] = (short)f2bf(v); } }
    tile_commit(R1, TA, tid);
    LBAR();
    tile_issue(TA, pbase + P0_GB, EVEN_IN, tid);
#pragma unroll
    for (int ks = 0; ks < 4; ++ks) { const bf16x8 a = frag_row(Simg, 136, 16 * w, 32 * ks, lane);
#pragma unroll
        for (int nf = 0; nf < 16; ++nf) { const bf16x8 bb = frag_tr(R1, LDQ, 16 * nf, 32 * ks, lane); accY[nf] = MFMA16(a, bb, accY[nf]); }
        pin(accY); }
    LBAR();
#pragma unroll
    for (int r = 0; r < 4; ++r) { const int i = 16 * w + 4 * fq + r; const float di = __expf(lg * (float)(i + 1));
        float ss = 0.f;
#pragma unroll
        for (int nf = 0; nf < 16; ++nf) { const float v = accY[nf][r] * di; accY[nf][r] = v; ss += v * v; }
        ss = row16_sum(ss);
        const float rn = rsqrtf(ss * (1.f / 256.f) + EPS);
#pragma unroll
        for (int nf = 0; nf < 16; ++nf) R1[i * LDQ + 16 * nf + fr] = (short)f2bf(accY[nf][r] * rn); }
    LBAR();
#pragma unroll
    for (int i = 0; i < 8; ++i) { const unsigned c = (unsigned)tid + 512u * i, row = c >> 5, ch = c & 31u;
        const u32x4 g = TA.v[i]; const u32x4 y = *(const LAS u32x4*)(R1 + row * LDQ + ch * 8);
        u32x4 o; o.x = pk2(siluf_(bflo(g.x)) * bflo(y.x), siluf_(bfhi(g.x)) * bfhi(y.x)); o.y = pk2(siluf_(bflo(g.y)) * bflo(y.y), siluf_(bfhi(g.y)) * bfhi(y.y));
        o.z = pk2(siluf_(bflo(g.z)) * bflo(y.z), siluf_(bfhi(g.z)) * bfhi(y.z)); o.w = pk2(siluf_(bflo(g.w)) * bflo(y.w), siluf_(bfhi(g.w)) * bfhi(y.w));
        if (!DRY || o.x == 0x12345678u) *(u32x4*)(proj + (size_t)(tok0 + row) * EVEN_IN + P0_GB + h * 256 + ch * 8) = o; }
    LBAR();
}

DI void peer_topk_unit(const Frame& F, int layer, int wu) {
    const int t0 = wu * 16, lane = F.lane, fr = lane & 15, fq = lane >> 4, tl = lane >> 2, qq = lane & 3;
    const bf16_t* Q = WSP(bf16_t, WS_Q); const bf16_t* KEYS = WSP(bf16_t, WS_KEYS) + (size_t)layer * 8 * 2 * 128 * 64;
    LAS float* SC = (LAS float*)(F.lds + F.wave * 16384);
    LAS float* TV = SC + 16 * 132;
    LAS int* TI = (LAS int*)(TV + 512);
    int* EIDX = WSP(int, WS_EIDX); float* GATE = WSP(float, WS_GATE);
    for (int hp = 0; hp < 16; ++hp) {
        f32x4 acc[8];
#pragma unroll
        for (int nf = 0; nf < 8; ++nf) acc[nf] = (f32x4){0.f, 0.f, 0.f, 0.f};
#pragma unroll
        for (int ks = 0; ks < 2; ++ks) { const bf16x8 a = *(const bf16x8*)(Q + (size_t)(t0 + fr) * 1024 + hp * 64 + 32 * ks + 8 * fq);
#pragma unroll
            for (int nf = 0; nf < 8; ++nf) { const bf16x8 bb = *(const bf16x8*)(KEYS + ((size_t)hp * 128 + 16 * nf + fr) * 64 + 32 * ks + 8 * fq); acc[nf] = MFMA16(a, bb, acc[nf]); } }
#pragma unroll
        for (int nf = 0; nf < 8; ++nf)
#pragma unroll
            for (int r = 0; r < 4; ++r) SC[(4 * fq + r) * 132 + 16 * nf + fr] = acc[nf][r];
        float vals[32];
#pragma unroll
        for (int i = 0; i < 32; ++i) vals[i] = SC[tl * 132 + 4 * i + qq];
        const int p = hp & 1;
#pragma unroll 1
        for (int rd = 0; rd < 16; ++rd) {
            float bv = vals[0]; int bi = 0;
#pragma unroll
            for (int i = 1; i < 32; ++i) { if (vals[i] > bv) { bv = vals[i]; bi = i; } }
            int bn = 4 * bi + qq;
#pragma unroll
            for (int o = 1; o < 4; o <<= 1) { const float ov = __shfl_xor(bv, o); const int on = __shfl_xor(bn, o); if (ov > bv || (ov == bv && on < bn)) { bv = ov; bn = on; } }
            const int wi = (bn & 3) == qq ? (bn >> 2) : -1;
#pragma unroll
            for (int i = 0; i < 32; ++i) vals[i] = (i == wi) ? -INFINITY : vals[i];
            if (qq == 0) { TV[(p * 16 + tl) * 16 + rd] = bv; TI[(p * 16 + tl) * 16 + rd] = bn; }
        }
        if (p == 1) {
            float cv[13]; int cij[13];
#pragma unroll
            for (int k = 0; k < 13; ++k) { cv[k] = -INFINITY; cij[k] = 255; }
            {
                int cnt = 0;
#pragma unroll
                for (int i = 0; i < 16; ++i)
#pragma unroll
                    for (int j = 0; j < 16; ++j) if ((i + 1) * (j + 1) <= 16) {
                        const float v = TV[(0 * 16 + tl) * 16 + i] + TV[(1 * 16 + tl) * 16 + j];
                        if (qq == (cnt & 3)) { cv[cnt >> 2] = v; cij[cnt >> 2] = i * 16 + j; }
                        ++cnt; }
            }
            float best[16]; int bidx[16];
#pragma unroll
            for (int rd = 0; rd < 16; ++rd) {
                float bv = cv[0]; int bk = 0;
#pragma unroll
                for (int k = 1; k < 13; ++k) { if (cv[k] > bv || (cv[k] == bv && cij[k] < cij[bk])) { bv = cv[k]; bk = k; } }
                int bc = cij[0];
#pragma unroll
                for (int k = 1; k < 13; ++k) bc = (k == bk) ? cij[k] : bc;
                int own = qq;
#pragma unroll
                for (int o = 1; o < 4; o <<= 1) { const float ov = __shfl_xor(bv, o); const int oc = __shfl_xor(bc, o); const int oo = __shfl_xor(own, o); if (ov > bv || (ov == bv && oc < bc)) { bv = ov; bc = oc; own = oo; } }
#pragma unroll
                for (int k = 0; k < 13; ++k) cv[k] = (own == qq && cij[k] == bc) ? -INFINITY : cv[k];
                best[rd] = bv; bidx[rd] = bc;
            }
            float sum = 0.f; float ex[16];
#pragma unroll
            for (int rd = 0; rd < 16; ++rd) { ex[rd] = __expf(best[rd] - best[0]); sum += ex[rd]; }
            const float inv = 1.f / sum;
            if (qq == 0) {
                const int hh = hp >> 1; const size_t o = (size_t)(t0 + tl) * 128 + hh * 16;
#pragma unroll
                for (int rd = 0; rd < 16; ++rd) { const int i = bidx[rd] >> 4, j = bidx[rd] & 15;
                    EIDX[o + rd] = TI[(0 * 16 + tl) * 16 + i] * 128 + TI[(1 * 16 + tl) * 16 + j]; GATE[o + rd] = ex[rd] * inv; }
            }
        }
    }
}

DI int f2ord(float f) { const int b = __builtin_bit_cast(int, f); return b ^ ((b >> 31) & 0x7fffffff); }
DI float ord2f(int o) { return __builtin_bit_cast(float, o ^ ((o >> 31) & 0x7fffffff)); }
#define CE_DESC(a, b) do { const int mx_ = max((a), (b)), mn_ = min((a), (b)); (a) = mx_; (b) = mn_; } while (0)
template <int N> DI void bitonic_sort_desc(int (&v)[N]) {
#pragma unroll
    for (int k = 2; k <= N; k <<= 1)
#pragma unroll
        for (int j = k >> 1; j > 0; j >>= 1)
#pragma unroll
            for (int i = 0; i < N; ++i) { const int l = i ^ j; if (l > i) { if ((i & k) == 0 || k == N) CE_DESC(v[i], v[l]); else CE_DESC(v[l], v[i]); } }
}
template <int N> DI void batcher_sort_desc(int (&v)[N]) {
#pragma unroll
    for (int p = 1; p < N; p <<= 1)
#pragma unroll
        for (int k = p; k >= 1; k >>= 1)
#pragma unroll
            for (int j = k % p; j <= N - 1 - k; j += 2 * k)
#pragma unroll
                for (int i = 0; i <= ((k - 1 < N - j - k - 1) ? k - 1 : N - j - k - 1); ++i)
                    if ((i + j) / (2 * p) == (i + j + k) / (2 * p)) CE_DESC(v[i + j], v[i + j + k]);
}
template <int N> DI void bitonic_merge_desc(int (&v)[N]) {
#pragma unroll
    for (int j = N >> 1; j > 0; j >>= 1)
#pragma unroll
        for (int i = 0; i < N; ++i) { const int l = i ^ j; if (l > i) CE_DESC(v[i], v[l]); }
}
template <int CTRL> DI void quad_merge16(int (&v)[16]) {
    int z[16];
#pragma unroll
    for (int k = 0; k < 16; ++k) z[k] = max(v[k], __builtin_amdgcn_mov_dpp(v[15 - k], CTRL, 0xf, 0xf, true));
    bitonic_merge_desc<16>(z);
#pragma unroll
    for (int k = 0; k < 16; ++k) v[k] = z[k];
}
DI void peer_topk2_unit(const Frame& F, int layer, int unit) {
    const int t0 = (unit >> 3) * 16, h = unit & 7, lane = F.lane, fr = lane & 15, fq = lane >> 4, tl = lane >> 2, qq = lane & 3;
    const bf16_t* Q = WSP(bf16_t, WS_Q); const bf16_t* KEYS = WSP(bf16_t, WS_KEYS) + (size_t)layer * 8 * 2 * 128 * 64;
    LAS float* SC = (LAS float*)(F.lds + F.wave * 16384);
    LAS int* IDX = (LAS int*)(SC + 16 * 132);
    int* EIDX = WSP(int, WS_EIDX); float* GATE = WSP(float, WS_GATE);
    int L[2][16];
#pragma unroll
    for (int p = 0; p < 2; ++p) {
        const int hp = 2 * h + p;
        f32x4 acc[8];
#pragma unroll
        for (int nf = 0; nf < 8; ++nf) acc[nf] = (f32x4){0.f, 0.f, 0.f, 0.f};
#pragma unroll
        for (int ks = 0; ks < 2; ++ks) { const bf16x8 a = *(const bf16x8*)(Q + (size_t)(t0 + fr) * 1024 + hp * 64 + 32 * ks + 8 * fq);
#pragma unroll
            for (int nf = 0; nf < 8; ++nf) { const bf16x8 bb = *(const bf16x8*)(KEYS + ((size_t)hp * 128 + 16 * nf + fr) * 64 + 32 * ks + 8 * fq); acc[nf] = MFMA16(a, bb, acc[nf]); } }
#pragma unroll
        for (int nf = 0; nf < 8; ++nf)
#pragma unroll
            for (int r = 0; r < 4; ++r) SC[(4 * fq + r) * 132 + 16 * nf + fr] = acc[nf][r];
        int ka[16], kb[16];
#pragma unroll
        for (int i = 0; i < 16; ++i) { ka[i] = (f2ord(SC[tl * 132 + 4 * i + qq]) & ~0x7f) | (127 - (4 * i + qq)); kb[i] = (f2ord(SC[tl * 132 + 4 * (i + 16) + qq]) & ~0x7f) | (127 - (4 * (i + 16) + qq)); }
        bitonic_sort_desc<16>(ka); bitonic_sort_desc<16>(kb);
#pragma unroll
        for (int k = 0; k < 16; ++k) ka[k] = max(ka[k], kb[15 - k]);
        bitonic_merge_desc<16>(ka);
        quad_merge16<0xB1>(ka);
        quad_merge16<0x4E>(ka);
#pragma unroll
        for (int k = 0; k < 16; ++k) L[p][k] = ka[k];
        if (qq == 0) {
#pragma unroll
            for (int k = 0; k < 16; ++k) IDX[(tl * 2 + p) * 16 + k] = 127 - (ka[k] & 0x7f);
        }
    }
    float fa[16], fb[16];
#pragma unroll
    for (int k = 0; k < 16; ++k) { fa[k] = ord2f(L[0][k] & ~0x7f); fb[k] = ord2f(L[1][k] & ~0x7f); }
    int cv[16];
#pragma unroll
    for (int k = 0; k < 16; ++k) cv[k] = (int)0x80000000;
    {
        int cnt = 0;
#pragma unroll
        for (int i = 0; i < 16; ++i)
#pragma unroll
            for (int j = 0; j < 16; ++j) if ((i + 1) * (j + 1) <= 16) {
                const int key = (f2ord(fa[i] + fb[j]) & ~0xff) | (255 - (16 * i + j));
                if (qq == (cnt & 3)) cv[cnt >> 2] = key;
                ++cnt; }
    }
    bitonic_sort_desc<16>(cv);
    quad_merge16<0xB1>(cv);
    quad_merge16<0x4E>(cv);
    const float b0 = ord2f(cv[0] & ~0xff);
    float ex[16]; float sum = 0.f;
#pragma unroll
    for (int k = 0; k < 16; ++k) { ex[k] = __expf(ord2f(cv[k] & ~0xff) - b0); sum += ex[k]; }
    const float inv = 1.f / sum;
#pragma unroll
    for (int m = 0; m < 4; ++m) {
        const int key = (qq == 0) ? cv[4 * m] : (qq == 1) ? cv[4 * m + 1] : (qq == 2) ? cv[4 * m + 2] : cv[4 * m + 3];
        const float g = ((qq == 0) ? ex[4 * m] : (qq == 1) ? ex[4 * m + 1] : (qq == 2) ? ex[4 * m + 2] : ex[4 * m + 3]) * inv;
        const int code = 255 - (key & 0xff), i = code >> 4, j = code & 15;
        const int e = IDX[(tl * 2 + 0) * 16 + i] * 128 + IDX[(tl * 2 + 1) * 16 + j];
        const size_t o = (size_t)(t0 + tl) * 128 + h * 16 + 4 * m + qq;
        EIDX[o] = e; GATE[o] = g;
    }
}

DI void peer_topk3_tile(const Frame& F, int layer, int pm, int pn, bool rider) {
    const int lane = F.lane, fr = lane & 15, fq = lane >> 4, tl = lane >> 2, qq = lane & 3, h = 2 * pn + (F.wave & 1), tg0 = 16 * pm + (F.wave >> 1);
    const bf16_t* Q = WSP(bf16_t, WS_Q); const bf16_t* KEYS = WSP(bf16_t, WS_KEYS) + (size_t)layer * 8 * 2 * 128 * 64;
    LAS float* SC = (LAS float*)(F.lds + F.wave * 16896);
    LAS int* LST = (LAS int*)(SC + 16 * 132);
    int* EIDX = WSP(int, WS_EIDX); float* GATE = WSP(float, WS_GATE);
    const int trow0 = F.vcu * NWAVES + F.wave;
    f32x4 tg[4], tva[4], tvb[4];
#pragma unroll
    for (int i = 0; i < 4; ++i) { tg[i] = (f32x4){1.f, 1.f, 1.f, 1.f}; tva[i] = (f32x4){0.f, 0.f, 0.f, 0.f}; tvb[i] = (f32x4){0.f, 0.f, 0.f, 0.f}; }
    if (rider) { const f32x4* g4 = (const f32x4*)F.in[2] + 2 * lane; tg[0] = g4[0]; tg[1] = g4[1]; tg[2] = g4[128]; tg[3] = g4[129]; }
#define TK_TLOAD(tv_, k_) do { const int tr_ = trow0 + 2048 * (k_); const float* src = (tr_ < 16384) ? F.in[23] + (size_t)tr_ * 1024 : F.in[24] + (size_t)(tr_ - 16384) * 1024; const f32x4* s4 = (const f32x4*)src + 2 * lane; \
        tv_[0] = s4[0]; tv_[1] = s4[1]; tv_[2] = s4[128]; tv_[3] = s4[129]; asm volatile("" ::: "memory"); } while (0)
#define TK_TSTORE(tv_, k_) do { const int tr_ = trow0 + 2048 * (k_); const bool isu = tr_ < 16384; const int e_ = isu ? tr_ : tr_ - 16384; const float scl = isu ? PEER_SU : PEER_SV; \
        unsigned char* dstb = (isu ? WSP(unsigned char, WS_UB) : WSP(unsigned char, WS_VB)) + (size_t)(lane >> 5) * (16384 * 128) + (size_t)e_ * 128 + 4 * (lane & 31); \
        _Pragma("unroll") for (int j = 0; j < 2; ++j) { f32x4 a4 = tv_[2 * j] * scl, b4 = tv_[2 * j + 1] * scl; if (isu) { a4 = a4 * tg[2 * j]; b4 = b4 * tg[2 * j + 1]; } \
            unsigned wq = 0; \
            wq = __builtin_amdgcn_cvt_scalef32_pk_fp4_f32(wq, a4[0], a4[1], 1.0f, 0); wq = __builtin_amdgcn_cvt_scalef32_pk_fp4_f32(wq, a4[2], a4[3], 1.0f, 1); \
            wq = __builtin_amdgcn_cvt_scalef32_pk_fp4_f32(wq, b4[0], b4[1], 1.0f, 2); wq = __builtin_amdgcn_cvt_scalef32_pk_fp4_f32(wq, b4[2], b4[3], 1.0f, 3); \
            *(unsigned*)(dstb + (size_t)j * (2 * 16384 * 128)) = wq; } } while (0)
#pragma unroll 1
    for (int p = 0; p < 2; ++p) {
        const int hp = 2 * h + p;
        bf16x8 kf[2][8];
#pragma unroll
        for (int ks = 0; ks < 2; ++ks)
#pragma unroll
            for (int nf = 0; nf < 8; ++nf) kf[ks][nf] = *(const bf16x8*)(KEYS + ((size_t)hp * 128 + 16 * nf + fr) * 64 + 32 * ks + 8 * fq);
        bf16x8 qa[2], qn[2];
#pragma unroll
        for (int ks = 0; ks < 2; ++ks) qa[ks] = *(const bf16x8*)(Q + (size_t)(tg0 * 16 + fr) * 1024 + hp * 64 + 32 * ks + 8 * fq);
        asm volatile("" ::: "memory");
#pragma unroll 1
        for (int uu = 0; uu < 4; ++uu) {
            const int tgn = tg0 + 4 * ((uu < 3) ? uu + 1 : uu);
#pragma unroll
            for (int ks = 0; ks < 2; ++ks) qn[ks] = *(const bf16x8*)(Q + (size_t)(tgn * 16 + fr) * 1024 + hp * 64 + 32 * ks + 8 * fq);
            asm volatile("" ::: "memory");
            if (rider) { TK_TLOAD(tva, 2 * (4 * p + uu)); TK_TLOAD(tvb, 2 * (4 * p + uu) + 1); }
            f32x4 acc[8];
#pragma unroll
            for (int nf = 0; nf < 8; ++nf) acc[nf] = (f32x4){0.f, 0.f, 0.f, 0.f};
#pragma unroll
            for (int ks = 0; ks < 2; ++ks)
#pragma unroll
                for (int nf = 0; nf < 8; ++nf) acc[nf] = MFMA16(qa[ks], kf[ks][nf], acc[nf]);
#pragma unroll
            for (int nf = 0; nf < 8; ++nf)
#pragma unroll
                for (int r = 0; r < 4; ++r) SC[(4 * fq + r) * 132 + 16 * nf + fr] = acc[nf][r];
            int ka[16], kb[16];
#pragma unroll
            for (int i = 0; i < 16; ++i) { ka[i] = (f2ord(SC[tl * 132 + 4 * i + qq]) & ~0x7f) | (127 - (4 * i + qq)); kb[i] = (f2ord(SC[tl * 132 + 4 * (i + 16) + qq]) & ~0x7f) | (127 - (4 * (i + 16) + qq)); }
            batcher_sort_desc<16>(ka); batcher_sort_desc<16>(kb);
#pragma unroll
            for (int k = 0; k < 16; ++k) ka[k] = max(ka[k], kb[15 - k]);
            bitonic_merge_desc<16>(ka);
            quad_merge16<0xB1>(ka);
            quad_merge16<0x4E>(ka);
            if (qq == 0) { LAS int* dst = LST + ((uu * 2 + p) * 16 + tl) * 16;
#pragma unroll
                for (int k4 = 0; k4 < 4; ++k4) *(LAS u32x4*)(dst + 4 * k4) = (u32x4){(unsigned)ka[4 * k4], (unsigned)ka[4 * k4 + 1], (unsigned)ka[4 * k4 + 2], (unsigned)ka[4 * k4 + 3]}; }
            if (rider) { TK_TSTORE(tva, 2 * (4 * p + uu)); TK_TSTORE(tvb, 2 * (4 * p + uu) + 1); }
            qa[0] = qn[0]; qa[1] = qn[1];
        }
    }
#pragma unroll 1
    for (int uu = 0; uu < 4; ++uu) {
        const int t0 = (tg0 + 4 * uu) * 16;
        const LAS int* l0 = LST + ((uu * 2 + 0) * 16 + tl) * 16; const LAS int* l1 = LST + ((uu * 2 + 1) * 16 + tl) * 16;
        float fa[16], fb[16];
#pragma unroll
        for (int k4 = 0; k4 < 4; ++k4) { const u32x4 a = *(const LAS u32x4*)(l0 + 4 * k4), bq = *(const LAS u32x4*)(l1 + 4 * k4);
            fa[4 * k4] = ord2f((int)a.x & ~0x7f); fa[4 * k4 + 1] = ord2f((int)a.y & ~0x7f); fa[4 * k4 + 2] = ord2f((int)a.z & ~0x7f); fa[4 * k4 + 3] = ord2f((int)a.w & ~0x7f);
            fb[4 * k4] = ord2f((int)bq.x & ~0x7f); fb[4 * k4 + 1] = ord2f((int)bq.y & ~0x7f); fb[4 * k4 + 2] = ord2f((int)bq.z & ~0x7f); fb[4 * k4 + 3] = ord2f((int)bq.w & ~0x7f); }
        int cv[16];
#pragma unroll
        for (int k = 0; k < 16; ++k) cv[k] = (int)0x80000000;
        {
            int cnt = 0;
#pragma unroll
            for (int i = 0; i < 16; ++i)
#pragma unroll
                for (int j = 0; j < 16; ++j) if ((i + 1) * (j + 1) <= 16) {
                    const int key = (f2ord(fa[i] + fb[j]) & ~0xff) | (255 - (16 * i + j));
                    if (qq == (cnt & 3)) cv[cnt >> 2] = key;
                    ++cnt; }
        }
        batcher_sort_desc<16>(cv);
        quad_merge16<0xB1>(cv);
        quad_merge16<0x4E>(cv);
        const float b0 = ord2f(cv[0] & ~0xff);
        float ex[16]; float sum = 0.f;
#pragma unroll
        for (int k = 0; k < 16; ++k) { ex[k] = __expf(ord2f(cv[k] & ~0xff) - b0); sum += ex[k]; }
        const float inv = frcp(sum);
#pragma unroll
        for (int m = 0; m < 4; ++m) {
            const int key = (qq == 0) ? cv[4 * m] : (qq == 1) ? cv[4 * m + 1] : (qq == 2) ? cv[4 * m + 2] : cv[4 * m + 3];
            const float g = ((qq == 0) ? ex[4 * m] : (qq == 1) ? ex[4 * m + 1] : (qq == 2) ? ex[4 * m + 2] : ex[4 * m + 3]) * inv;
            const int code = 255 - (key & 0xff), i = code >> 4, j = code & 15;
            const int e = (127 - (l0[i] & 0x7f)) * 128 + (127 - (l1[j] & 0x7f));
            const size_t o = (size_t)(t0 + tl) * 128 + h * 16 + 4 * m + qq;
            EIDX[o] = e; GATE[o] = g;
        }
    }
}
#undef TK_TLOAD
#undef TK_TSTORE

template <bool FINAL, bool DRY = false>
DI void peer_token(const Frame& F, int t) {
    const int lane = F.lane, qd = lane >> 4, li = lane & 15;
    const bf16_t* UB = WSP(bf16_t, WS_UB); const bf16_t* VB = WSP(bf16_t, WS_VB); bf16_t* XB = WSP(bf16_t, WS_XB);
    const int* EIDX = WSP(int, WS_EIDX); const float* GATE = WSP(float, WS_GATE);
    float sl = (lane < 16) ? WSP(float, WS_SLOTS)[(size_t)t * 16 + lane] : 0.f;
    const float rstd = rsqrtf(wave_sum(sl) * (1.f / 1024.f) + EPS);
    const int e0 = EIDX[(size_t)t * 128 + lane], e1 = EIDX[(size_t)t * 128 + 64 + lane];
    const float g0 = GATE[(size_t)t * 128 + lane], g1 = GATE[(size_t)t * 128 + 64 + lane];
    u32x4 xq[8];
#pragma unroll
    for (int c = 0; c < 8; ++c) xq[c] = *(const u32x4*)(XB + (size_t)t * 1024 + (c * 16 + li) * 8);
    float act[32];
#pragma unroll
    for (int g = 0; g < 32; ++g) {
        const int src = (4 * g + qd) & 63;
        const int e = __shfl((g < 16) ? e0 : e1, src);
        const float gt = __shfl((g < 16) ? g0 : g1, src);
        const bf16_t* row = UB + (size_t)e * 1024;
        float d = 0.f;
#pragma unroll
        for (int c = 0; c < 8; ++c) { const u32x4 u = *(const u32x4*)(row + (c * 16 + li) * 8);
            d = dot2bf(u.x, xq[c].x, d); d = dot2bf(u.y, xq[c].y, d); d = dot2bf(u.z, xq[c].z, d); d = dot2bf(u.w, xq[c].w, d); }
        d += __shfl_xor(d, 1); d += __shfl_xor(d, 2); d += __shfl_xor(d, 4); d += __shfl_xor(d, 8);
        act[g] = (DBG_SKIP & 1) ? 0.f : gelu_tanh(d * rstd) * gt;
    }
    float o[16];
#pragma unroll
    for (int i = 0; i < 16; ++i) o[i] = 0.f;
#pragma unroll
    for (int g = 0; g < 32; ++g) {
#pragma unroll
        for (int q4 = 0; q4 < 4; ++q4) {
            const int k = 4 * g + q4;
            const int e = __builtin_amdgcn_readlane((g < 16) ? e0 : e1, k & 63);
            const float a = __builtin_bit_cast(float, __builtin_amdgcn_readlane(__builtin_bit_cast(int, act[g]), 16 * q4));
            const bf16_t* row = VB + (size_t)e * 1024;
            const u32x4 v0 = *(const u32x4*)(row + 8 * lane), v1 = *(const u32x4*)(row + 512 + 8 * lane);
            o[0] += a * bflo(v0.x); o[1] += a * bfhi(v0.x); o[2] += a * bflo(v0.y); o[3] += a * bfhi(v0.y); o[4] += a * bflo(v0.z); o[5] += a * bfhi(v0.z); o[6] += a * bflo(v0.w); o[7] += a * bfhi(v0.w);
            o[8] += a * bflo(v1.x); o[9] += a * bfhi(v1.x); o[10] += a * bflo(v1.y); o[11] += a * bfhi(v1.y); o[12] += a * bflo(v1.z); o[13] += a * bfhi(v1.z); o[14] += a * bflo(v1.w); o[15] += a * bfhi(v1.w);
        }
    }
    float* xo = F.out + (size_t)t * 1024;
    float ss = 0.f;
#pragma unroll
    for (int hlf = 0; hlf < 2; ++hlf)
#pragma unroll
        for (int q = 0; q < 2; ++q) { const f32x4 r = *(const f32x4*)(xo + hlf * 512 + 8 * lane + 4 * q);
#pragma unroll
            for (int j = 0; j < 4; ++j) { o[hlf * 8 + q * 4 + j] += r[j]; ss += o[hlf * 8 + q * 4 + j] * o[hlf * 8 + q * 4 + j]; } }
    const float rs2 = rsqrtf(wave_sum(ss) * (1.f / 1024.f) + EPS);
    if (DRY && rs2 != -1.f) return;
    if (FINAL) {
        const float* fg = F.in[3];
#pragma unroll
        for (int hlf = 0; hlf < 2; ++hlf)
#pragma unroll
            for (int q = 0; q < 2; ++q) { const f32x4 g = *(const f32x4*)(fg + hlf * 512 + 8 * lane + 4 * q); f32x4 w;
#pragma unroll
                for (int j = 0; j < 4; ++j) w[j] = o[hlf * 8 + q * 4 + j] * rs2 * g[j];
                *(f32x4*)(xo + hlf * 512 + 8 * lane + 4 * q) = w; }
    } else {
        if (lane == 0) WSP(float, WS_RSTD)[t] = rs2;
#pragma unroll
        for (int hlf = 0; hlf < 2; ++hlf) {
#pragma unroll
            for (int q = 0; q < 2; ++q) { f32x4 w;
#pragma unroll
                for (int j = 0; j < 4; ++j) w[j] = o[hlf * 8 + q * 4 + j];
                *(f32x4*)(xo + hlf * 512 + 8 * lane + 4 * q) = w; }
            u32x4 w; w.x = pk2(o[hlf * 8 + 0], o[hlf * 8 + 1]); w.y = pk2(o[hlf * 8 + 2], o[hlf * 8 + 3]); w.z = pk2(o[hlf * 8 + 4], o[hlf * 8 + 5]); w.w = pk2(o[hlf * 8 + 6], o[hlf * 8 + 7]);
            *(u32x4*)(XB + (size_t)t * 1024 + hlf * 512 + 8 * lane) = w;
        }
    }
}

DI f32x2 fp8lo(unsigned w) { return __builtin_amdgcn_cvt_pk_f32_fp8((int)w, false); }
DI f32x2 fp8hi(unsigned w) { return __builtin_amdgcn_cvt_pk_f32_fp8((int)w, true); }
template <bool FINAL, bool DRY = false>
DI void peer_token8(const Frame& F, int t) {
    const int lane = F.lane, qd = lane >> 4, li = lane & 15;
    const unsigned char* UB = WSP(unsigned char, WS_UB); const unsigned char* VB = WSP(unsigned char, WS_VB); bf16_t* XB = WSP(bf16_t, WS_XB);
    const int* EIDX = WSP(int, WS_EIDX); const float* GATE = WSP(float, WS_GATE);
    float sl = (lane < 16) ? WSP(float, WS_SLOTS)[(size_t)t * 16 + lane] : 0.f;
    const float rstd = rsqrtf(wave_sum(sl) * (1.f / 1024.f) + EPS);
    const int e0 = EIDX[(size_t)t * 128 + lane], e1 = EIDX[(size_t)t * 128 + 64 + lane];
    const float g0 = GATE[(size_t)t * 128 + lane], g1 = GATE[(size_t)t * 128 + 64 + lane];
    f32x2 xq[4][8];
#pragma unroll
    for (int c = 0; c < 4; ++c)
#pragma unroll
        for (int hf = 0; hf < 2; ++hf) { const u32x4 w = *(const u32x4*)(XB + (size_t)t * 1024 + (c * 16 + li) * 16 + 8 * hf);
            xq[c][4 * hf + 0] = (f32x2){bflo(w.x), bfhi(w.x)}; xq[c][4 * hf + 1] = (f32x2){bflo(w.y), bfhi(w.y)}; xq[c][4 * hf + 2] = (f32x2){bflo(w.z), bfhi(w.z)}; xq[c][4 * hf + 3] = (f32x2){bflo(w.w), bfhi(w.w)}; }
    const float zs = rstd * (1.f / PEER_SU);
    float act[32];
#pragma unroll
    for (int g = 0; g < 32; ++g) {
        const int src = (4 * g + qd) & 63;
        const int e = __shfl((g < 16) ? e0 : e1, src);
        const float gt = __shfl((g < 16) ? g0 : g1, src);
        const unsigned char* row = UB + (size_t)e * 1024;
        f32x2 d2 = (f32x2){0.f, 0.f};
#pragma unroll
        for (int c = 0; c < 4; ++c) { const u32x4 u = *(const u32x4*)(row + (c * 16 + li) * 16);
            d2 += fp8lo(u.x) * xq[c][0]; d2 += fp8hi(u.x) * xq[c][1]; d2 += fp8lo(u.y) * xq[c][2]; d2 += fp8hi(u.y) * xq[c][3];
            d2 += fp8lo(u.z) * xq[c][4]; d2 += fp8hi(u.z) * xq[c][5]; d2 += fp8lo(u.w) * xq[c][6]; d2 += fp8hi(u.w) * xq[c][7]; }
        float d = d2.x + d2.y;
        d += __shfl_xor(d, 1); d += __shfl_xor(d, 2); d += __shfl_xor(d, 4); d += __shfl_xor(d, 8);
        act[g] = gelu_tanh(d * zs) * gt * (1.f / PEER_SV);
    }
    f32x2 o2[8];
#pragma unroll
    for (int i = 0; i < 8; ++i) o2[i] = (f32x2){0.f, 0.f};
#pragma unroll
    for (int g = 0; g < 32; ++g) {
#pragma unroll
        for (int q4 = 0; q4 < 4; ++q4) {
            const int k = 4 * g + q4;
            const int e = __builtin_amdgcn_readlane((g < 16) ? e0 : e1, k & 63);
            const float a = __builtin_bit_cast(float, __builtin_amdgcn_readlane(__builtin_bit_cast(int, act[g]), 16 * q4));
            const u32x4 v = *(const u32x4*)(VB + (size_t)e * 1024 + 16 * lane);
            o2[0] += fp8lo(v.x) * a; o2[1] += fp8hi(v.x) * a; o2[2] += fp8lo(v.y) * a; o2[3] += fp8hi(v.y) * a;
            o2[4] += fp8lo(v.z) * a; o2[5] += fp8hi(v.z) * a; o2[6] += fp8lo(v.w) * a; o2[7] += fp8hi(v.w) * a;
        }
    }
    float* xo = F.out + (size_t)t * 1024 + 16 * lane;
    float o[16]; float ss = 0.f;
#pragma unroll
    for (int q = 0; q < 4; ++q) { const f32x4 r = *(const f32x4*)(xo + 4 * q);
        o[4 * q + 0] = o2[2 * q].x + r[0]; o[4 * q + 1] = o2[2 * q].y + r[1]; o[4 * q + 2] = o2[2 * q + 1].x + r[2]; o[4 * q + 3] = o2[2 * q + 1].y + r[3];
#pragma unroll
        for (int j = 0; j < 4; ++j) ss += o[4 * q + j] * o[4 * q + j]; }
    const float rs2 = rsqrtf(wave_sum(ss) * (1.f / 1024.f) + EPS);
    if (DRY && rs2 != -1.f) return;
    if (FINAL) {
        const float* fg = F.in[3] + 16 * lane;
#pragma unroll
        for (int q = 0; q < 4; ++q) { const f32x4 gq = *(const f32x4*)(fg + 4 * q); f32x4 w;
#pragma unroll
            for (int j = 0; j < 4; ++j) w[j] = o[4 * q + j] * rs2 * gq[j];
            *(f32x4*)(xo + 4 * q) = w; }
    } else {
        if (lane == 0) WSP(float, WS_RSTD)[t] = rs2;
#pragma unroll
        for (int q = 0; q < 4; ++q) { f32x4 w;
#pragma unroll
            for (int j = 0; j < 4; ++j) w[j] = o[4 * q + j];
            *(f32x4*)(xo + 4 * q) = w; }
#pragma unroll
        for (int hf = 0; hf < 2; ++hf) { u32x4 w; w.x = pk2(o[8 * hf + 0], o[8 * hf + 1]); w.y = pk2(o[8 * hf + 2], o[8 * hf + 3]); w.z = pk2(o[8 * hf + 4], o[8 * hf + 5]); w.w = pk2(o[8 * hf + 6], o[8 * hf + 7]);
            *(u32x4*)(XB + (size_t)t * 1024 + 16 * lane + 8 * hf) = w; }
    }
}

template <int SEL> DI f32x2 fp4p(unsigned w) { return __builtin_amdgcn_cvt_scalef32_pk_f32_fp4(w, 1.0f, SEL); }
template <int SEL> DI bf2_t fp4b(unsigned w) { return __builtin_amdgcn_cvt_scalef32_pk_bf16_fp4(w, 1.0f, SEL); }
template <bool FINAL, bool DRY = false>
DI void peer_token4(const Frame& F, int t) {
    const int lane = F.lane, qd = lane >> 4, li = lane & 15;
    const unsigned char* UB = WSP(unsigned char, WS_UB); const unsigned char* VB = WSP(unsigned char, WS_VB); bf16_t* XB = WSP(bf16_t, WS_XB);
    const int* EIDX = WSP(int, WS_EIDX); const float* GATE = WSP(float, WS_GATE);
    float sl = (lane < 16) ? WSP(float, WS_SLOTS)[(size_t)t * 16 + lane] : 0.f;
    const float rstd = rsqrtf(wave_sum(sl) * (1.f / 1024.f) + EPS);
    const int e0 = EIDX[(size_t)t * 128 + lane], e1 = EIDX[(size_t)t * 128 + 64 + lane];
    unsigned xq[2][16];
#pragma unroll
    for (int c = 0; c < 2; ++c)
#pragma unroll
        for (int hf = 0; hf < 4; ++hf) { const u32x4 w = *(const u32x4*)(XB + (size_t)t * 1024 + (c * 16 + li) * 32 + 8 * hf);
            xq[c][4 * hf + 0] = w.x; xq[c][4 * hf + 1] = w.y; xq[c][4 * hf + 2] = w.z; xq[c][4 * hf + 3] = w.w; }
    const float zs = rstd * (1.f / PEER_SU);
    float zlo = 0.f, zhi = 0.f;
    u32x4 uA[4][2], uB[4][2];
#define PT4_ULOAD(buf, bt_) do { _Pragma("unroll") for (int gg = 0; gg < 4; ++gg) { const int g = 4 * (bt_) + gg; const int src = (4 * g + qd) & 63; \
        const int e = __shfl((g < 16) ? e0 : e1, src); const unsigned char* row = UB + (size_t)e * 512; \
        buf[gg][0] = *(const u32x4*)(row + li * 16); buf[gg][1] = *(const u32x4*)(row + (16 + li) * 16); } asm volatile("" ::: "memory"); } while (0)
#define PT4_DOT4(w_, c_, m_) do { d0 = __builtin_amdgcn_fdot2_f32_bf16(fp4b<0>(w_), __builtin_bit_cast(bf2_t, xq[c_][m_]), d0, false); d1 = __builtin_amdgcn_fdot2_f32_bf16(fp4b<1>(w_), __builtin_bit_cast(bf2_t, xq[c_][(m_) + 1]), d1, false); \
        d2 = __builtin_amdgcn_fdot2_f32_bf16(fp4b<2>(w_), __builtin_bit_cast(bf2_t, xq[c_][(m_) + 2]), d2, false); d3 = __builtin_amdgcn_fdot2_f32_bf16(fp4b<3>(w_), __builtin_bit_cast(bf2_t, xq[c_][(m_) + 3]), d3, false); } while (0)
#define PT4_UCOMP(buf, bt_) do { _Pragma("unroll") for (int gg = 0; gg < 4; ++gg) { const int g = 4 * (bt_) + gg; float d0 = 0.f, d1 = 0.f, d2 = 0.f, d3 = 0.f; \
        _Pragma("unroll") for (int c = 0; c < 2; ++c) { const unsigned ux = buf[gg][c].x, uy = buf[gg][c].y, uz = buf[gg][c].z, uw = buf[gg][c].w; \
            PT4_DOT4(ux, c, 0); PT4_DOT4(uy, c, 4); PT4_DOT4(uz, c, 8); PT4_DOT4(uw, c, 12); } \
        const float d = row16_sum((d0 + d1) + (d2 + d3)); \
        if (g < 16) zlo = (li == g) ? d : zlo; else zhi = (li == g - 16) ? d : zhi; } } while (0)
    u32x2 vA[16], vB[16];
#define PT4_VLOAD(buf, bt_) do { _Pragma("unroll") for (int kk = 0; kk < 16; ++kk) { const int k = 16 * (bt_) + kk; const int e = __builtin_amdgcn_readlane((k < 64) ? e0 : e1, k & 63); \
        buf[kk] = *(const u32x2*)(VB + (size_t)e * 512 + 8 * lane); } asm volatile("" ::: "memory"); } while (0)
#define PT4_VCOMP(buf, bt_) do { _Pragma("unroll") for (int kk = 0; kk < 16; ++kk) { const int k = 16 * (bt_) + kk; const int g = k >> 2, q4 = k & 3; \
        const float a = __builtin_bit_cast(float, __builtin_amdgcn_readlane(__builtin_bit_cast(int, (g < 16) ? actlo : acthi), 16 * q4 + (g & 15))); const u32x2 v = buf[kk]; \
        o2[0] += fp4p<0>(v.x) * a; o2[1] += fp4p<1>(v.x) * a; o2[2] += fp4p<2>(v.x) * a; o2[3] += fp4p<3>(v.x) * a; \
        o2[4] += fp4p<0>(v.y) * a; o2[5] += fp4p<1>(v.y) * a; o2[6] += fp4p<2>(v.y) * a; o2[7] += fp4p<3>(v.y) * a; } } while (0)
    PT4_ULOAD(uA, 0);
    PT4_ULOAD(uB, 1); PT4_UCOMP(uA, 0);
    PT4_ULOAD(uA, 2); PT4_UCOMP(uB, 1);
    PT4_ULOAD(uB, 3); PT4_UCOMP(uA, 2);
    PT4_ULOAD(uA, 4); PT4_UCOMP(uB, 3);
    PT4_ULOAD(uB, 5); PT4_UCOMP(uA, 4);
    PT4_ULOAD(uA, 6); PT4_UCOMP(uB, 5);
    PT4_ULOAD(uB, 7); PT4_UCOMP(uA, 6);
    PT4_VLOAD(vA, 0);     PT4_UCOMP(uB, 7);
    const float actlo = gelu_tanh(zlo * zs) * GATE[(size_t)t * 128 + 4 * li + qd] * (1.f / PEER_SV);
    const float acthi = gelu_tanh(zhi * zs) * GATE[(size_t)t * 128 + 64 + 4 * li + qd] * (1.f / PEER_SV);
    f32x2 o2[8];
#pragma unroll
    for (int i = 0; i < 8; ++i) o2[i] = (f32x2){0.f, 0.f};
    PT4_VLOAD(vB, 1); PT4_VCOMP(vA, 0);
    PT4_VLOAD(vA, 2); PT4_VCOMP(vB, 1);
    PT4_VLOAD(vB, 3); PT4_VCOMP(vA, 2);
    PT4_VLOAD(vA, 4); PT4_VCOMP(vB, 3);
    PT4_VLOAD(vB, 5); PT4_VCOMP(vA, 4);
    PT4_VLOAD(vA, 6); PT4_VCOMP(vB, 5);
    PT4_VLOAD(vB, 7); PT4_VCOMP(vA, 6);
    PT4_VCOMP(vB, 7);
#undef PT4_ULOAD
#undef PT4_UCOMP
#undef PT4_DOT4
#undef PT4_VLOAD
#undef PT4_VCOMP
    float* xo = F.out + (size_t)t * 1024 + 16 * lane;
    float o[16]; float ss = 0.f;
    { const u32x4 r0 = *(const u32x4*)(XB + (size_t)t * 1024 + 16 * lane), r1 = *(const u32x4*)(XB + (size_t)t * 1024 + 16 * lane + 8);
      const unsigned rw[8] = {r0.x, r0.y, r0.z, r0.w, r1.x, r1.y, r1.z, r1.w};
#pragma unroll
      for (int m = 0; m < 8; ++m) { o[2 * m] = o2[m].x + bflo(rw[m]); o[2 * m + 1] = o2[m].y + bfhi(rw[m]); ss += o[2 * m] * o[2 * m] + o[2 * m + 1] * o[2 * m + 1]; } }
    const float rs2 = rsqrtf(wave_sum(ss) * (1.f / 1024.f) + EPS);
    if (DRY && rs2 != -1.f) return;
    if (FINAL) {
        const float* fg = F.in[3] + 16 * lane;
#pragma unroll
        for (int q = 0; q < 4; ++q) { const f32x4 gq = *(const f32x4*)(fg + 4 * q); f32x4 w;
#pragma unroll
            for (int j = 0; j < 4; ++j) w[j] = o[4 * q + j] * rs2 * gq[j];
            *(f32x4*)(xo + 4 * q) = w; }
    } else {
        if (lane == 0) WSP(float, WS_RSTD)[t] = rs2;
#pragma unroll
        for (int hf = 0; hf < 2; ++hf) { u32x4 w; w.x = pk2(o[8 * hf + 0], o[8 * hf + 1]); w.y = pk2(o[8 * hf + 2], o[8 * hf + 3]); w.z = pk2(o[8 * hf + 4], o[8 * hf + 5]); w.w = pk2(o[8 * hf + 6], o[8 * hf + 7]);
            *(u32x4*)(XB + (size_t)t * 1024 + 16 * lane + 8 * hf) = w; }
    }
}
typedef int v8i_t __attribute__((ext_vector_type(8)));
constexpr size_t WS_ZP = 200 * MiB;
constexpr float PEER_XL = 8.f;
#define PM_X4(hw, lw, word, SEL) do { const float a = bflo(word), b2 = bfhi(word); hw = __builtin_amdgcn_cvt_scalef32_pk_fp4_f32(hw, a, b2, 1.0f, SEL); \
          const f32x2 hv = fp4p<SEL>(hw); lw = __builtin_amdgcn_cvt_scalef32_pk_fp4_f32(lw, (a - hv.x) * PEER_XL, (b2 - hv.y) * PEER_XL, 1.0f, SEL); } while (0)
DI void peer_u_phase(const Frame& F) {
    const int lane = F.lane, r16 = lane & 15, kq = lane >> 4, rho = lane >> 3, c8 = lane & 7;
    const unsigned char* UB = WSP(unsigned char, WS_UB); const bf16_t* XB = WSP(bf16_t, WS_XB);
    const int* EIDX = WSP(int, WS_EIDX); float* ZP = WSP(float, WS_ZP);
    LAS unsigned char* rowsL = F.lds + F.wave * 16640; LAS unsigned char* x8 = rowsL + 16384;
    const bool sliced = (F.G % 4) == 0;
    const int q = sliced ? F.G / 4 : F.G;
    const int wi = (sliced ? F.vcu % q : F.vcu) * NWAVES + F.wave, nw = q * NWAVES;
    const int s0 = sliced ? F.vcu / q : 0, s1 = sliced ? s0 + 1 : 4;
    const int goff0 = 16 * (c8 ^ (rho >> 1)), goff1 = 16 * (c8 ^ (4 + (rho >> 1)));
    const int aoff0 = r16 * 128 + 16 * (kq ^ ((r16 >> 1) & 7)), aoff1 = r16 * 128 + 16 * ((4 + kq) ^ ((r16 >> 1) & 7));
    for (int s = s0; s < s1; ++s) {
        const unsigned char* UBs = UB + (size_t)s * (16384 * 128);
        int e0A, e1A, e0B, e1B; u32x4 rr[16]; u32x2 xA, xC;
#define PU_IDX(e0b, e1b, xb, t_) do { const int tt = min((t_), T - 1); xb = *(const u32x2*)(XB + (size_t)tt * 1024 + 256 * s + 4 * lane); \
            e0b = EIDX[(size_t)tt * 128 + lane]; e1b = EIDX[(size_t)tt * 128 + 64 + lane]; asm volatile("" ::: "memory"); } while (0)
#define PU_ROWS(e0b, e1b) do { _Pragma("unroll") for (int j = 0; j < 16; ++j) { const int e = __shfl((j < 8) ? e0b : e1b, (8 * j + rho) & 63); \
            rr[j] = *(const u32x4*)(UBs + (size_t)e * 128 + ((j & 1) ? goff1 : goff0)); } asm volatile("" ::: "memory"); } while (0)
#define PU_STAGE(xb) do { unsigned hw = 0u, lw = 0u; const unsigned x0_ = xb.x, x1_ = xb.y; PM_X4(hw, lw, x0_, 0); PM_X4(hw, lw, x1_, 1); \
            *(LAS unsigned short*)(x8 + 2 * lane) = (unsigned short)hw; *(LAS unsigned short*)(x8 + 128 + 2 * lane) = (unsigned short)lw; \
            _Pragma("unroll") for (int j = 0; j < 16; ++j) *(LAS u32x4*)(rowsL + j * 1024 + 16 * lane) = rr[j]; asm volatile("" ::: "memory"); } while (0)
#define PU_MMA(t_) do { \
            const u32x4 b0 = *(const LAS u32x4*)(x8 + 128 * (r16 & 1) + 16 * kq), b1 = *(const LAS u32x4*)(x8 + 128 * (r16 & 1) + 64 + 16 * kq); \
            const v8i_t B0 = {(int)b0.x, (int)b0.y, (int)b0.z, (int)b0.w, 0, 0, 0, 0}, B1 = {(int)b1.x, (int)b1.y, (int)b1.z, (int)b1.w, 0, 0, 0, 0}; \
            f32x4 zz[8]; \
            _Pragma("unroll") for (int TT = 0; TT < 8; ++TT) { f32x4 acc = {0.f, 0.f, 0.f, 0.f}; \
                const u32x4 a0 = *(const LAS u32x4*)(rowsL + TT * 2048 + aoff0), a1 = *(const LAS u32x4*)(rowsL + TT * 2048 + aoff1); \
                const v8i_t A0 = {(int)a0.x, (int)a0.y, (int)a0.z, (int)a0.w, 0, 0, 0, 0}, A1 = {(int)a1.x, (int)a1.y, (int)a1.z, (int)a1.w, 0, 0, 0, 0}; \
                acc = __builtin_amdgcn_mfma_scale_f32_16x16x128_f8f6f4(A0, B0, acc, 4, 4, 0, 0x7f7f7f7f, 0, 0x7f7f7f7f); \
                acc = __builtin_amdgcn_mfma_scale_f32_16x16x128_f8f6f4(A1, B1, acc, 4, 4, 0, 0x7f7f7f7f, 0, 0x7f7f7f7f); \
                _Pragma("unroll") for (int r = 0; r < 4; ++r) { const float v = acc[r]; \
                    const float o = __builtin_bit_cast(float, __builtin_amdgcn_update_dpp(0, __builtin_bit_cast(int, v), 0xB1, 0xf, 0xf, false)); zz[TT][r] = v + o * (1.f / PEER_XL); } } \
            asm volatile("" ::: "memory"); \
            if (r16 == 0 && (t_) < T) { float* zo = ZP + ((size_t)(t_) * 4 + s) * 128 + 4 * kq; _Pragma("unroll") for (int TT = 0; TT < 8; ++TT) *(f32x4*)(zo + 16 * TT) = zz[TT]; } } while (0)
        int t = wi;
        PU_IDX(e0A, e1A, xA, t); PU_IDX(e0B, e1B, xC, t + nw); PU_ROWS(e0A, e1A);
        for (; t < T; t += 2 * nw) {
            PU_STAGE(xA); PU_IDX(e0A, e1A, xA, t + 2 * nw); PU_ROWS(e0B, e1B); PU_MMA(t);
            PU_STAGE(xC); PU_IDX(e0B, e1B, xC, t + 3 * nw); PU_ROWS(e0A, e1A); PU_MMA(t + nw);
        }
#undef PU_IDX
#undef PU_ROWS
#undef PU_STAGE
#undef PU_MMA
    }
}
DI void peer_u_owned(const Frame& F) {
    const int lane = F.lane, r16 = lane & 15, kq = lane >> 4, rho = lane >> 3, c8 = lane & 7;
    const unsigned char* UB = WSP(unsigned char, WS_UB); const bf16_t* XB = WSP(bf16_t, WS_XB);
    const int* EIDX = WSP(int, WS_EIDX); float* ZP = WSP(float, WS_ZP);
    LAS unsigned char* rowsL = F.lds + F.wave * 18400;     LAS unsigned char* x8 = rowsL + 16384;
    const int goff0 = 16 * (c8 ^ (rho >> 1)), goff1 = 16 * (c8 ^ (4 + (rho >> 1)));
    const int aoff0 = r16 * 128 + 16 * (kq ^ ((r16 >> 1) & 7)), aoff1 = r16 * 128 + 16 * ((4 + kq) ^ ((r16 >> 1) & 7));
    {
        int e0A, e1A, e0B, e1B; u32x4 rr[16]; u32x2 xA, xC;
#define PU_IDX(e0b, e1b, xb, i_) do { const int ii = min((i_), 31), s = ii >> 3, tt = F.gw + F.NGW * (ii & 7); xb = *(const u32x2*)(XB + (size_t)tt * 1024 + 256 * s + 4 * lane); \
            e0b = EIDX[(size_t)tt * 128 + lane]; e1b = EIDX[(size_t)tt * 128 + 64 + lane]; asm volatile("" ::: "memory"); } while (0)
#define PU_ROWS(e0b, e1b, i_) do { const unsigned char* UBs = UB + (size_t)(min((i_), 31) >> 3) * (16384 * 128); _Pragma("unroll") for (int j = 0; j < 16; ++j) { const int e = __shfl((j < 8) ? e0b : e1b, (8 * j + rho) & 63); \
            rr[j] = *(const u32x4*)(UBs + (size_t)e * 128 + ((j & 1) ? goff1 : goff0)); } asm volatile("" ::: "memory"); } while (0)
#define PU_STAGE(xb) do { unsigned hw = 0u, lw = 0u; const unsigned x0_ = xb.x, x1_ = xb.y; PM_X4(hw, lw, x0_, 0); PM_X4(hw, lw, x1_, 1); \
            *(LAS unsigned short*)(x8 + 2 * lane) = (unsigned short)hw; *(LAS unsigned short*)(x8 + 128 + 2 * lane) = (unsigned short)lw; \
            _Pragma("unroll") for (int j = 0; j < 16; ++j) *(LAS u32x4*)(rowsL + j * 1024 + 16 * lane) = rr[j]; asm volatile("" ::: "memory"); } while (0)
#define PU_MMA(i_) do { const int s = (i_) >> 3, t_ = F.gw + F.NGW * ((i_) & 7); \
            const u32x4 b0 = *(const LAS u32x4*)(x8 + 128 * (r16 & 1) + 16 * kq), b1 = *(const LAS u32x4*)(x8 + 128 * (r16 & 1) + 64 + 16 * kq); \
            const v8i_t B0 = {(int)b0.x, (int)b0.y, (int)b0.z, (int)b0.w, 0, 0, 0, 0}, B1 = {(int)b1.x, (int)b1.y, (int)b1.z, (int)b1.w, 0, 0, 0, 0}; \
            f32x4 zz[8]; \
            _Pragma("unroll") for (int TT = 0; TT < 8; ++TT) { f32x4 acc = {0.f, 0.f, 0.f, 0.f}; \
                const u32x4 a0 = *(const LAS u32x4*)(rowsL + TT * 2048 + aoff0), a1 = *(const LAS u32x4*)(rowsL + TT * 2048 + aoff1); \
                const v8i_t A0 = {(int)a0.x, (int)a0.y, (int)a0.z, (int)a0.w, 0, 0, 0, 0}, A1 = {(int)a1.x, (int)a1.y, (int)a1.z, (int)a1.w, 0, 0, 0, 0}; \
                acc = __builtin_amdgcn_mfma_scale_f32_16x16x128_f8f6f4(A0, B0, acc, 4, 4, 0, 0x7f7f7f7f, 0, 0x7f7f7f7f); \
                acc = __builtin_amdgcn_mfma_scale_f32_16x16x128_f8f6f4(A1, B1, acc, 4, 4, 0, 0x7f7f7f7f, 0, 0x7f7f7f7f); \
                _Pragma("unroll") for (int r = 0; r < 4; ++r) { const float v = acc[r]; \
                    const float o = __builtin_bit_cast(float, __builtin_amdgcn_update_dpp(0, __builtin_bit_cast(int, v), 0xB1, 0xf, 0xf, false)); zz[TT][r] = v + o * (1.f / PEER_XL); } } \
            asm volatile("" ::: "memory"); \
            if (r16 == 0 && (t_) < T) { float* zo = ZP + ((size_t)(t_) * 4 + s) * 128 + 4 * kq; _Pragma("unroll") for (int TT = 0; TT < 8; ++TT) *(f32x4*)(zo + 16 * TT) = zz[TT]; } } while (0)
        PU_IDX(e0A, e1A, xA, 0); PU_IDX(e0B, e1B, xC, 1); PU_ROWS(e0A, e1A, 0);
        for (int i = 0; i < 32; i += 2) {
            PU_STAGE(xA); PU_IDX(e0A, e1A, xA, i + 2); PU_ROWS(e0B, e1B, i + 1); PU_MMA(i);
            PU_STAGE(xC); PU_IDX(e0B, e1B, xC, i + 3); PU_ROWS(e0A, e1A, i + 2); PU_MMA(i + 1);
        }
#undef PU_IDX
#undef PU_ROWS
#undef PU_STAGE
#undef PU_MMA
    }
}
typedef int v2i_t __attribute__((ext_vector_type(2)));
constexpr size_t WS_SLOTS2 = WS_YSLOTS;
DI float row16_max(float v) {
    v = fmaxf(v, __builtin_bit_cast(float, __builtin_amdgcn_update_dpp(0, __builtin_bit_cast(int, v), 0xB1, 0xf, 0xf, false)));
    v = fmaxf(v, __builtin_bit_cast(float, __builtin_amdgcn_update_dpp(0, __builtin_bit_cast(int, v), 0x4E, 0xf, 0xf, false)));
    v = fmaxf(v, __builtin_bit_cast(float, __builtin_amdgcn_update_dpp(0, __builtin_bit_cast(int, v), 0x141, 0xf, 0xf, false)));
    v = fmaxf(v, __builtin_bit_cast(float, __builtin_amdgcn_update_dpp(0, __builtin_bit_cast(int, v), 0x140, 0xf, 0xf, false)));
    return v;
}
template <bool DRY = false>
DI void peer_v_mfma_phase(const Frame& F) {
    const int lane = F.lane, r16 = lane & 15, kq = lane >> 4, rho = lane >> 3, c8 = lane & 7;
    const unsigned char* VB = WSP(unsigned char, WS_VB); bf16_t* XB = WSP(bf16_t, WS_XB);
    const int* EIDX = WSP(int, WS_EIDX); const float* GATE = WSP(float, WS_GATE); const float* ZP = WSP(float, WS_ZP);
    const float* SLOTS = WSP(float, WS_SLOTS); float* SLOTS2 = WSP(float, WS_SLOTS2);
    LAS unsigned char* rowsL = F.lds + F.wave * 17664; LAS unsigned char* actL = rowsL + 16384; LAS float* outL = (LAS float*)(rowsL + 16640);
    const bool sliced = (F.G % 4) == 0;
    const int q = sliced ? F.G / 4 : F.G;
    const int wi = (sliced ? F.vcu % q : F.vcu) * NWAVES + F.wave, nw = q * NWAVES;
    const int s0 = sliced ? F.vcu / q : 0, s1 = sliced ? s0 + 1 : 4;
    const int goff0 = 16 * (c8 ^ (rho >> 1)), goff1 = 16 * (c8 ^ (4 + (rho >> 1)));
    int tra[8];
#pragma unroll
    for (int c = 0; c < 8; ++c) tra[c] = (32 * kq + r16) * 128 + 16 * (c ^ ((r16 >> 1) & 7));
    unsigned amask[4];
#pragma unroll
    for (int g = 0; g < 4; ++g) amask[g] = ((r16 >> 2) == g && (r16 & 3) < 3) ? 0xffffffffu : 0u;
    const int aoff = (((r16 & 3) < 3) ? (r16 & 3) : 0) * 64 + 16 * kq;
    for (int s = s0; s < s1; ++s) {
        const unsigned char* VBs = VB + (size_t)s * (16384 * 128);
        int e0A, e1A, e0B, e1B; float g0A, g1A, g0B, g1B, slA, slB; float zA[8], zB[8]; u32x2 rrA, rrB; u32x4 rr[16];
#define PV_IDX(e0b, e1b, g0b, g1b, zb, slb, rrb, t_) do { const int tt = min((t_), T - 1); \
            e0b = EIDX[(size_t)tt * 128 + lane]; e1b = EIDX[(size_t)tt * 128 + 64 + lane]; g0b = GATE[(size_t)tt * 128 + lane]; g1b = GATE[(size_t)tt * 128 + 64 + lane]; \
            _Pragma("unroll") for (int sp = 0; sp < 4; ++sp) { zb[sp] = ZP[((size_t)tt * 4 + sp) * 128 + lane]; zb[4 + sp] = ZP[((size_t)tt * 4 + sp) * 128 + 64 + lane]; } \
            slb = SLOTS[(size_t)tt * 16 + r16]; rrb = *(const u32x2*)(XB + (size_t)tt * 1024 + 256 * s + 4 * lane); asm volatile("" ::: "memory"); } while (0)
#define PV_ROWS(e0b, e1b) do { _Pragma("unroll") for (int j = 0; j < 16; ++j) { const int e = __shfl((j < 8) ? e0b : e1b, (8 * j + rho) & 63); \
            rr[j] = *(const u32x4*)(VBs + (size_t)e * 128 + ((j & 1) ? goff1 : goff0)); } asm volatile("" ::: "memory"); } while (0)
#define PV_PACK3(pa_, pb_, idx_) do { unsigned hb = __builtin_amdgcn_cvt_scalef32_pk_fp4_f32(0u, pa_, pb_, 1.0f, 0); const f32x2 hv = fp4p<0>(hb); const float ra = (pa_ - hv.x) * 8.f, rb = (pb_ - hv.y) * 8.f; \
            unsigned mb = __builtin_amdgcn_cvt_scalef32_pk_fp4_f32(0u, ra, rb, 1.0f, 0); const f32x2 mv = fp4p<0>(mb); const float ra2 = (ra - mv.x) * 8.f, rb2 = (rb - mv.y) * 8.f; \
            unsigned lb = __builtin_amdgcn_cvt_scalef32_pk_fp4_f32(0u, ra2, rb2, 1.0f, 0); \
            if (!(lane & 1)) { actL[(idx_)] = (unsigned char)hb; actL[64 + (idx_)] = (unsigned char)mb; actL[128 + (idx_)] = (unsigned char)lb; } } while (0)
#define PV_ACT(g0b, g1b, zb, slb, rrb) do { const float zs = rsqrtf(row16_sum(slb) * (1.f / 1024.f) + EPS) * (1.f / PEER_SU); \
            const float a0 = gelu_tanh(((zb[0] + zb[1]) + (zb[2] + zb[3])) * zs) * g0b * (1.f / PEER_SV), a1 = gelu_tanh(((zb[4] + zb[5]) + (zb[6] + zb[7])) * zs) * g1b * (1.f / PEER_SV); \
            float am = row16_max(fmaxf(fabsf(a0), fabsf(a1))); { const int ai = __builtin_bit_cast(int, am); am = fmaxf(fmaxf(__builtin_bit_cast(float, __builtin_amdgcn_readlane(ai, 0)), __builtin_bit_cast(float, __builtin_amdgcn_readlane(ai, 16))), fmaxf(__builtin_bit_cast(float, __builtin_amdgcn_readlane(ai, 32)), __builtin_bit_cast(float, __builtin_amdgcn_readlane(ai, 48)))); } \
            const float S = (am > 0.f) ? 4.f * frcp(am) : 1.f; invS = (am > 0.f) ? am * 0.25f : 1.f; \
            const float t0 = a0 * S, t1 = a1 * S; \
            const float n0 = __builtin_bit_cast(float, __builtin_amdgcn_update_dpp(0, __builtin_bit_cast(int, t0), 0xB1, 0xf, 0xf, false)), n1 = __builtin_bit_cast(float, __builtin_amdgcn_update_dpp(0, __builtin_bit_cast(int, t1), 0xB1, 0xf, 0xf, false)); \
            const bool odd = lane & 1; const float pa0 = odd ? n0 : t0, pb0 = odd ? t0 : n0, pa1 = odd ? n1 : t1, pb1 = odd ? t1 : n1; \
            PV_PACK3(pa0, pb0, lane >> 1); PV_PACK3(pa1, pb1, 32 + (lane >> 1)); rcur = rrb; asm volatile("" ::: "memory"); } while (0)
#define PV_STAGE() do { _Pragma("unroll") for (int j = 0; j < 16; ++j) *(LAS u32x4*)(rowsL + j * 1024 + 16 * lane) = rr[j]; asm volatile("" ::: "memory"); } while (0)
#define PV_MMA(t_) do { const u32x4 av = *(const LAS u32x4*)(actL + aoff); v8i_t Aop[4]; \
            _Pragma("unroll") for (int g = 0; g < 4; ++g) Aop[g] = (v8i_t){(int)(av.x & amask[g]), (int)(av.y & amask[g]), (int)(av.z & amask[g]), (int)(av.w & amask[g]), 0, 0, 0, 0}; \
            v2i_t bl[16], bh[16]; \
            _Pragma("unroll") for (int cb = 0; cb < 16; ++cb) { bl[cb] = __builtin_amdgcn_ds_read_tr4_b64_v2i32((LAS v2i_t*)(rowsL + tra[cb >> 1] + 8 * (cb & 1))); bh[cb] = __builtin_amdgcn_ds_read_tr4_b64_v2i32((LAS v2i_t*)(rowsL + tra[cb >> 1] + 8 * (cb & 1) + 2048)); } \
            f32x4 acc[4]; \
            _Pragma("unroll") for (int c = 0; c < 4; ++c) acc[c] = (f32x4){0.f, 0.f, 0.f, 0.f}; \
            _Pragma("unroll") for (int g = 0; g < 4; ++g) _Pragma("unroll") for (int c = 0; c < 4; ++c) { const v8i_t Bop = {bl[4 * c + g].x, bl[4 * c + g].y, bh[4 * c + g].x, bh[4 * c + g].y, 0, 0, 0, 0}; \
                acc[c] = __builtin_amdgcn_mfma_scale_f32_16x16x128_f8f6f4(Aop[g], Bop, acc[c], 4, 4, 0, 0x7f7f7f7f, 0, 0x7f7f7f7f); } \
            _Pragma("unroll") for (int c = 0; c < 4; ++c) { const float c0 = acc[c][0], c1 = acc[c][1], c2 = acc[c][2]; outL[64 * c + lane] = (c0 + c1 * 0.125f + c2 * 0.015625f) * invS; } \
            asm volatile("" ::: "memory"); \
            const f32x4 ov4 = *(const LAS f32x4*)(outL + 4 * lane); const unsigned rw0 = rcur.x, rw1 = rcur.y; \
            const float o0 = ov4[0] + bflo(rw0), o1 = ov4[1] + bfhi(rw0), o2_ = ov4[2] + bflo(rw1), o3 = ov4[3] + bfhi(rw1); \
            const int ssi = __builtin_bit_cast(int, row16_sum((o0 * o0 + o1 * o1) + (o2_ * o2_ + o3 * o3))); \
            const float ss = (__builtin_bit_cast(float, __builtin_amdgcn_readlane(ssi, 0)) + __builtin_bit_cast(float, __builtin_amdgcn_readlane(ssi, 16))) + (__builtin_bit_cast(float, __builtin_amdgcn_readlane(ssi, 32)) + __builtin_bit_cast(float, __builtin_amdgcn_readlane(ssi, 48))); \
            if ((t_) < T && !(DRY && ss != -1.f)) { if (lane == 0) *(f32x4*)(SLOTS2 + (size_t)(t_) * 16 + 4 * s) = (f32x4){ss, 0.f, 0.f, 0.f}; \
                u32x2 w; w.x = pk2(o0, o1); w.y = pk2(o2_, o3); *(u32x2*)(XB + (size_t)(t_) * 1024 + 256 * s + 4 * lane) = w; } } while (0)
        float invS = 1.f; u32x2 rcur = {0u, 0u};
        int t = wi;
        PV_IDX(e0A, e1A, g0A, g1A, zA, slA, rrA, t); PV_IDX(e0B, e1B, g0B, g1B, zB, slB, rrB, t + nw); PV_ROWS(e0A, e1A);
        for (; t < T; t += 2 * nw) {
            PV_ACT(g0A, g1A, zA, slA, rrA); PV_STAGE(); PV_IDX(e0A, e1A, g0A, g1A, zA, slA, rrA, t + 2 * nw); PV_ROWS(e0B, e1B); PV_MMA(t);
            PV_ACT(g0B, g1B, zB, slB, rrB); PV_STAGE(); PV_IDX(e0B, e1B, g0B, g1B, zB, slB, rrB, t + 3 * nw); PV_ROWS(e0A, e1A); PV_MMA(t + nw);
        }
#undef PV_IDX
#undef PV_ROWS
#undef PV_PACK3
#undef PV_ACT
#undef PV_STAGE
#undef PV_MMA
    }
}
template <bool FINAL>
DI void peer_v_mfma_final(const Frame& F) {
    const int lane = F.lane, r16 = lane & 15, kq = lane >> 4, rho = lane >> 3, c8 = lane & 7;
    const unsigned char* VB = WSP(unsigned char, WS_VB); bf16_t* XB = WSP(bf16_t, WS_XB);
    const int* EIDX = WSP(int, WS_EIDX); const float* GATE = WSP(float, WS_GATE); const float* ZP = WSP(float, WS_ZP);
    const float* SLOTS = WSP(float, WS_SLOTS);
    LAS unsigned char* rowsL = F.lds + F.wave * 18400; LAS unsigned char* tactL = rowsL + 16640; LAS float* outL = (LAS float*)rowsL;
    const int goff0 = 16 * (c8 ^ (rho >> 1)), goff1 = 16 * (c8 ^ (4 + (rho >> 1)));
    int tra[8];
#pragma unroll
    for (int c = 0; c < 8; ++c) tra[c] = (32 * kq + r16) * 128 + 16 * (c ^ ((r16 >> 1) & 7));
    unsigned amask[4];
#pragma unroll
    for (int g = 0; g < 4; ++g) amask[g] = ((r16 >> 2) == g && (r16 & 3) < 3) ? 0xffffffffu : 0u;
    const int aoff = (((r16 & 3) < 3) ? (r16 & 3) : 0) * 64 + 16 * kq;
    {
        int e0A, e1A, e0B, e1B; u32x2 rrA, rrB; u32x4 rr[16];
#define PV_IDX(e0b, e1b, rrb, i_) do { const int ii = min((i_), 31), s = ii >> 3, tt = F.gw + F.NGW * (ii & 7); \
            e0b = EIDX[(size_t)tt * 128 + lane]; e1b = EIDX[(size_t)tt * 128 + 64 + lane]; rrb = *(const u32x2*)(XB + (size_t)tt * 1024 + 256 * s + 4 * lane); asm volatile("" ::: "memory"); } while (0)
#define PV_ROWS(e0b, e1b, i_) do { const unsigned char* VBs = VB + (size_t)(min((i_), 31) >> 3) * (16384 * 128); _Pragma("unroll") for (int j = 0; j < 16; ++j) { const int e = __shfl((j < 8) ? e0b : e1b, (8 * j + rho) & 63); \
            rr[j] = *(const u32x4*)(VBs + (size_t)e * 128 + ((j & 1) ? goff1 : goff0)); } asm volatile("" ::: "memory"); } while (0)
#define PV_PACK3(pa_, pb_, idx_) do { unsigned hb = __builtin_amdgcn_cvt_scalef32_pk_fp4_f32(0u, pa_, pb_, 1.0f, 0); const f32x2 hv = fp4p<0>(hb); const float ra = (pa_ - hv.x) * 8.f, rb = (pb_ - hv.y) * 8.f; \
            unsigned mb = __builtin_amdgcn_cvt_scalef32_pk_fp4_f32(0u, ra, rb, 1.0f, 0); const f32x2 mv = fp4p<0>(mb); const float ra2 = (ra - mv.x) * 8.f, rb2 = (rb - mv.y) * 8.f; \
            unsigned lb = __builtin_amdgcn_cvt_scalef32_pk_fp4_f32(0u, ra2, rb2, 1.0f, 0); \
            if (!(lane & 1)) { tj[(idx_)] = (unsigned char)hb; tj[64 + (idx_)] = (unsigned char)mb; tj[128 + (idx_)] = (unsigned char)lb; } } while (0)
#define PV_STAGE() do { _Pragma("unroll") for (int j = 0; j < 16; ++j) *(LAS u32x4*)(rowsL + j * 1024 + 16 * lane) = rr[j]; asm volatile("" ::: "memory"); } while (0)
#define PV_MMA(i_, rrb) do { const int s = (i_) >> 3, jt = (i_) & 7, t_ = F.gw + F.NGW * jt; const u32x4 av = *(const LAS u32x4*)(tactL + jt * 192 + aoff); const u32x2 rcur = rrb; v8i_t Aop[4]; \
            const float invS = __builtin_bit_cast(float, __builtin_amdgcn_readlane(__builtin_bit_cast(int, invSv), jt)); \
            _Pragma("unroll") for (int g = 0; g < 4; ++g) Aop[g] = (v8i_t){(int)(av.x & amask[g]), (int)(av.y & amask[g]), (int)(av.z & amask[g]), (int)(av.w & amask[g]), 0, 0, 0, 0}; \
            v2i_t bl[16], bh[16]; \
            _Pragma("unroll") for (int cb = 0; cb < 16; ++cb) { bl[cb] = __builtin_amdgcn_ds_read_tr4_b64_v2i32((LAS v2i_t*)(rowsL + tra[cb >> 1] + 8 * (cb & 1))); bh[cb] = __builtin_amdgcn_ds_read_tr4_b64_v2i32((LAS v2i_t*)(rowsL + tra[cb >> 1] + 8 * (cb & 1) + 2048)); } \
            f32x4 acc[4]; \
            _Pragma("unroll") for (int c = 0; c < 4; ++c) acc[c] = (f32x4){0.f, 0.f, 0.f, 0.f}; \
            _Pragma("unroll") for (int g = 0; g < 4; ++g) _Pragma("unroll") for (int c = 0; c < 4; ++c) { const v8i_t Bop = {bl[4 * c + g].x, bl[4 * c + g].y, bh[4 * c + g].x, bh[4 * c + g].y, 0, 0, 0, 0}; \
                acc[c] = __builtin_amdgcn_mfma_scale_f32_16x16x128_f8f6f4(Aop[g], Bop, acc[c], 4, 4, 0, 0x7f7f7f7f, 0, 0x7f7f7f7f); } \
            _Pragma("unroll") for (int c = 0; c < 4; ++c) { const float c0 = acc[c][0], c1 = acc[c][1], c2 = acc[c][2]; outL[64 * c + lane] = (c0 + c1 * 0.125f + c2 * 0.015625f) * invS; } \
            asm volatile("" ::: "memory"); \
            const f32x4 ov4 = *(const LAS f32x4*)(outL + 4 * lane); const unsigned rw0 = rcur.x, rw1 = rcur.y; \
            const float o0 = ov4[0] + bflo(rw0), o1 = ov4[1] + bfhi(rw0), o2_ = ov4[2] + bflo(rw1), o3 = ov4[3] + bfhi(rw1); \
            const int ssi = __builtin_bit_cast(int, row16_sum((o0 * o0 + o1 * o1) + (o2_ * o2_ + o3 * o3))); \
            const float ss = (__builtin_bit_cast(float, __builtin_amdgcn_readlane(ssi, 0)) + __builtin_bit_cast(float, __builtin_amdgcn_readlane(ssi, 16))) + (__builtin_bit_cast(float, __builtin_amdgcn_readlane(ssi, 32)) + __builtin_bit_cast(float, __builtin_amdgcn_readlane(ssi, 48))); \
            ssqv = (lane == jt) ? ssqv + ss : ssqv; \
            { u32x2 w; w.x = pk2(o0, o1); w.y = pk2(o2_, o3); *(u32x2*)(XB + (size_t)t_ * 1024 + 256 * s + 4 * lane) = w; } } while (0)
        float invSv = 1.f;
        { float zt[8][8], gt[8][2], st[8];
#pragma unroll
          for (int j = 0; j < 8; ++j) { const int tt = F.gw + F.NGW * j;
#pragma unroll
              for (int sp = 0; sp < 4; ++sp) { zt[j][sp] = ZP[((size_t)tt * 4 + sp) * 128 + lane]; zt[j][4 + sp] = ZP[((size_t)tt * 4 + sp) * 128 + 64 + lane]; }
              gt[j][0] = GATE[(size_t)tt * 128 + lane]; gt[j][1] = GATE[(size_t)tt * 128 + 64 + lane]; st[j] = SLOTS[(size_t)tt * 16 + r16]; }
          asm volatile("" ::: "memory");
#pragma unroll
          for (int j = 0; j < 8; ++j) { LAS unsigned char* tj = tactL + j * 192;
              const float zs = rsqrtf(row16_sum(st[j]) * (1.f / 1024.f) + EPS) * (1.f / PEER_SU);
              const float a0 = gelu_tanh(((zt[j][0] + zt[j][1]) + (zt[j][2] + zt[j][3])) * zs) * gt[j][0] * (1.f / PEER_SV), a1 = gelu_tanh(((zt[j][4] + zt[j][5]) + (zt[j][6] + zt[j][7])) * zs) * gt[j][1] * (1.f / PEER_SV);
              float am = row16_max(fmaxf(fabsf(a0), fabsf(a1))); { const int ai = __builtin_bit_cast(int, am); am = fmaxf(fmaxf(__builtin_bit_cast(float, __builtin_amdgcn_readlane(ai, 0)), __builtin_bit_cast(float, __builtin_amdgcn_readlane(ai, 16))), fmaxf(__builtin_bit_cast(float, __builtin_amdgcn_readlane(ai, 32)), __builtin_bit_cast(float, __builtin_amdgcn_readlane(ai, 48)))); }
              const float S = (am > 0.f) ? 4.f * frcp(am) : 1.f; invSv = (lane == j) ? ((am > 0.f) ? am * 0.25f : 1.f) : invSv;
              const float t0 = a0 * S, t1 = a1 * S;
              const float n0 = __builtin_bit_cast(float, __builtin_amdgcn_update_dpp(0, __builtin_bit_cast(int, t0), 0xB1, 0xf, 0xf, false)), n1 = __builtin_bit_cast(float, __builtin_amdgcn_update_dpp(0, __builtin_bit_cast(int, t1), 0xB1, 0xf, 0xf, false));
              const bool odd = lane & 1; const float pa0 = odd ? n0 : t0, pb0 = odd ? t0 : n0, pa1 = odd ? n1 : t1, pb1 = odd ? t1 : n1;
              PV_PACK3(pa0, pb0, lane >> 1); PV_PACK3(pa1, pb1, 32 + (lane >> 1)); }
          asm volatile("" ::: "memory"); }
        float ssqv = 0.f;
        PV_IDX(e0A, e1A, rrA, 0); PV_IDX(e0B, e1B, rrB, 1); PV_ROWS(e0A, e1A, 0);
        for (int i = 0; i < 32; i += 2) {
            { const u32x2 rc = rrA; PV_STAGE(); PV_IDX(e0A, e1A, rrA, i + 2); PV_ROWS(e0B, e1B, i + 1); PV_MMA(i, rc); }
            { const u32x2 rc = rrB; PV_STAGE(); PV_IDX(e0B, e1B, rrB, i + 3); PV_ROWS(e0A, e1A, i + 2); PV_MMA(i + 1, rc); }
        }
        if (!FINAL) { if (lane < 8) WSP(float, WS_RSTD)[F.gw + F.NGW * lane] = rsqrtf(ssqv * (1.f / 1024.f) + EPS); }
        else {
        asm volatile("s_waitcnt vmcnt(0)\n\tbuffer_inv sc0\n\ts_waitcnt vmcnt(0)" ::: "memory");
        const float* fg = F.in[3] + 16 * lane;
        for (int jt = 0; jt < 8; ++jt) { const int t = F.gw + F.NGW * jt;
            const float rs2 = rsqrtf(__builtin_bit_cast(float, __builtin_amdgcn_readlane(__builtin_bit_cast(int, ssqv), jt)) * (1.f / 1024.f) + EPS);
            const u32x4 r0 = *(const u32x4*)(XB + (size_t)t * 1024 + 16 * lane), r1 = *(const u32x4*)(XB + (size_t)t * 1024 + 16 * lane + 8);
            const unsigned rw[8] = {r0.x, r0.y, r0.z, r0.w, r1.x, r1.y, r1.z, r1.w}; float* xo = F.out + (size_t)t * 1024 + 16 * lane;
#pragma unroll
            for (int qq = 0; qq < 4; ++qq) { const f32x4 gq = *(const f32x4*)(fg + 4 * qq); f32x4 w;
                w[0] = bflo(rw[2 * qq]) * rs2 * gq[0]; w[1] = bfhi(rw[2 * qq]) * rs2 * gq[1]; w[2] = bflo(rw[2 * qq + 1]) * rs2 * gq[2]; w[3] = bfhi(rw[2 * qq + 1]) * rs2 * gq[3];
                *(f32x4*)(xo + 4 * qq) = w; } } }
#undef PV_IDX
#undef PV_ROWS
#undef PV_PACK3
#undef PV_STAGE
#undef PV_MMA
    }
}
template <bool FINAL, bool DRY = false>
DI void peer_v_token(const Frame& F, int t) {
    const int lane = F.lane;
    const unsigned char* VB = WSP(unsigned char, WS_VB); bf16_t* XB = WSP(bf16_t, WS_XB);
    const int* EIDX = WSP(int, WS_EIDX); const float* GATE = WSP(float, WS_GATE); const float* zp = WSP(float, WS_ZP) + (size_t)t * 512;
    float sl = (lane < 16) ? WSP(float, WS_SLOTS)[(size_t)t * 16 + lane] : 0.f;
    const int e0 = EIDX[(size_t)t * 128 + lane] & (DRY ? 2047 : 0x7fffffff), e1 = EIDX[(size_t)t * 128 + 64 + lane] & (DRY ? 2047 : 0x7fffffff);
    float zlo = (zp[lane] + zp[128 + lane]) + (zp[256 + lane] + zp[384 + lane]), zhi = (zp[64 + lane] + zp[192 + lane]) + (zp[320 + lane] + zp[448 + lane]);
    const float glo = GATE[(size_t)t * 128 + lane], ghi = GATE[(size_t)t * 128 + 64 + lane];
    u32x2 vA[16], vB[16];
#define PV_VLOAD(buf, bt_) do { _Pragma("unroll") for (int kk = 0; kk < 16; ++kk) { const int k = 16 * (bt_) + kk; const int e = __builtin_amdgcn_readlane((k < 64) ? e0 : e1, k & 63); \
        buf[kk] = *(const u32x2*)(VB + (size_t)e * 512 + 8 * lane); } asm volatile("" ::: "memory"); } while (0)
#define PV_VCOMP(buf, bt_) do { _Pragma("unroll") for (int kk = 0; kk < 16; ++kk) { const int k = 16 * (bt_) + kk; \
        const float a = __builtin_bit_cast(float, __builtin_amdgcn_readlane(__builtin_bit_cast(int, (k < 64) ? actlo : acthi), k & 63)); const u32x2 v = buf[kk]; \
        o2[0] += fp4p<0>(v.x) * a; o2[1] += fp4p<1>(v.x) * a; o2[2] += fp4p<2>(v.x) * a; o2[3] += fp4p<3>(v.x) * a; \
        o2[4] += fp4p<0>(v.y) * a; o2[5] += fp4p<1>(v.y) * a; o2[6] += fp4p<2>(v.y) * a; o2[7] += fp4p<3>(v.y) * a; } } while (0)
    PV_VLOAD(vA, 0);
    const float rstd = rsqrtf(wave_sum(sl) * (1.f / 1024.f) + EPS);
    const float zs = rstd * (1.f / PEER_SU);
    const float actlo = gelu_tanh(zlo * zs) * glo * (1.f / PEER_SV), acthi = gelu_tanh(zhi * zs) * ghi * (1.f / PEER_SV);
    f32x2 o2[8];
#pragma unroll
    for (int i = 0; i < 8; ++i) o2[i] = (f32x2){0.f, 0.f};
    PV_VLOAD(vB, 1); PV_VCOMP(vA, 0);
    PV_VLOAD(vA, 2); PV_VCOMP(vB, 1);
    PV_VLOAD(vB, 3); PV_VCOMP(vA, 2);
    PV_VLOAD(vA, 4); PV_VCOMP(vB, 3);
    PV_VLOAD(vB, 5); PV_VCOMP(vA, 4);
    PV_VLOAD(vA, 6); PV_VCOMP(vB, 5);
    PV_VLOAD(vB, 7); PV_VCOMP(vA, 6);
    PV_VCOMP(vB, 7);
#undef PV_VLOAD
#undef PV_VCOMP
    float* xo = F.out + (size_t)t * 1024 + 16 * lane;
    float o[16]; float ss = 0.f;
    { const u32x4 r0 = *(const u32x4*)(XB + (size_t)t * 1024 + 16 * lane), r1 = *(const u32x4*)(XB + (size_t)t * 1024 + 16 * lane + 8);
      const unsigned rw[8] = {r0.x, r0.y, r0.z, r0.w, r1.x, r1.y, r1.z, r1.w};
#pragma unroll
      for (int m = 0; m < 8; ++m) { o[2 * m] = o2[m].x + bflo(rw[m]); o[2 * m + 1] = o2[m].y + bfhi(rw[m]); ss += o[2 * m] * o[2 * m] + o[2 * m + 1] * o[2 * m + 1]; } }
    const float rs2 = rsqrtf(wave_sum(ss) * (1.f / 1024.f) + EPS);
    if (DRY && rs2 != -1.f) return;
    if (FINAL) {
        const float* fg = F.in[3] + 16 * lane;
#pragma unroll
        for (int q = 0; q < 4; ++q) { const f32x4 gq = *(const f32x4*)(fg + 4 * q); f32x4 w;
#pragma unroll
            for (int j = 0; j < 4; ++j) w[j] = o[4 * q + j] * rs2 * gq[j];
            *(f32x4*)(xo + 4 * q) = w; }
    } else {
        if (lane == 0) WSP(float, WS_RSTD)[t] = rs2;
#pragma unroll
        for (int hf = 0; hf < 2; ++hf) { u32x4 w; w.x = pk2(o[8 * hf + 0], o[8 * hf + 1]); w.y = pk2(o[8 * hf + 2], o[8 * hf + 3]); w.z = pk2(o[8 * hf + 4], o[8 * hf + 5]); w.w = pk2(o[8 * hf + 6], o[8 * hf + 7]);
            *(u32x4*)(XB + (size_t)t * 1024 + 16 * lane + 8 * hf) = w; }
    }
}
DI void conv_dt_unit(const Frame& F, int unit) {
    const int tok0 = unit * 64, tid = F.tid;
    const bf16_t* proj = WSP(bf16_t, WS_PROJ); bf16_t* xbc = WSP(bf16_t, WS_XBC);
    const float* cw = F.in[14]; const float* cb = F.in[15];
    for (int it = tid; it < 8 * 384; it += NTHR) {
        const int seg = it / 384, cg = it % 384, c0 = cg * 8, ts = tok0 + seg * 8;
        float w[4][8], bsv[8];
#pragma unroll
        for (int k = 0; k < 4; ++k) { const f32x4 a = *(const f32x4*)(cw + k * 3072 + c0), b2 = *(const f32x4*)(cw + k * 3072 + c0 + 4);
#pragma unroll
            for (int j = 0; j < 4; ++j) { w[k][j] = a[j]; w[k][4 + j] = b2[j]; } }
        { const f32x4 a = *(const f32x4*)(cb + c0), b2 = *(const f32x4*)(cb + c0 + 4);
#pragma unroll
          for (int j = 0; j < 4; ++j) { bsv[j] = a[j]; bsv[4 + j] = b2[j]; } }
        float xr[11][8];
#pragma unroll
        for (int i = 0; i < 11; ++i) { const int tt = ts - 3 + i; const bool ok = ((ts & (SEQ - 1)) + i - 3) >= 0;
            u32x4 v = (u32x4){0u, 0u, 0u, 0u};
            if (ok) v = *(const u32x4*)(proj + (size_t)tt * SSM_N + 2048 + c0);
            xr[i][0] = bflo(v.x); xr[i][1] = bfhi(v.x); xr[i][2] = bflo(v.y); xr[i][3] = bfhi(v.y); xr[i][4] = bflo(v.z); xr[i][5] = bfhi(v.z); xr[i][6] = bflo(v.w); xr[i][7] = bfhi(v.w); }
#pragma unroll
        for (int t = 0; t < 8; ++t) { float y[8];
#pragma unroll
            for (int j = 0; j < 8; ++j) { const float v = bsv[j] + w[0][j] * xr[t][j] + w[1][j] * xr[t + 1][j] + w[2][j] * xr[t + 2][j] + w[3][j] * xr[t + 3][j]; y[j] = siluf_(v); }
            u32x4 o; o.x = pk2(y[0], y[1]); o.y = pk2(y[2], y[3]); o.z = pk2(y[4], y[5]); o.w = pk2(y[6], y[7]);
            *(u32x4*)(xbc + (size_t)(ts + t) * 3072 + c0) = o; }
    }
}
DI void dt_unit(const Frame& F, int wu) {
    {
        const int lane = F.lane, fr = lane & 15, fq = lane >> 4, tw = 16 * wu;
        const bf16_t* XB = WSP(bf16_t, WS_XB); const bf16_t* WDT = WSP(bf16_t, WS_WDT);
        f32x4 acc[2] = {(f32x4){0.f, 0.f, 0.f, 0.f}, (f32x4){0.f, 0.f, 0.f, 0.f}};
#pragma unroll 1
        for (int kb = 0; kb < 4; ++kb) {
            bf16x8 a[8], b0[8], b1[8];
#pragma unroll
            for (int k2 = 0; k2 < 8; ++k2) { const int ks = 8 * kb + k2;
                a[k2] = *(const bf16x8*)(XB + (size_t)(tw + fr) * 1024 + 32 * ks + 8 * fq);
                b0[k2] = *(const bf16x8*)(WDT + (size_t)fr * 1024 + 32 * ks + 8 * fq); b1[k2] = *(const bf16x8*)(WDT + (size_t)(16 + fr) * 1024 + 32 * ks + 8 * fq); }
            asm volatile("" ::: "memory");
#pragma unroll
            for (int k2 = 0; k2 < 8; ++k2) { acc[0] = MFMA16(a[k2], b0[k2], acc[0]); acc[1] = MFMA16(a[k2], b1[k2], acc[1]); }
        }
        const float* rstd = WSP(float, WS_RSTD); float* DT = WSP(float, WS_DT);
#pragma unroll
        for (int nf = 0; nf < 2; ++nf)
#pragma unroll
            for (int r = 0; r < 4; ++r) { const int tt = tw + 4 * fq + r, hh = 16 * nf + fr; float rsv;
                if (PEER_SPLIT && PEER_VSLICE && !PEER_OWNED) { const f32x4* sp = (const f32x4*)(WSP(float, WS_SLOTS2) + (size_t)tt * 16); rsv = rsqrtf(((sp[0][0] + sp[1][0]) + (sp[2][0] + sp[3][0])) * (1.f / 1024.f) + EPS); } else rsv = rstd[tt];
                DT[(size_t)tt * 32 + hh] = softplusf_(acc[nf][r] * rsv + F.in[16][hh]); }
    }
}

DI void ssd_dt_acum(const Frame& F, int tok0, int g, LAS float* dtl, LAS float* acl) {
    const int hh = F.wave, lane = F.lane, head = 8 * g + hh;
    const float* DT = WSP(float, WS_DT);
    const float an = -expf(F.in[17][head]);
    const float d0 = DT[(size_t)(tok0 + 2 * lane) * 32 + head], d1 = DT[(size_t)(tok0 + 2 * lane + 1) * 32 + head];
    const float a0 = d0 * an, a1 = d1 * an;
    float s = a0 + a1;
#pragma unroll
    for (int o = 1; o < 64; o <<= 1) { const float v = __shfl_up(s, o); if (lane >= o) s += v; }
    dtl[(2 * lane) * 8 + hh] = d0; dtl[(2 * lane + 1) * 8 + hh] = d1;
    acl[(2 * lane) * 8 + hh] = s - a1; acl[(2 * lane + 1) * 8 + hh] = s;
}

DI void ssd_state_unit(const Frame& F, int unit) {
    const int g = unit & 3, bn = unit >> 2, tok0 = bn * CH, tid = F.tid, lane = F.lane, w = F.wave, fr = lane & 15, fq = lane >> 4;
    const bf16_t* xbc = WSP(bf16_t, WS_XBC);
    LAS short* Bimg = (LAS short*)F.lds;
    LAS short* Ximg = Bimg + 128 * 136;
    LAS float* dtl = (LAS float*)(F.lds + (128 * 136 + 128 * LDQ) * 2);
    LAS float* acl = dtl + 1024;
    LAS float* wsc = acl + 1024;
    ssd_dt_acum(F, tok0, g, dtl, acl);
#pragma unroll
    for (int i = 0; i < 4; ++i) { const int c = tid + 512 * i, row = c >> 4, ch8 = c & 15;
        *(LAS u32x4*)(Bimg + row * 136 + ch8 * 8) = *(const u32x4*)(xbc + (size_t)(tok0 + row) * 3072 + 2048 + g * 128 + ch8 * 8); }
    __syncthreads();
    for (int i = tid; i < 1024; i += NTHR) { const int s = i >> 3, hh = i & 7; wsc[i] = expf(acl[127 * 8 + hh] - acl[i]) * dtl[i]; (void)s; }
    if (tid < 8) WSP(float, WS_CDEC)[bn * 32 + 8 * g + tid] = expf(acl[127 * 8 + tid]);
    __syncthreads();
    for (int half = 0; half < 2; ++half) {
#pragma unroll
        for (int i = 0; i < 8; ++i) { const int c = tid + 512 * i, row = c >> 5, ch8 = c & 31, hl = ch8 >> 3;
            u32x4 v = *(const u32x4*)(xbc + (size_t)(tok0 + row) * 3072 + g * 512 + half * 256 + ch8 * 8);
            const float s = wsc[row * 8 + 4 * half + hl];
            v.x = pk2(bflo(v.x) * s, bfhi(v.x) * s); v.y = pk2(bflo(v.y) * s, bfhi(v.y) * s); v.z = pk2(bflo(v.z) * s, bfhi(v.z) * s); v.w = pk2(bflo(v.w) * s, bfhi(v.w) * s);
            *(LAS u32x4*)(Ximg + row * LDQ + ch8 * 8) = v; }
        __syncthreads();
        const int hl = w >> 1, kn = w & 1;
        f32x4 acc[4][4];
#pragma unroll
        for (int m = 0; m < 4; ++m)
#pragma unroll
            for (int nn = 0; nn < 4; ++nn) acc[m][nn] = (f32x4){0.f, 0.f, 0.f, 0.f};
#pragma unroll
        for (int ks = 0; ks < 4; ++ks) { bf16x8 bb[4];
#pragma unroll
            for (int nn = 0; nn < 4; ++nn) bb[nn] = frag_tr(Bimg, 136, 64 * kn + 16 * nn, 32 * ks, lane);
#pragma unroll
            for (int m = 0; m < 4; ++m) { const bf16x8 a = frag_tr(Ximg, LDQ, hl * 64 + 16 * m, 32 * ks, lane);
#pragma unroll
                for (int nn = 0; nn < 4; ++nn) acc[m][nn] = MFMA16(a, bb[nn], acc[m][nn]); } }
        float* st = WSP(float, WS_STATES) + ((size_t)bn * 32 + 8 * g + 4 * half + hl) * 8192;
#pragma unroll
        for (int m = 0; m < 4; ++m)
#pragma unroll
            for (int nn = 0; nn < 4; ++nn)
#pragma unroll
                for (int r = 0; r < 4; ++r) st[(16 * m + 4 * fq + r) * 128 + 64 * kn + 16 * nn + fr] = acc[m][nn][r];
        __syncthreads();
    }
}
template <bool DRY = false>
DI void ssd_scan(const Frame& F) {
    f32x4* st = WSP(f32x4, WS_STATES); const float* cdec = WSP(float, WS_CDEC);
    const int gt = F.gw * 64 + F.lane, NGT = F.NGW * 64;
    for (int i = gt; i < 8 * 65536; i += NGT) {
        const int b = i >> 16, e = i & 65535, h = e >> 11;
        f32x4 run = (f32x4){0.f, 0.f, 0.f, 0.f};
        f32x4* p = st + (size_t)b * 16 * 65536 + e;
        f32x4 tmp[16];
#pragma unroll
        for (int n = 0; n < 16; ++n) tmp[n] = p[(size_t)n * 65536];
#pragma unroll
        for (int n = 0; n < 16; ++n) { if (!DRY || run[0] == 1.2345e30f) p[(size_t)n * 65536] = run; run = run * cdec[(b * 16 + n) * 32 + h] + tmp[n]; }
    }
}

template <bool DRY = false>
DI void ssd_out_unit(const Frame& F, int unit) {
    const int g = unit & 3, bn = unit >> 2, tok0 = bn * CH, tid = F.tid, lane = F.lane, w = F.wave, fr = lane & 15, fq = lane >> 4;
    const bf16_t* xbc = WSP(bf16_t, WS_XBC); bf16_t* proj = WSP(bf16_t, WS_PROJ);
    LAS short* Cimg = (LAS short*)F.lds;
    LAS short* Bimg = Cimg + 128 * 136;
    LAS short* Ximg = Bimg + 128 * 136;
    LAS short* Pimg = Ximg + 128 * 72;
    LAS float* dtl = (LAS float*)(Pimg + 64 * 136);
    LAS float* acl = dtl + 1024;
    ssd_dt_acum(F, tok0, g, dtl, acl);
#pragma unroll
    for (int i = 0; i < 4; ++i) { const int c = tid + 512 * i, row = c >> 4, ch8 = c & 15;
        *(LAS u32x4*)(Bimg + row * 136 + ch8 * 8) = *(const u32x4*)(xbc + (size_t)(tok0 + row) * 3072 + 2048 + g * 128 + ch8 * 8);
        *(LAS u32x4*)(Cimg + row * 136 + ch8 * 8) = *(const u32x4*)(xbc + (size_t)(tok0 + row) * 3072 + 2560 + g * 128 + ch8 * 8); }
    __syncthreads();
    f32x4 cbm[8];
#pragma unroll
    for (int nf = 0; nf < 8; ++nf) cbm[nf] = (f32x4){0.f, 0.f, 0.f, 0.f};
#pragma unroll
    for (int ks = 0; ks < 4; ++ks) { const bf16x8 a = frag_row(Cimg, 136, 16 * w, 32 * ks, lane);
#pragma unroll
        for (int nf = 0; nf < 8; ++nf) { const bf16x8 bb = frag_row(Bimg, 136, 16 * nf, 32 * ks, lane); cbm[nf] = MFMA16(a, bb, cbm[nf]); } }
    __syncthreads();
    LAS short* Mimg = Bimg;
    for (int hh = 0; hh < 8; ++hh) {
        const int head = 8 * g + hh;
#pragma unroll
        for (int i = 0; i < 2; ++i) { const int c = tid + 512 * i, row = c >> 3, ch8 = c & 7;
            *(LAS u32x4*)(Ximg + row * 72 + ch8 * 8) = *(const u32x4*)(xbc + (size_t)(tok0 + row) * 3072 + head * 64 + ch8 * 8); }
        { const float* prev = WSP(float, WS_STATES) + ((size_t)bn * 32 + head) * 8192;
#pragma unroll
          for (int i = 0; i < 4; ++i) { const int c = tid + 512 * i, row = c >> 5, c4 = c & 31; const f32x4 v = *(const f32x4*)(prev + row * 128 + c4 * 4);
              u32x2 o; o.x = pk2(v[0], v[1]); o.y = pk2(v[2], v[3]); *(LAS u32x2*)(Pimg + row * 136 + c4 * 4) = o; } }
#pragma unroll
        for (int nf = 0; nf < 8; ++nf) { const int s = 16 * nf + fr; const float as = acl[s * 8 + hh], ds = dtl[s * 8 + hh];
#pragma unroll
            for (int r = 0; r < 4; ++r) { const int l = 16 * w + 4 * fq + r; const float v = (s <= l) ? cbm[nf][r] * __expf(acl[l * 8 + hh] - as) * ds : 0.f; Mimg[l * 136 + s] = (short)f2bf(v); } }
        __syncthreads();
        f32x4 a1[4], a2[4];
#pragma unroll
        for (int nn = 0; nn < 4; ++nn) { a1[nn] = (f32x4){0.f, 0.f, 0.f, 0.f}; a2[nn] = (f32x4){0.f, 0.f, 0.f, 0.f}; }
#pragma unroll
        for (int ks = 0; ks < 4; ++ks) { const bf16x8 am = frag_row(Mimg, 136, 16 * w, 32 * ks, lane), ac = frag_row(Cimg, 136, 16 * w, 32 * ks, lane);
#pragma unroll
            for (int nn = 0; nn < 4; ++nn) { const bf16x8 bx = frag_tr(Ximg, 72, 16 * nn, 32 * ks, lane); a1[nn] = MFMA16(am, bx, a1[nn]);
                const bf16x8 bp = frag_row(Pimg, 136, 16 * nn, 32 * ks, lane); a2[nn] = MFMA16(ac, bp, a2[nn]); } }
        const float dsk = F.in[18][head];
#pragma unroll
        for (int r = 0; r < 4; ++r) { const int l = 16 * w + 4 * fq + r; const float el = __expf(acl[l * 8 + hh]);
            bf16_t* zp = proj + (size_t)(tok0 + l) * SSM_N + head * 64 + fr;
            float ss = 0.f;
#pragma unroll
            for (int nn = 0; nn < 4; ++nn) { const float xv = bf2f((unsigned short)Ximg[l * 72 + 16 * nn + fr]); const float y = a1[nn][r] + el * a2[nn][r] + dsk * xv;
                const float z = bf2f(zp[16 * nn]); const float yg = y * siluf_(z); ss += yg * yg; if (!DRY || yg == 1.2345e30f) zp[16 * nn] = (bf16_t)f2bf(yg); }
            ss = row16_sum(ss);
            if (fr == 0) WSP(float, WS_YSLOTS)[(size_t)(tok0 + l) * 32 + head] = ss; }
        __syncthreads();
    }
}


constexpr size_t WS_ST16 = WS_STATES, WS_SP16 = WS_STATES + 64 * MiB;
DI void ssd_state2_unit(const Frame& F, int unit) {
    const int g = unit & 3, bn = unit >> 2, tok0 = bn * CH;
    int tid = F.tid; asm volatile("" : "+v"(tid));
    const int lane = tid & 63, w = F.wave, fr = lane & 15, fq = lane >> 4;
    const bf16_t* xbc = WSP(bf16_t, WS_XBC);
    LAS short* Bimg = (LAS short*)F.lds;
    LAS short* Ximg = Bimg + 128 * 136;
    LAS float* dtl = (LAS float*)(F.lds + (128 * 136 + 128 * LDQ) * 2);
    LAS float* acl = dtl + 1024;
    LAS float* wsc = acl + 1024;
    Tile TX; u32x4 tb[4];
    tile_issue(TX, xbc + (size_t)tok0 * 3072 + g * 512, 3072, tid);
#pragma unroll
    for (int i = 0; i < 4; ++i) { const unsigned c = (unsigned)tid + 512u * i; tb[i] = *(const u32x4*)(xbc + (size_t)(tok0 + (c >> 4)) * 3072 + 2048 + g * 128 + (c & 15u) * 8); }
    ssd_dt_acum(F, tok0, g, dtl, acl);
#pragma unroll
    for (int i = 0; i < 4; ++i) { const unsigned c = (unsigned)tid + 512u * i; *(LAS u32x4*)(Bimg + (c >> 4) * 136 + (c & 15u) * 8) = tb[i]; }
    LBAR();
    for (int i = tid; i < 1024; i += NTHR) wsc[i] = __expf(acl[127 * 8 + (i & 7)] - acl[i]) * dtl[i];
    if (tid < 8) WSP(float, WS_CDEC)[bn * 32 + 8 * g + tid] = __expf(acl[127 * 8 + tid]);
    LBAR();
#pragma unroll 1
    for (int half = 0; half < 2; ++half) {
#pragma unroll
        for (int i = 0; i < 8; ++i) { const unsigned c = (unsigned)tid + 512u * i, row = c >> 5, ch = c & 31u; const float s = wsc[row * 8 + 4 * half + (ch >> 3)]; u32x4 v = TX.v[i];
            v.x = pk2(bflo(v.x) * s, bfhi(v.x) * s); v.y = pk2(bflo(v.y) * s, bfhi(v.y) * s); v.z = pk2(bflo(v.z) * s, bfhi(v.z) * s); v.w = pk2(bflo(v.w) * s, bfhi(v.w) * s);
            *(LAS u32x4*)(Ximg + row * LDQ + ch * 8) = v; }
        LBAR();
        if (half == 0) tile_issue(TX, xbc + (size_t)tok0 * 3072 + g * 512 + 256, 3072, tid);
        const int hl = w >> 1, kn = w & 1;
        f32x4 acc[4][4];
#pragma unroll
        for (int m = 0; m < 4; ++m)
#pragma unroll
            for (int nn = 0; nn < 4; ++nn) acc[m][nn] = (f32x4){0.f, 0.f, 0.f, 0.f};
#pragma unroll
        for (int ks = 0; ks < 4; ++ks) { bf16x8 bb[4];
#pragma unroll
            for (int nn = 0; nn < 4; ++nn) bb[nn] = frag_tr(Bimg, 136, 64 * kn + 16 * nn, 32 * ks, lane);
#pragma unroll
            for (int m = 0; m < 4; ++m) { const bf16x8 a = frag_tr(Ximg, LDQ, hl * 64 + 16 * m, 32 * ks, lane);
#pragma unroll
                for (int nn = 0; nn < 4; ++nn) acc[m][nn] = MFMA16(a, bb[nn], acc[m][nn]); } }
        bf16_t* st = WSP(bf16_t, WS_ST16) + ((size_t)bn * 32 + 8 * g + 4 * half + hl) * 8192;
#pragma unroll
        for (int m = 0; m < 4; ++m)
#pragma unroll
            for (int nn = 0; nn < 4; ++nn) { u32x2 o; o.x = pk2(acc[m][nn][0], acc[m][nn][1]); o.y = pk2(acc[m][nn][2], acc[m][nn][3]);
                *(u32x2*)(st + (64 * kn + 16 * nn + fr) * 64 + 16 * m + 4 * fq) = o; }
        LBAR();
    }
}
template <bool DRY = false>
DI void ssd_scan2(const Frame& F) {
    const u32x4* sv = WSP(u32x4, WS_ST16); u32x4* pv = WSP(u32x4, WS_SP16); const float* cdec = WSP(float, WS_CDEC);
    const int gt = F.gw * 64 + F.lane, NGT = F.NGW * 64;
    for (int i = gt; i < 8 * 32768; i += NGT) {
        const int b = i >> 15, e = i & 32767, h = e >> 10;
        float run[8];
#pragma unroll
        for (int k = 0; k < 8; ++k) run[k] = 0.f;
        const size_t base = (size_t)b * 16 * 32768 + e;
        u32x4 tmp[16];
#pragma unroll
        for (int n = 0; n < 16; ++n) tmp[n] = sv[base + (size_t)n * 32768];
#pragma unroll
        for (int n = 0; n < 16; ++n) { u32x4 o; o.x = pk2(run[0], run[1]); o.y = pk2(run[2], run[3]); o.z = pk2(run[4], run[5]); o.w = pk2(run[6], run[7]);
            if (!DRY || run[0] == 1.2345e30f) pv[base + (size_t)n * 32768] = o;
            const u32x4 t = tmp[n]; const float cd = cdec[(b * 16 + n) * 32 + h];
            run[0] = run[0] * cd + bflo(t.x); run[1] = run[1] * cd + bfhi(t.x); run[2] = run[2] * cd + bflo(t.y); run[3] = run[3] * cd + bfhi(t.y);
            run[4] = run[4] * cd + bflo(t.z); run[5] = run[5] * cd + bfhi(t.z); run[6] = run[6] * cd + bflo(t.w); run[7] = run[7] * cd + bfhi(t.w); }
    }
}
template <bool DRY = false>
DI void ssd_out2_unit(const Frame& F, int unit) {
    const int g = unit & 3, bn = unit >> 2, tok0 = bn * CH;
    int tid = F.tid; asm volatile("" : "+v"(tid));
    const int lane = tid & 63, w = F.wave, fr = lane & 15, fq = lane >> 4;
    const bf16_t* xbc = WSP(bf16_t, WS_XBC); bf16_t* proj = WSP(bf16_t, WS_PROJ);
    LAS short* Cimg = (LAS short*)F.lds;
    LAS short* Mimg = Cimg + 128 * 136;
    LAS short* Ximg = Mimg + 128 * 136;
    LAS short* Pimg = Ximg + 128 * 72;
    LAS short* Zimg = Pimg + 128 * 72;
    LAS float* dtl = (LAS float*)(Zimg + 128 * 72);
    LAS float* acl = dtl + 1024;
    const bf16_t* spbase = WSP(bf16_t, WS_SP16) + ((size_t)bn * 32 + 8 * g) * 8192;
    u32x4 px[2], pp[2], pz[2];
#define SSD2_PREF(hh_) do { const int head_ = 8 * g + (hh_); _Pragma("unroll") for (int i = 0; i < 2; ++i) { const unsigned c = (unsigned)tid + 512u * i, row = c >> 3, ch = c & 7u; \
        px[i] = *(const u32x4*)(xbc + (size_t)(tok0 + row) * 3072 + head_ * 64 + ch * 8); pp[i] = *(const u32x4*)(spbase + (size_t)(hh_) * 8192 + row * 64 + ch * 8); \
        pz[i] = *(const u32x4*)(proj + (size_t)(tok0 + row) * SSM_N + head_ * 64 + ch * 8); } } while (0)
    SSD2_PREF(0);
    ssd_dt_acum(F, tok0, g, dtl, acl);
#pragma unroll
    for (int i = 0; i < 4; ++i) { const unsigned c = (unsigned)tid + 512u * i, row = c >> 4, ch8 = c & 15u;
        *(LAS u32x4*)(Mimg + row * 136 + ch8 * 8) = *(const u32x4*)(xbc + (size_t)(tok0 + row) * 3072 + 2048 + g * 128 + ch8 * 8);
        *(LAS u32x4*)(Cimg + row * 136 + ch8 * 8) = *(const u32x4*)(xbc + (size_t)(tok0 + row) * 3072 + 2560 + g * 128 + ch8 * 8); }
    LBAR();
    f32x4 cbm[8];
#pragma unroll
    for (int nf = 0; nf < 8; ++nf) cbm[nf] = (f32x4){0.f, 0.f, 0.f, 0.f};
#pragma unroll
    for (int ks = 0; ks < 4; ++ks) { const bf16x8 a = frag_row(Cimg, 136, 16 * w, 32 * ks, lane);
#pragma unroll
        for (int nf = 0; nf < 8; ++nf) { const bf16x8 bb = frag_row(Mimg, 136, 16 * nf, 32 * ks, lane); cbm[nf] = MFMA16(a, bb, cbm[nf]); }
        pin(cbm); }
    LBAR();
#pragma unroll 1
    for (int hh = 0; hh < 8; ++hh) {
        const int head = 8 * g + hh;
#pragma unroll
        for (int i = 0; i < 2; ++i) { const unsigned c = (unsigned)tid + 512u * i, row = c >> 3, ch = c & 7u;
            *(LAS u32x4*)(Ximg + row * 72 + ch * 8) = px[i]; *(LAS u32x4*)(Pimg + row * 72 + ch * 8) = pp[i]; *(LAS u32x4*)(Zimg + row * 72 + ch * 8) = pz[i]; }
#pragma unroll
        for (int nf = 0; nf < 8; ++nf) { const int s = 16 * nf + fr; const float as = acl[s * 8 + hh], ds = dtl[s * 8 + hh];
#pragma unroll
            for (int r = 0; r < 4; ++r) { const int l = 16 * w + 4 * fq + r; const float v = (s <= l) ? cbm[nf][r] * __expf(acl[l * 8 + hh] - as) * ds : 0.f; Mimg[l * 136 + s] = (short)f2bf(v); } }
        LBAR();
        if (hh < 7) SSD2_PREF(hh + 1);
        f32x4 a1[4], a2[4];
#pragma unroll
        for (int nn = 0; nn < 4; ++nn) { a1[nn] = (f32x4){0.f, 0.f, 0.f, 0.f}; a2[nn] = (f32x4){0.f, 0.f, 0.f, 0.f}; }
#pragma unroll
        for (int ks = 0; ks < 4; ++ks) { const bf16x8 am = frag_row(Mimg, 136, 16 * w, 32 * ks, lane), ac = frag_row(Cimg, 136, 16 * w, 32 * ks, lane);
#pragma unroll
            for (int nn = 0; nn < 4; ++nn) { const bf16x8 bx = frag_tr(Ximg, 72, 16 * nn, 32 * ks, lane); a1[nn] = MFMA16(am, bx, a1[nn]);
                const bf16x8 bp = frag_tr(Pimg, 72, 16 * nn, 32 * ks, lane); a2[nn] = MFMA16(ac, bp, a2[nn]); }
            pin(a1); pin(a2); }
        const float dsk = F.in[18][head];
#pragma unroll
        for (int r = 0; r < 4; ++r) { const int l = 16 * w + 4 * fq + r; const float el = __expf(acl[l * 8 + hh]);
            float ss = 0.f;
#pragma unroll
            for (int nn = 0; nn < 4; ++nn) { const int p = 16 * nn + fr; const float xv = bf2f((unsigned short)Ximg[l * 72 + p]); const float y = a1[nn][r] + el * a2[nn][r] + dsk * xv;
                const float z = bf2f((unsigned short)Zimg[l * 72 + p]); const float yg = y * siluf_(z); ss += yg * yg; Zimg[l * 72 + p] = (short)f2bf(yg); }
            ss = row16_sum(ss);
            if (fr == 0) WSP(float, WS_YSLOTS)[(size_t)(tok0 + l) * 32 + head] = ss; }
        LBAR();
#pragma unroll
        for (int i = 0; i < 2; ++i) { const unsigned c = (unsigned)tid + 512u * i, row = c >> 3, ch = c & 7u; const u32x4 y = *(const LAS u32x4*)(Zimg + row * 72 + ch * 8);
            if (!DRY || y.x == 0x12345678u) *(u32x4*)(proj + (size_t)(tok0 + row) * SSM_N + head * 64 + ch * 8) = y; }
        LBAR();
    }
#undef SSD2_PREF
}

#ifndef SSD_FUSED
#define SSD_FUSED 1
#endif
template <bool DRY = false>
DI void ssd_fused_unit(const Frame& F, int unit) {
    const int b = unit >> 5, head = unit & 31, g = head >> 3;
    int tid = F.tid; asm volatile("" : "+v"(tid));
    const int lane = tid & 63, w = F.wave, fr = lane & 15, fq = lane >> 4;
    const bf16_t* xbc = WSP(bf16_t, WS_XBC); bf16_t* proj = WSP(bf16_t, WS_PROJ); const float* DT = WSP(float, WS_DT);
    LAS short* Cimg = (LAS short*)F.lds;
    LAS short* Mimg = Cimg + 128 * 136;
    LAS short* Ximg = Mimg + 128 * 136;
    LAS short* Simg = Ximg + 128 * 72;
    LAS short* Pimg = Simg + 128 * 72;
    LAS short* Zimg = Pimg + 128 * 72;
    LAS float* dtl = (LAS float*)(Zimg + 128 * 72);
    LAS float* acl = dtl + 128;
    const float an = -expf(F.in[17][head]), dsk = F.in[18][head];
    f32x4 st[4];
#pragma unroll
    for (int m = 0; m < 4; ++m) st[m] = (f32x4){0.f, 0.f, 0.f, 0.f};
    u32x4 tb[4], tc[4], px[2], pz[2]; float dn0 = 0.f, dn1 = 0.f;
#define SSD3_PREF(n_) do { const int tk_ = (b * 16 + (n_)) * CH; _Pragma("unroll") for (int i = 0; i < 4; ++i) { const unsigned c = (unsigned)tid + 512u * i, row = c >> 4, ch8 = c & 15u; \
            tb[i] = *(const u32x4*)(xbc + (size_t)(tk_ + row) * 3072 + 2048 + g * 128 + ch8 * 8); tc[i] = *(const u32x4*)(xbc + (size_t)(tk_ + row) * 3072 + 2560 + g * 128 + ch8 * 8); } \
        _Pragma("unroll") for (int i = 0; i < 2; ++i) { const unsigned c = (unsigned)tid + 512u * i, row = c >> 3, ch = c & 7u; \
            px[i] = *(const u32x4*)(xbc + (size_t)(tk_ + row) * 3072 + head * 64 + ch * 8); pz[i] = *(const u32x4*)(proj + (size_t)(tk_ + row) * SSM_N + head * 64 + ch * 8); } \
        if (w == 0) { dn0 = DT[(size_t)(tk_ + 2 * lane) * 32 + head]; dn1 = DT[(size_t)(tk_ + 2 * lane + 1) * 32 + head]; } asm volatile("" ::: "memory"); } while (0)
    SSD3_PREF(0);
    const bool tconv = TCONV_IN_SSD && !DRY && F.G == 256;
    const int trow0 = unit * 8 + w;
    f32x4 tg[4]; f32x4 tv[4];
#pragma unroll
    for (int i = 0; i < 4; ++i) { tg[i] = (f32x4){1.f, 1.f, 1.f, 1.f}; tv[i] = (f32x4){0.f, 0.f, 0.f, 0.f}; }
    if (tconv) { const f32x4* g4 = (const f32x4*)(F.in[2] + 1024) + 2 * lane; tg[0] = g4[0]; tg[1] = g4[1]; tg[2] = g4[128]; tg[3] = g4[129]; }
#pragma unroll 1
    for (int n = 0; n < 16; ++n) {
        const int tok0 = (b * 16 + n) * CH;
        const int trow = trow0 + 2048 * n;
#pragma unroll
        for (int i = 0; i < 4; ++i) { const unsigned c = (unsigned)tid + 512u * i, row = c >> 4, ch8 = c & 15u; *(LAS u32x4*)(Mimg + row * 136 + ch8 * 8) = tb[i]; *(LAS u32x4*)(Cimg + row * 136 + ch8 * 8) = tc[i]; }
#pragma unroll
        for (int i = 0; i < 2; ++i) { const unsigned c = (unsigned)tid + 512u * i, row = c >> 3, ch = c & 7u; *(LAS u32x4*)(Ximg + row * 72 + ch * 8) = px[i]; *(LAS u32x4*)(Zimg + row * 72 + ch * 8) = pz[i]; }
#pragma unroll
        for (int m = 0; m < 4; ++m) { u32x2 o; o.x = pk2(st[m][0], st[m][1]); o.y = pk2(st[m][2], st[m][3]); *(LAS u32x2*)(Pimg + (16 * w + fr) * 72 + 16 * m + 4 * fq) = o; }
        if (w == 0) { const float d0 = dn0, d1 = dn1;
            const float a0 = d0 * an, a1 = d1 * an; float sm = a0 + a1;
#pragma unroll
            for (int o = 1; o < 64; o <<= 1) { const float v = __shfl_up(sm, o); if (lane >= o) sm += v; }
            dtl[2 * lane] = d0; dtl[2 * lane + 1] = d1; acl[2 * lane] = sm - a1; acl[2 * lane + 1] = sm; }
        LBAR();
        if (n < 15) SSD3_PREF(n + 1);
        if (tconv) { const float* src = (trow < 16384) ? F.in[23] + ((size_t)16384 + trow) * 1024 : F.in[24] + ((size_t)16384 + (trow - 16384)) * 1024; const f32x4* s4 = (const f32x4*)src + 2 * lane;
            tv[0] = s4[0]; tv[1] = s4[1]; tv[2] = s4[128]; tv[3] = s4[129]; asm volatile("" ::: "memory"); }
        const float alast = acl[127];
#pragma unroll
        for (int i = 0; i < 2; ++i) { const unsigned c = (unsigned)tid + 512u * i, row = c >> 3, ch = c & 7u; const float sc = __expf(alast - acl[row]) * dtl[row]; u32x4 v = *(const LAS u32x4*)(Ximg + row * 72 + ch * 8);
            v.x = pk2(bflo(v.x) * sc, bfhi(v.x) * sc); v.y = pk2(bflo(v.y) * sc, bfhi(v.y) * sc); v.z = pk2(bflo(v.z) * sc, bfhi(v.z) * sc); v.w = pk2(bflo(v.w) * sc, bfhi(v.w) * sc);
            *(LAS u32x4*)(Simg + row * 72 + ch * 8) = v; }
        f32x4 cbm[8];
#pragma unroll
        for (int nf = 0; nf < 8; ++nf) cbm[nf] = (f32x4){0.f, 0.f, 0.f, 0.f};
#pragma unroll
        for (int ks = 0; ks < 4; ++ks) { const bf16x8 a = frag_row(Mimg, 136, 16 * w, 32 * ks, lane);
#pragma unroll
            for (int nf = 0; nf < 8; ++nf) { const bf16x8 bb = frag_row(Cimg, 136, 16 * nf, 32 * ks, lane); cbm[nf] = MFMA16(a, bb, cbm[nf]); }
            pin(cbm); }
        LBAR();
        { f32x4 an4[4];
#pragma unroll
          for (int m = 0; m < 4; ++m) an4[m] = (f32x4){0.f, 0.f, 0.f, 0.f};
#pragma unroll
          for (int ks = 0; ks < 4; ++ks) { const bf16x8 bb = frag_tr(Mimg, 136, 16 * w, 32 * ks, lane);
#pragma unroll
              for (int m = 0; m < 4; ++m) { const bf16x8 a = frag_tr(Simg, 72, 16 * m, 32 * ks, lane); an4[m] = MFMA16(a, bb, an4[m]); }
              pin(an4); }
          const float cd = __expf(alast);
#pragma unroll
          for (int m = 0; m < 4; ++m) st[m] = st[m] * cd + an4[m]; }
        LBAR();
        { const int sb = 16 * w + 4 * fq; const f32x4 as4 = *(const LAS f32x4*)(acl + sb), ds4 = *(const LAS f32x4*)(dtl + sb);
          const float asv[4] = {as4[0], as4[1], as4[2], as4[3]}, dsv[4] = {ds4[0], ds4[1], ds4[2], ds4[3]};
#pragma unroll
          for (int nf = 0; nf < 8; ++nf) { const int l = 16 * nf + fr; const float al = acl[l]; float v[4];
#pragma unroll
              for (int r = 0; r < 4; ++r) v[r] = (sb + r <= l) ? cbm[nf][r] * __expf(al - asv[r]) * dsv[r] : 0.f;
              u32x2 o; o.x = pk2(v[0], v[1]); o.y = pk2(v[2], v[3]); *(LAS u32x2*)(Mimg + l * 136 + sb) = o; } }
        LBAR();
        f32x4 a1[4], a2[4];
#pragma unroll
        for (int np = 0; np < 4; ++np) { a1[np] = (f32x4){0.f, 0.f, 0.f, 0.f}; a2[np] = (f32x4){0.f, 0.f, 0.f, 0.f}; }
#pragma unroll
        for (int ks = 0; ks < 4; ++ks) { const bf16x8 bm = frag_row(Mimg, 136, 16 * w, 32 * ks, lane), bc = frag_row(Cimg, 136, 16 * w, 32 * ks, lane);
#pragma unroll
            for (int np = 0; np < 4; ++np) { const bf16x8 ax = frag_tr(Ximg, 72, 16 * np, 32 * ks, lane); a1[np] = MFMA16(ax, bm, a1[np]);
                const bf16x8 ap = frag_tr(Pimg, 72, 16 * np, 32 * ks, lane); a2[np] = MFMA16(ap, bc, a2[np]); }
            pin(a1); pin(a2); }
        { const int l = 16 * w + fr; const float el = __expf(acl[l]); float ss = 0.f;
#pragma unroll
          for (int np = 0; np < 4; ++np) { const int p0 = 16 * np + 4 * fq; const u32x2 xw = *(const LAS u32x2*)(Ximg + l * 72 + p0), zw = *(const LAS u32x2*)(Zimg + l * 72 + p0);
              const unsigned xw0 = xw.x, xw1 = xw.y, zw0 = zw.x, zw1 = zw.y;
              const float xv[4] = {bflo(xw0), bfhi(xw0), bflo(xw1), bfhi(xw1)}, zv[4] = {bflo(zw0), bfhi(zw0), bflo(zw1), bfhi(zw1)}; float yg[4];
#pragma unroll
              for (int r = 0; r < 4; ++r) { const float y = a1[np][r] + el * a2[np][r] + dsk * xv[r]; yg[r] = y * siluf_(zv[r]); ss += yg[r] * yg[r]; }
              u32x2 o; o.x = pk2(yg[0], yg[1]); o.y = pk2(yg[2], yg[3]); *(LAS u32x2*)(Zimg + l * 72 + p0) = o; }
          ss += __shfl_xor(ss, 16); ss += __shfl_xor(ss, 32);
          if (fq == 0) WSP(float, WS_YSLOTS)[(size_t)(tok0 + l) * 32 + head] = ss; }
        if (tconv) { const bool isu = trow < 16384; const int e = isu ? trow : trow - 16384; const float scl = isu ? PEER_SU : PEER_SV;
            unsigned char* dstb = (isu ? WSP(unsigned char, WS_UB) : WSP(unsigned char, WS_VB)) + (size_t)(lane >> 5) * (16384 * 128) + (size_t)e * 128 + 4 * (lane & 31);
#pragma unroll
            for (int j = 0; j < 2; ++j) { f32x4 a4 = tv[2 * j] * scl, b4 = tv[2 * j + 1] * scl; if (isu) { a4 = a4 * tg[2 * j]; b4 = b4 * tg[2 * j + 1]; }
                unsigned wq = 0;
                wq = __builtin_amdgcn_cvt_scalef32_pk_fp4_f32(wq, a4[0], a4[1], 1.0f, 0); wq = __builtin_amdgcn_cvt_scalef32_pk_fp4_f32(wq, a4[2], a4[3], 1.0f, 1);
                wq = __builtin_amdgcn_cvt_scalef32_pk_fp4_f32(wq, b4[0], b4[1], 1.0f, 2); wq = __builtin_amdgcn_cvt_scalef32_pk_fp4_f32(wq, b4[2], b4[3], 1.0f, 3);
                *(unsigned*)(dstb + (size_t)j * (2 * 16384 * 128)) = wq; } }
        LBAR();
#pragma unroll
        for (int i = 0; i < 2; ++i) { const unsigned c = (unsigned)tid + 512u * i, row = c >> 3, ch = c & 7u; const u32x4 y = *(const LAS u32x4*)(Zimg + row * 72 + ch * 8);
            if (!DRY || y.x == 0x12345678u) *(u32x4*)(proj + (size_t)(tok0 + row) * SSM_N + head * 64 + ch * 8) = y; }
        LBAR();
    }
#undef SSD3_PREF
}


DI void lru_ref_unit(const Frame& F, int unit) {
    if (F.wave != 0) return;
    const int b = unit >> 4, blk = unit & 15, c = F.lane, ch = blk * 64 + c;
    bf16_t* proj = WSP(bf16_t, WS_PROJ);
    LAS float* xs = (LAS float*)F.lds;
    const float* cw = F.in[5]; const float cw0 = cw[ch], cw1 = cw[1024 + ch], cw2 = cw[2048 + ch], cw3 = cw[3072 + ch], cb = F.in[6][ch];
    const float ba = F.in[8][ch], bi = F.in[10][ch], sp = softplusf_(-F.in[11][ch]);
    const float* wa = F.in[7] + blk * 4096; const float* wi = F.in[9] + blk * 4096;
    float x1 = 0.f, x2 = 0.f, x3 = 0.f, h = 0.f;
    for (int t = 0; t < SEQ; ++t) {
        const size_t tok = (size_t)b * SEQ + t;
        const float x0 = bf2f(proj[tok * EVEN_IN + P0_XA + ch]);
        const float xc = cb + cw0 * x3 + cw1 * x2 + cw2 * x1 + cw3 * x0; x3 = x2; x2 = x1; x1 = x0;
        xs[c] = xc;
        float pr = 0.f, pi = 0.f;
        for (int i = 0; i < 64; ++i) { const float xv = xs[i]; pr += xv * wa[i * 64 + c]; pi += xv * wi[i * 64 + c]; }
        const float rg = 1.f / (1.f + expf(-(pr + ba))), ig = 1.f / (1.f + expf(-(pi + bi)));
        const float la = -8.f * rg * sp, a = expf(la), mult = sqrtf(-expm1f(2.f * la));
        h = a * h + mult * (ig * xc);
        bf16_t* gp = proj + tok * EVEN_IN + P0_GA + ch; const float ga = bf2f(*gp);
        *gp = (bf16_t)f2bf(gelu_tanh(ga) * h);
    }
}
DI void ret_ref_unit(const Frame& F, int wu) {
    const int i = wu & 2047, h = (wu >> 11) & 3, b = wu >> 13, lane = F.lane;
    bf16_t* proj = WSP(bf16_t, WS_PROJ);
    const size_t tok = (size_t)b * SEQ + i;
    const float lg = ret_lg(h);
    const u32x2 qw = *(const u32x2*)(proj + tok * EVEN_IN + P0_Q + h * 256 + 4 * lane);
    const float q0 = bflo(qw.x), q1 = bfhi(qw.x), q2 = bflo(qw.y), q3 = bfhi(qw.y);
    float o0 = 0.f, o1 = 0.f, o2 = 0.f, o3 = 0.f;
    for (int j = 0; j <= i; ++j) {
        const size_t tj = (size_t)b * SEQ + j;
        const u32x2 kw = *(const u32x2*)(proj + tj * EVEN_IN + P0_K + h * 256 + 4 * lane);
        const u32x2 vw = *(const u32x2*)(proj + tj * EVEN_IN + P0_V + h * 256 + 4 * lane);
        float s = q0 * bflo(kw.x) + q1 * bfhi(kw.x) + q2 * bflo(kw.y) + q3 * bfhi(kw.y);
        s = wave_sum(s) * expf(lg * (float)(i - j));
        o0 += s * bflo(vw.x); o1 += s * bfhi(vw.x); o2 += s * bflo(vw.y); o3 += s * bfhi(vw.y);
    }
    const float ss = wave_sum(o0 * o0 + o1 * o1 + o2 * o2 + o3 * o3);
    const float rn = rsqrtf(ss * (1.f / 256.f) + EPS);
    bf16_t* gp = proj + tok * EVEN_IN + P0_GB + h * 256 + 4 * lane;
    const u32x2 gw = *(const u32x2*)gp;
    u32x2 ow; ow.x = pk2(siluf_(bflo(gw.x)) * o0 * rn, siluf_(bfhi(gw.x)) * o1 * rn); ow.y = pk2(siluf_(bflo(gw.y)) * o2 * rn, siluf_(bfhi(gw.y)) * o3 * rn);
    *(u32x2*)gp = ow;
}
DI void ssd_ref_unit(const Frame& F, int unit) {
    const int b = unit >> 5, head = unit & 31, g = head >> 3, tid = F.tid, p = tid >> 3, kq = tid & 7;
    const bf16_t* xbc = WSP(bf16_t, WS_XBC); bf16_t* proj = WSP(bf16_t, WS_PROJ); const float* DT = WSP(float, WS_DT);
    LAS float* red = (LAS float*)F.lds;
    const float an = -expf(F.in[17][head]), dsk = F.in[18][head];
    float st[16];
#pragma unroll
    for (int k = 0; k < 16; ++k) st[k] = 0.f;
    for (int t = 0; t < SEQ; ++t) {
        const size_t tok = (size_t)b * SEQ + t;
        const float dt = DT[tok * 32 + head], a = expf(dt * an);
        const float x = bf2f(xbc[tok * 3072 + head * 64 + p]);
        const bf16_t* Bp = xbc + tok * 3072 + 2048 + g * 128 + kq * 16; const bf16_t* Cp = Bp + 512;
        float y = 0.f;
#pragma unroll
        for (int k = 0; k < 16; ++k) { st[k] = a * st[k] + dt * x * bf2f(Bp[k]); y += bf2f(Cp[k]) * st[k]; }
        y += __shfl_xor(y, 1); y += __shfl_xor(y, 2); y += __shfl_xor(y, 4);
        y += dsk * x;
        bf16_t* zp = proj + tok * SSM_N + head * 64 + p;
        const float yg = y * siluf_(bf2f(*zp));
        if (kq == 0) *zp = (bf16_t)f2bf(yg);
        float sq = (kq == 0) ? yg * yg : 0.f;
        sq = wave_sum(sq);
        if (F.lane == 0) red[(t & 1) * 8 + F.wave] = sq;
        __syncthreads();
        if (tid == 0) { float tot = 0.f; for (int w = 0; w < 8; ++w) tot += red[(t & 1) * 8 + w]; WSP(float, WS_YSLOTS)[tok * 32 + head] = tot; for (int hh = 0; hh < 0; ++hh) {} }
    }
    __syncthreads();
}

DI void peer_sel_ref_a(const Frame& F, int layer) {
    const bf16_t* Q = WSP(bf16_t, WS_Q); const float* keys = F.in[22] + (size_t)layer * 8 * 2 * 128 * 64;
    float* TOPV = WSP(float, WS_STATES); int* TOPI = (int*)(TOPV + (size_t)T * 16 * 16);
    const int gt = F.gw * 64 + F.lane, NGT = F.NGW * 64;
    for (int it = gt; it < T * 16; it += NGT) {
        const int t = it >> 4, hp = it & 15;
        float q[64];
#pragma unroll
        for (int k = 0; k < 64; ++k) q[k] = bf2f(Q[(size_t)t * 1024 + hp * 64 + k]);
        float tv[16]; int ti[16];
#pragma unroll
        for (int k = 0; k < 16; ++k) { tv[k] = -INFINITY; ti[k] = 0; }
        for (int n = 0; n < 128; ++n) {
            const float* kr = keys + ((size_t)hp * 128 + n) * 64; float sc = 0.f;
#pragma unroll
            for (int k = 0; k < 64; ++k) sc += q[k] * kr[k];
            float cv = sc; int ci = n;
#pragma unroll
            for (int k = 0; k < 16; ++k) { if (cv > tv[k]) { const float tvv = tv[k]; const int tii = ti[k]; tv[k] = cv; ti[k] = ci; cv = tvv; ci = tii; } }
        }
#pragma unroll
        for (int k = 0; k < 16; ++k) { TOPV[(size_t)it * 16 + k] = tv[k]; TOPI[(size_t)it * 16 + k] = ti[k]; }
    }
}
DI void peer_sel_ref_b(const Frame& F) {
    const float* TOPV = WSP(float, WS_STATES); const int* TOPI = (const int*)(TOPV + (size_t)T * 16 * 16);
    int* EIDX = WSP(int, WS_EIDX); float* GATE = WSP(float, WS_GATE);
    const int gt = F.gw * 64 + F.lane, NGT = F.NGW * 64;
    for (int it = gt; it < T * 8; it += NGT) {
        const int t = it >> 3, h = it & 7;
        const float* v0 = TOPV + ((size_t)t * 16 + 2 * h) * 16; const float* v1 = v0 + 16; const int* i0 = TOPI + ((size_t)t * 16 + 2 * h) * 16; const int* i1 = i0 + 16;
        float tv[16]; int ti[16];
#pragma unroll
        for (int k = 0; k < 16; ++k) { tv[k] = -INFINITY; ti[k] = 0; }
        for (int a = 0; a < 16; ++a) for (int b2 = 0; b2 < 16; ++b2) {
            float cv = v0[a] + v1[b2]; int ci = i0[a] * 128 + i1[b2];
#pragma unroll
            for (int k = 0; k < 16; ++k) { if (cv > tv[k]) { const float tvv = tv[k]; const int tii = ti[k]; tv[k] = cv; ti[k] = ci; cv = tvv; ci = tii; } }
        }
        float sum = 0.f; float ex[16];
#pragma unroll
        for (int k = 0; k < 16; ++k) { ex[k] = expf(tv[k] - tv[0]); sum += ex[k]; }
#pragma unroll
        for (int k = 0; k < 16; ++k) { EIDX[(size_t)t * 128 + h * 16 + k] = ti[k]; GATE[(size_t)t * 128 + h * 16 + k] = ex[k] / sum; }
    }
}

template <bool FINAL>
DI void peer_token_ref(const Frame& F, int layer, int t) {
    const int lane = F.lane;
    const float* U = F.in[23] + (size_t)layer * 16384 * 1024; const float* V = F.in[24] + (size_t)layer * 16384 * 1024; const float* g = F.in[2] + layer * 1024;
    const int* EIDX = WSP(int, WS_EIDX); const float* GATE = WSP(float, WS_GATE);
    float* xo = F.out + (size_t)t * 1024;
    float xv[16], hn[16], o[16]; float ss = 0.f;
#pragma unroll
    for (int j = 0; j < 16; ++j) { xv[j] = xo[lane + 64 * j]; ss += xv[j] * xv[j]; o[j] = 0.f; }
    float rstd = rsqrtf(wave_sum(ss) * (1.f / 1024.f) + EPS);
    const bf16_t* UBt = WSP(bf16_t, WS_UB); const bf16_t* VBt = WSP(bf16_t, WS_VB);
    if (DBG_REF & 32) { float sl = (lane < 16) ? WSP(float, WS_SLOTS)[(size_t)t * 16 + lane] : 0.f; rstd = rsqrtf(wave_sum(sl) * (1.f / 1024.f) + EPS); }
#pragma unroll
    for (int j = 0; j < 16; ++j) hn[j] = (DBG_REF & 32) ? bf2f(WSP(bf16_t, WS_XB)[(size_t)t * 1024 + lane + 64 * j]) * rstd : xv[j] * rstd * g[lane + 64 * j];
    for (int k = 0; k < 128; ++k) {
        const int e = EIDX[(size_t)t * 128 + k]; const float gt = GATE[(size_t)t * 128 + k];
        float d = 0.f;
#pragma unroll
        for (int j = 0; j < 16; ++j) d += hn[j] * ((DBG_REF & 32) ? bf2f(UBt[(size_t)e * 1024 + lane + 64 * j]) : U[(size_t)e * 1024 + lane + 64 * j]);
        d = wave_sum(d);
        const float a = gelu_tanh(d) * gt;
#pragma unroll
        for (int j = 0; j < 16; ++j) o[j] += a * ((DBG_REF & 32) ? bf2f(VBt[(size_t)e * 1024 + lane + 64 * j]) : V[(size_t)e * 1024 + lane + 64 * j]);
    }
    float s2 = 0.f;
#pragma unroll
    for (int j = 0; j < 16; ++j) { o[j] += xv[j]; s2 += o[j] * o[j]; }
    const float rs2 = rsqrtf(wave_sum(s2) * (1.f / 1024.f) + EPS);
    if (FINAL) {
#pragma unroll
        for (int j = 0; j < 16; ++j) xo[lane + 64 * j] = o[j] * rs2 * F.in[3][lane + 64 * j];
    } else {
        if (lane == 0) WSP(float, WS_RSTD)[t] = rs2;
#pragma unroll
        for (int j = 0; j < 16; ++j) { xo[lane + 64 * j] = o[j]; WSP(bf16_t, WS_XB)[(size_t)t * 1024 + lane + 64 * j] = (bf16_t)f2bf(o[j]); }
    }
}

DI void gemm_p1(const Frame& F, int bx) {
        pg8::Gemm g{WSP(bf16_t, WS_XB), WSP(bf16_t, WS_WIN0), T, EVEN_IN, 1024, 1024}; pg8::StaticOrder S; S.init(T, EVEN_IN, F.G, bx);
        pg8::Epi E{WSP(bf16_t, WS_PROJ), EVEN_IN, nullptr, nullptr, nullptr, WSP(float, WS_RSTD), 1, nullptr, WSP(f32x2, WS_ROPE), 12, 20, 16};
        pg8::gemm_phase<pg8::Epi, pg8::StaticOrder, true>(F.lds, g, S, E);
}
DI void gemm_p5(const Frame& F, int bx) {
        pg8::Gemm g{WSP(bf16_t, WS_PROJ), WSP(bf16_t, WS_WOUT0), T, 1024, 2048, EVEN_IN}; pg8::StaticOrder S; S.init(T, 1024, F.G, bx);
        pg8::Epi E{WSP(bf16_t, WS_XB), 1024, nullptr, F.in[0], nullptr, nullptr, 0, WSP(float, WS_SLOTS), nullptr, 0, 0, 0};
        pg8::gemm_phase<pg8::Epi, pg8::StaticOrder, true>(F.lds, g, S, E);
}
DI void gemm_p6(const Frame& F, int bx) {
        pg8::Gemm g{WSP(bf16_t, WS_XB), WSP(bf16_t, WS_WQ0), T, 1024, 1024, 1024}; pg8::StaticOrder S; S.init(T, 1024, F.G, bx);
        pg8::Epi E{WSP(bf16_t, WS_Q), 1024, nullptr, nullptr, nullptr, WSP(float, WS_SLOTS), 2, nullptr, nullptr, 0, 0, 0};
        pg8::gemm_phase<pg8::Epi, pg8::StaticOrder, true>(F.lds, g, S, E);
}
DI void gemm_p9(const Frame& F, int bx) {
        pg8::Gemm g{WSP(bf16_t, WS_XB), WSP(bf16_t, WS_WIN1), T, SSM_N, 1024, 1024}; pg8::StaticOrder S; S.init(T, SSM_N, F.G, bx);
        pg8::Epi E{WSP(bf16_t, WS_PROJ), SSM_N, nullptr, nullptr, nullptr, (PEER_SPLIT && PEER_VSLICE && !PEER_OWNED) ? WSP(float, WS_SLOTS2) : WSP(float, WS_RSTD), (PEER_SPLIT && PEER_VSLICE && !PEER_OWNED) ? 2 : 1, nullptr, nullptr, 0, 0, 0};
        pg8::gemm_phase<pg8::Epi, pg8::StaticOrder, true>(F.lds, g, S, E);
        if (F.G == 256) { if (F.wave < 4) dt_unit(F, (F.vcu >> 5) * 128 + (F.vcu & 31) * 4 + F.wave); }
        else for (int u = F.wave * F.G + F.vcu; u < T / 16; u += F.NGW) dt_unit(F, u);
}
DI void gemm_p14(const Frame& F, int bx) {
        pg8::Gemm g{WSP(bf16_t, WS_PROJ), WSP(bf16_t, WS_WOUT1), T, 1024, 2048, SSM_N}; pg8::StaticOrder S; S.init(T, 1024, F.G, bx);
        pg8::Epi E{WSP(bf16_t, WS_XB), 1024, nullptr, nullptr, WSP(bf16_t, WS_XB), WSP(float, WS_YSLOTS), 3, WSP(float, WS_SLOTS), nullptr, 0, 0, 0};
        pg8::gemm_phase<pg8::Epi, pg8::StaticOrder, true>(F.lds, g, S, E);
}
DI void gemm_p15(const Frame& F, int bx) {
        pg8::Gemm g{WSP(bf16_t, WS_XB), WSP(bf16_t, WS_WQ1), T, 1024, 1024, 1024}; pg8::StaticOrder S; S.init(T, 1024, F.G, bx);
        pg8::Epi E{WSP(bf16_t, WS_Q), 1024, nullptr, nullptr, nullptr, WSP(float, WS_SLOTS), 2, nullptr, nullptr, 0, 0, 0};
        pg8::gemm_phase<pg8::Epi, pg8::StaticOrder, true>(F.lds, g, S, E);
        if (!(TCONV_IN_SSD && F.G == 256 && !(DBG_REF & 4))) convert_tables(F, 1);
}

static_assert(PEER_FP4 && !(DBG_REF & 16), "the residual stream lives in XB (bf16): only the fp4 gather path reads it from there");
DI void topk_own_tiles(const Frame& F, int layer, int bx) {
    pg8::StaticOrder S; S.init(T, 1024, F.G, bx); pg8::Unit u;
    for (int i = 0; S.next(i, u); ++i)
        peer_topk3_tile(F, layer, u.pm, u.pn, TCONV0_IN_TOPK && layer == 0 && i == 0 && F.G == 256);
}
constexpr int NPHASE = 18;
__global__ void __launch_bounds__(NTHR, 2) fwd_kernel(Args args) {
    extern __shared__ __attribute__((aligned(16))) unsigned char lds_raw[];
    Frame F;
    F.lds = (LAS unsigned char*)lds_raw;
    F.tid = threadIdx.x; F.lane = F.tid & 63; F.wave = __builtin_amdgcn_readfirstlane(F.tid >> 6);
    F.G = gridDim.x; { const int bx = blockIdx.x; F.vcu = (F.G % 8 == 0) ? (bx % 8) * (F.G / 8) + bx / 8 : bx; }
    F.gw = F.vcu * NWAVES + F.wave; F.NGW = F.G * NWAVES;
    F.in = args.in; F.out = args.out; F.ws = args.ws;
    volatile LAS unsigned* MISC = (volatile LAS unsigned*)(F.lds + MISC_OFF);
    if (F.tid < 64) ((LAS unsigned*)(F.lds + MISC_OFF))[F.tid] = 0u;
    __syncthreads();
    unsigned* ctl = (unsigned*)(args.ws + WS_CTL);
    XcdBarrier bar = xcd_barrier_post(ctl + CW_BAR, MISC + 8);
    const int lo = args.ph_lo, hi = args.ph_hi;
    if (LOCAL_SEAMS != 0 && F.tid == 0 && F.G == 256) __hip_atomic_store(ctl + CW_GRPX + F.vcu, xb_xcc_id() + 1u, __ATOMIC_RELAXED, __HIP_MEMORY_SCOPE_AGENT);
#ifndef PHASE_MASK
#define PHASE_MASK 0x3ffff
#endif
#define IN(k) ((((PHASE_MASK) >> (k)) & 1) && lo <= (k) && (k) < hi)
#define SEAM(k) do { if (IN(k) && IN((k) + 1)) { xcd_barrier(bar, (((LOCAL_SEAMS) >> (k)) & 1) && MISC[12] != 0u); if ((REPEAT_MASK >> 21) & 1) xcd_barrier(bar); } } while (0)
    const int bx = (int)blockIdx.x;

    if (IN(0)) { p0_prologue(F); if (REPEAT_MASK & 1) p0_prologue(F); } SEAM(0);
    if (LOCAL_SEAMS != 0 && IN(0) && IN(1)) {
        if (F.tid < 64) { bool bad = false;
#pragma unroll
            for (int k = 0; k < 4; ++k) { const unsigned v = (F.G == 256) ? xb_ld(ctl + CW_GRPX + F.tid + 64 * k) : 0u; const unsigned first = (unsigned)__shfl((int)v, F.tid & 32); bad = bad || (v == 0u) || (v != first); }
            const bool okall = (__ballot(bad) == 0ull) && SSD_FUSED && DBG_REF == 0 && REPEAT_MASK == 0 && F.G == 256;
            if (F.tid == 0) MISC[12] = okall ? 1u : 0u; }
        __syncthreads(); }
    if (IN(1)) { gemm_p1(F, bx); if ((REPEAT_MASK >> 1) & 1) gemm_p1(F, bx); } SEAM(1);
    if (IN(2)) {
        const bool lru_first = (DBG_REF == 0) && (REPEAT_MASK == 0) && F.G == 256 && ((F.vcu >> 5) & 1);
        if (!lru_first) { if (!(DBG_REF & 2)) REP(2) ret_kv2_phase(F); }
        if (DBG_REF & 1) { for (int u = F.vcu; u < 128; u += F.G) lru_ref_unit(F, u); __syncthreads(); }
        else { if ((REPEAT_MASK >> 18) & 1) for (int u = F.vcu; u < 256; u += F.G) lru2_unit<true>(F, u);
               for (int u = F.vcu; u < 256; u += F.G) lru2_unit(F, u); }
        if (lru_first) ret_kv2_phase(F);
    } SEAM(2);
    if (IN(3)) { if (!(DBG_REF & 2)) { if ((REPEAT_MASK >> 3) & 1) ret_scan2<true>(F); ret_scan2(F); } } SEAM(3);
    if (IN(4)) { if (DBG_REF & 2) { for (int u = F.gw; u < 65536; u += F.NGW) ret_ref_unit(F, u); } else { if ((REPEAT_MASK >> 4) & 1) for (int u = F.vcu; u < 512; u += F.G) ret_out2_unit<true>(F, u); if (F.G == 256) { for (int r = 0; r < 2; ++r) ret_out2_unit(F, (F.vcu >> 5) * 64 + (F.vcu & 31) + 32 * r); } else for (int u = F.vcu; u < 512; u += F.G) ret_out2_unit(F, u); } } SEAM(4);
    if (IN(5)) { gemm_p5(F, bx); if ((REPEAT_MASK >> 5) & 1) gemm_p5(F, bx); } SEAM(5);
    if (IN(6)) { gemm_p6(F, bx); if ((REPEAT_MASK >> 6) & 1) gemm_p6(F, bx);
        if (!(DBG_REF & 8)) { topk_own_tiles(F, 0, bx); if ((REPEAT_MASK >> 7) & 1) topk_own_tiles(F, 0, bx); } }
    if (DBG_REF & 8) { SEAM(6); if (IN(7)) { peer_sel_ref_a(F, 0); xcd_barrier(bar); peer_sel_ref_b(F); } }
    SEAM(7);
    if (IN(8)) {
#if PEER_SPLIT
        if (PEER_OWNED && PEER_VSLICE && T == 8 * F.NGW) { peer_u_owned(F); asm volatile("s_waitcnt vmcnt(0)\n\tbuffer_inv sc0\n\ts_waitcnt vmcnt(0)" ::: "memory"); peer_v_mfma_final<false>(F); }
        else {
        peer_u_phase(F); if ((REPEAT_MASK >> 19) & 1) peer_u_phase(F);
        xcd_barrier(bar);
        if (PEER_VSLICE) { if ((REPEAT_MASK >> 8) & 1) peer_v_mfma_phase<true>(F); peer_v_mfma_phase(F); }
        else { if ((REPEAT_MASK >> 8) & 1) for (int t = F.gw; t < T; t += F.NGW) peer_v_token<false, true>(F, t);
               for (int t = F.gw; t < T; t += F.NGW) peer_v_token<false>(F, t); }
        }
#else
        if ((REPEAT_MASK >> 8) & 1) for (int t = F.gw; t < T; t += F.NGW) { if (PEER_FP4) peer_token4<false, true>(F, t); else peer_token8<false, true>(F, t); }
        for (int t = F.gw; t < T; t += F.NGW) { if (DBG_REF & 16) peer_token_ref<false>(F, 0, t); else if (PEER_FP4) peer_token4<false>(F, t); else peer_token8<false>(F, t); }
#endif
    } SEAM(8);
    if (IN(9)) { gemm_p9(F, bx); if ((REPEAT_MASK >> 9) & 1) gemm_p9(F, bx); } SEAM(9);
    if (IN(10)) { REP(10) for (int u = F.vcu; u < T / 64; u += F.G) conv_dt_unit(F, u); } SEAM(10);
    if (SSD_FUSED && !(DBG_REF & 4)) { if (IN(13)) { if ((REPEAT_MASK >> 13) & 1) for (int u = F.vcu; u < 256; u += F.G) ssd_fused_unit<true>(F, u); for (int u = F.vcu; u < 256; u += F.G) ssd_fused_unit(F, u); } if (IN(10) && IN(13)) {} }
    else {
    if (IN(11)) { if (!(DBG_REF & 4)) REP(11) for (int u = F.vcu; u < 512; u += F.G) ssd_state2_unit(F, u); } SEAM(11);
    if (IN(12)) { if (!(DBG_REF & 4)) { if ((REPEAT_MASK >> 12) & 1) ssd_scan2<true>(F); ssd_scan2(F); } } SEAM(12);
    if (IN(13)) { if (DBG_REF & 4) { for (int u = F.vcu; u < 256; u += F.G) ssd_ref_unit(F, u); } else { if ((REPEAT_MASK >> 13) & 1) for (int u = F.vcu; u < 512; u += F.G) ssd_out2_unit<true>(F, u); for (int u = F.vcu; u < 512; u += F.G) ssd_out2_unit(F, u); } } SEAM(13);
    }
    if (SSD_FUSED && !(DBG_REF & 4)) { SEAM(13); }
    if (IN(14)) { gemm_p14(F, bx); } SEAM(14);
    if (IN(15)) { gemm_p15(F, bx); if ((REPEAT_MASK >> 15) & 1) gemm_p15(F, bx);
        if (!(DBG_REF & 8)) { topk_own_tiles(F, 1, bx); if ((REPEAT_MASK >> 16) & 1) topk_own_tiles(F, 1, bx); } }
    if (DBG_REF & 8) { SEAM(15); if (IN(16)) { peer_sel_ref_a(F, 1); xcd_barrier(bar); peer_sel_ref_b(F); } }
    SEAM(16);
    if (IN(17)) {
        const unsigned bad = xb_ld(ctl + CW_BAR + XB_TMO);
#if PEER_SPLIT
        if (PEER_OWNED && PEER_VSLICE && T == 8 * F.NGW) { peer_u_owned(F); asm volatile("s_waitcnt vmcnt(0)\n\tbuffer_inv sc0\n\ts_waitcnt vmcnt(0)" ::: "memory"); peer_v_mfma_final<true>(F); }
        else {
        peer_u_phase(F); if ((REPEAT_MASK >> 19) & 1) peer_u_phase(F);
        xcd_barrier(bar);
        if (PEER_VSLICE && T == 8 * F.NGW) peer_v_mfma_final<true>(F);
        else { if ((REPEAT_MASK >> 17) & 1) for (int t = F.gw; t < T; t += F.NGW) peer_v_token<true, true>(F, t);
               for (int t = F.gw; t < T; t += F.NGW) peer_v_token<true>(F, t); }
        }
#else
        if ((REPEAT_MASK >> 17) & 1) for (int t = F.gw; t < T; t += F.NGW) { if (PEER_FP4) peer_token4<true, true>(F, t); else peer_token8<true, true>(F, t); }
        for (int t = F.gw; t < T; t += F.NGW) { if (DBG_REF & 16) peer_token_ref<true>(F, 1, t); else if (PEER_FP4) peer_token4<true>(F, t); else peer_token8<true>(F, t); }
#endif
        if (bad) { const float q = __builtin_nanf(""); for (int t = F.gw; t < T; t += F.NGW) F.out[(size_t)t * 1024 + F.lane] = q; }
    }
#undef IN
#undef SEAM
}

extern "C" void kernel_launch(void* const* d_in, const int* in_sizes, int n_in, void* d_out, int out_size, void* d_ws, size_t ws_size, hipStream_t stream) {
    static int grid = 0;
    if (grid == 0) {
        if (n_in != 25 || in_sizes[0] != T * D || out_size != T * D || ws_size < WS_END) { fprintf(stderr, "kernel_launch: unexpected shapes (n_in %d, in0 %d, out %d, ws %zu)\n", n_in, n_in > 0 ? in_sizes[0] : -1, out_size, ws_size); grid = -1; return; }
        int dev = 0, cus = 0, per_cu = 0;
        if (hipGetDevice(&dev) != hipSuccess || hipDeviceGetAttribute(&cus, hipDeviceAttributeMultiprocessorCount, dev) != hipSuccess) { grid = -1; return; }
        if (hipFuncSetAttribute((const void*)fwd_kernel, hipFuncAttributeMaxDynamicSharedMemorySize, LDS_BYTES) != hipSuccess) { fprintf(stderr, "kernel_launch: hipFuncSetAttribute failed\n"); grid = -1; return; }
        if (hipOccupancyMaxActiveBlocksPerMultiprocessor(&per_cu, (const void*)fwd_kernel, NTHR, LDS_BYTES) != hipSuccess || per_cu < 1) fprintf(stderr, "kernel_launch: occupancy query reports %d\n", per_cu);
        (void)hipGetLastError();
        grid = cus;
    }
    if (grid < 0) return;
    (void)hipMemsetAsync((char*)d_ws + WS_CTL, 0, CTL_ZERO_BYTES, stream);
    Args a{};
    for (int i = 0; i < 25; ++i) a.in[i] = (const float*)d_in[i];
    a.out = (float*)d_out; a.ws = (unsigned char*)d_ws; a.ph_lo = 0; a.ph_hi = NPHASE;
    hipLaunchKernelGGL(fwd_kernel, dim3(grid), dim3(NTHR), LDS_BYTES, stream, a);
}
```

```cpp
#include <hip/hip_runtime.h>
#include <cstdio>
#include <cstdint>

#ifndef DBG_REF
#define DBG_REF 0
#endif
#ifndef REPEAT_MASK
#define REPEAT_MASK 0
#endif
#define REP(k) for (int rep_ = 0; rep_ < ((((REPEAT_MASK) >> (k)) & 1) + 1); ++rep_)
#ifndef DBG_SKIP
#define DBG_SKIP 0
#endif
#ifndef PEER_VSLICE
#define PEER_VSLICE 1
#endif
#ifndef PEER_OWNED
#define PEER_OWNED 1
#endif
#ifndef PEER_SPLIT
#define PEER_SPLIT 1
#endif
#ifndef LOCAL_SEAMS
#define LOCAL_SEAMS ((1<<1)|(1<<2)|(1<<3)|(1<<4)|(1<<5)|(1<<9)|(1<<10)|(1<<13)|(1<<14))
#endif
#define DI __device__ __forceinline__
#define LAS __attribute__((address_space(3)))
typedef unsigned short bf16_t;
typedef short bf16x8 __attribute__((ext_vector_type(8)));
typedef short s16x4 __attribute__((ext_vector_type(4)));
typedef float f32x4 __attribute__((ext_vector_type(4)));
typedef float f32x2 __attribute__((ext_vector_type(2)));
typedef unsigned u32x4 __attribute__((ext_vector_type(4)));
typedef unsigned u32x2 __attribute__((ext_vector_type(2)));
typedef __bf16 bf2_t __attribute__((ext_vector_type(2)));

constexpr int T = 16384, D = 1024, SEQ = 2048, NB = 8, NCH = 16, CH = 128;
constexpr int EVEN_IN = 6144, SSM_IN = 5152, SSM_N = 5120;
constexpr float EPS = 1e-6f;
constexpr int NWAVES = 8, NTHR = 512;

constexpr size_t MiB = 1u << 20;
constexpr size_t WS_CTL = 0, CTL_ZERO_BYTES = 1 * MiB;
constexpr size_t WS_RSTD = 1 * MiB;
constexpr size_t WS_SLOTS = 2 * MiB;
constexpr size_t WS_YSLOTS = 3 * MiB;
constexpr size_t WS_ROPE = 5 * MiB;
constexpr size_t WS_LRUW = 7 * MiB;
constexpr size_t WS_KEYS = 7 * MiB + 512 * 1024;
constexpr size_t WS_WDT = 8 * MiB + 512 * 1024;
constexpr size_t WS_DT = 9 * MiB;
constexpr size_t WS_CDEC = 11 * MiB;
constexpr size_t WS_WIN0 = 16 * MiB;
constexpr size_t WS_WOUT0 = 28 * MiB;
constexpr size_t WS_WIN1 = 32 * MiB;
constexpr size_t WS_WOUT1 = 42 * MiB;
constexpr size_t WS_WQ0 = 46 * MiB, WS_WQ1 = 48 * MiB;
constexpr size_t WS_UB = 52 * MiB, WS_VB = 84 * MiB;
constexpr size_t WS_XB = 468 * MiB;
#ifndef SSD_FUSED
#define SSD_FUSED 1
#endif
#define TCONV0_IN_TOPK (PEER_SPLIT && PEER_VSLICE && PEER_OWNED)
#define TCONV_IN_SSD (SSD_FUSED && PEER_SPLIT && PEER_VSLICE && PEER_OWNED)
constexpr size_t WS_XBC = SSD_FUSED ? 340 * MiB : 52 * MiB;
constexpr size_t WS_PROJ = 148 * MiB;
constexpr size_t WS_Q = SSD_FUSED ? 92 * MiB : 148 * MiB;
constexpr size_t WS_EIDX = SSD_FUSED ? 124 * MiB : 180 * MiB;
constexpr size_t WS_GATE = SSD_FUSED ? 132 * MiB : 188 * MiB;
constexpr size_t WS_STATES = 340 * MiB;
constexpr size_t WS_END = 500 * MiB;

constexpr int CW_TMO = 0, CW_CODE = 1, CW_GRPX = 2048  , CW_BAR = 4096;

constexpr int LDS_BYTES = 147456, MISC_OFF = LDS_BYTES - 256;

DI unsigned pk2(float lo, float hi) { const f32x2 v = {lo, hi}; return __builtin_bit_cast(unsigned, __builtin_convertvector(v, bf2_t)); }
DI unsigned f2bf(float f) { return pk2(f, f) & 0xffffu; }

DI float bf2f(unsigned short h) { return __builtin_bit_cast(float, (unsigned)h << 16); }
DI float bflo(unsigned w) { return __builtin_bit_cast(float, w << 16); }
DI float bfhi(unsigned w) { return __builtin_bit_cast(float, w & 0xffff0000u); }
DI float dot2bf(unsigned a, unsigned b, float c) { return __builtin_amdgcn_fdot2_f32_bf16(__builtin_bit_cast(bf2_t, a), __builtin_bit_cast(bf2_t, b), c, false); }
DI float row16_sum(float v) {
    v += __builtin_bit_cast(float, __builtin_amdgcn_update_dpp(0, __builtin_bit_cast(int, v), 0xB1, 0xf, 0xf, false));
    v += __builtin_bit_cast(float, __builtin_amdgcn_update_dpp(0, __builtin_bit_cast(int, v), 0x4E, 0xf, 0xf, false));
    v += __builtin_bit_cast(float, __builtin_amdgcn_update_dpp(0, __builtin_bit_cast(int, v), 0x141, 0xf, 0xf, false));
    v += __builtin_bit_cast(float, __builtin_amdgcn_update_dpp(0, __builtin_bit_cast(int, v), 0x140, 0xf, 0xf, false));
    return v;
}
DI float wave_sum(float v) {
#pragma unroll
    for (int o = 1; o < 64; o <<= 1) v += __shfl_xor(v, o);
    return v;
}
DI float wave_scan_incl(float v) {
#define DPPF(x_, ctrl_, rmask_, bc_) __builtin_bit_cast(float, __builtin_amdgcn_update_dpp(0, __builtin_bit_cast(int, (x_)), (ctrl_), (rmask_), 0xf, (bc_)))
    v += DPPF(v, 0x111, 0xf, true); v += DPPF(v, 0x112, 0xf, true); v += DPPF(v, 0x114, 0xf, true); v += DPPF(v, 0x118, 0xf, true);
    v += DPPF(v, 0x142, 0xa, false);
    v += DPPF(v, 0x143, 0xc, false);
#undef DPPF
    return v;
}
DI float frcp(float x) { return __builtin_amdgcn_rcpf(x); }
DI float sigmoidf_(float x) { return frcp(1.f + __expf(-x)); }
DI float siluf_(float x) { return x * frcp(1.f + __expf(-x)); }
DI float gelu_tanh(float x) { const float u = (x * x) * (-2.f * 0.7978845608028654f * 0.044715f * 1.4426950408889634f) + (-2.f * 0.7978845608028654f * 1.4426950408889634f); return x * frcp(1.f + __builtin_amdgcn_exp2f(x * u)); }
DI float softplusf_(float x) { return x > 0.f ? x + log1pf(expf(-x)) : log1pf(expf(x)); }

DI bf16x8 frag_row(const LAS short* img, int ld, int row0, int k0, int lane) {
    return *(const LAS bf16x8*)(img + (row0 + (lane & 15)) * ld + k0 + 8 * (lane >> 4));
}
DI bf16x8 frag_tr(const LAS short* img, int ld, int x0, int k0, int lane) {
    const int g = lane >> 4, q = (lane & 15) >> 2, p = lane & 3;
    const LAS short* a = img + (k0 + 8 * g + q) * ld + x0 + 4 * p;
    const s16x4 lo = __builtin_amdgcn_ds_read_tr16_b64_v4i16((LAS s16x4*)a);
    const s16x4 hi = __builtin_amdgcn_ds_read_tr16_b64_v4i16((LAS s16x4*)(a + 4 * ld));
    return __builtin_shufflevector(lo, hi, 0, 1, 2, 3, 4, 5, 6, 7);
}
#define MFMA16(a, b, c) __builtin_amdgcn_mfma_f32_16x16x32_bf16((a), (b), (c), 0, 0, 0)
template <int N> DI void pin(f32x4 (&a)[N]) {
#pragma unroll
    for (int i = 0; i < N; ++i) asm volatile("" : "+v"(a[i]));
}

namespace pg8 {
#define PG8_LAS __attribute__((address_space(3)))
constexpr int BM = 256, BK = 64, HALF = 128, HTB = HALF * BK * 2, STAGE_BYTES = 8 * HTB, NXCD = 8, WGM = 8;
__host__ __device__ __forceinline__ int lds_byte(int r, int c) { const int st = (r >> 4) * 2 + (c >> 5), rr = r & 15, cc = c & 31, ob = rr * 64 + cc * 2; return st * 1024 + (ob ^ (((ob >> 9) & 1) << 5)); }
__host__ __device__ __forceinline__ void stage_rc(int b, int& R, int& C) { const int st = b / 1024, sb = b % 1024, swz = sb ^ (((sb >> 9) & 1) << 5); R = (st >> 1) * 16 + swz / 64; C = (st & 1) * 32 + (swz % 64) / 2; }
__host__ __device__ __forceinline__ int perm32(int rho) { const int n = rho >> 4, i = rho & 15; return 8 * (i >> 2) + 4 * n + (i & 3); }
struct Unit { int pm, pn; };
struct Gemm { const bf16_t* A; const bf16_t* Bt; int M, N, K, lda; };
struct StaticOrder {
    int nM, nN, nwg, G, c;
    __host__ __device__ void init(int M, int N, int G_, int c_) { nM = M / BM; nN = N / BM; nwg = nM * nN; G = G_; c = c_; }
    __host__ __device__ bool next(int i, Unit& u) const {
        const long L = (long)i * G + c; if (L >= nwg) return false;
        int wgid = (int)L; { const int q = nwg / NXCD, r = nwg % NXCD, xcd = wgid % NXCD, off = wgid / NXCD; wgid = (xcd < r ? xcd * (q + 1) : r * (q + 1) + (xcd - r) * q) + off; }
        const int nig = WGM * nN, gid = wgid / nig, fm = gid * WGM, gsz = (nM - fm) < WGM ? (nM - fm) : WGM;
        u.pm = fm + ((wgid % nig) % gsz); u.pn = (wgid % nig) / gsz; return true;
    }
};
DI unsigned cvt_pk_bf16(float lo, float hi) { return pk2(lo, hi); }

struct Epi {
    static constexpr bool PERM = true;
    bf16_t* O; int ldo;
    float* F32; const float* RES; const bf16_t* RESB;
    const float* rs; int rs_mode;
    float* ssq;
    const f32x2* rope; int rope_lo, rope_hi, q_hi;
    DI void operator()(const f32x4 (&acc)[2][2][4][2], const Unit& u, int wr, int wc, int fr, int fq) const {
        const bool do_rope = rope != nullptr && u.pn >= rope_lo && u.pn < rope_hi;
        const float qs = (do_rope && u.pn < q_hi) ? 0.0625f : 1.f;
        const int col0 = u.pn * BM + wc * 32 + 8 * fq;
#pragma unroll
        for (int ai = 0; ai < 2; ++ai)
#pragma unroll
            for (int m = 0; m < 4; ++m) {
                const int row = u.pm * BM + ai * HALF + wr * 64 + m * 16 + fr;
                float sc = 1.f;
                if (rs_mode == 1) sc = rs[row];
                else if (rs_mode == 2) { const f32x4 v = *(const f32x4*)(rs + (size_t)row * 16 + 4 * fq); float s = (v[0] + v[1]) + (v[2] + v[3]); s += __shfl_xor(s, 16); s += __shfl_xor(s, 32); sc = rsqrtf(s * (1.f / 1024.f) + EPS); }
                else if (rs_mode == 3) { const f32x4 v = *(const f32x4*)(rs + (size_t)row * 32 + 8 * fq), w = *(const f32x4*)(rs + (size_t)row * 32 + 8 * fq + 4); float s = ((v[0] + v[1]) + (v[2] + v[3])) + ((w[0] + w[1]) + (w[2] + w[3])); s += __shfl_xor(s, 16); s += __shfl_xor(s, 32); sc = rsqrtf(s * (1.f / 2048.f) + EPS); }
                f32x4 v[2][2];
#pragma unroll
                for (int bj = 0; bj < 2; ++bj)
#pragma unroll
                    for (int n = 0; n < 2; ++n) v[bj][n] = acc[ai][bj][m][n] * sc;
                if (do_rope) {
                    const int pos = row & (SEQ - 1);
                    const f32x2* tp = rope + (size_t)pos * 128 + wc * 32 + 8 * fq;
#pragma unroll
                    for (int n = 0; n < 2; ++n)
#pragma unroll
                        for (int j = 0; j < 4; ++j) { const f32x2 cs = tp[4 * n + j]; const float x1 = v[0][n][j], x2 = v[1][n][j]; v[0][n][j] = (x1 * cs.x - x2 * cs.y) * qs; v[1][n][j] = (x1 * cs.y + x2 * cs.x) * qs; }
                }
                if (RES || RESB) {
                    float s = 0.f;
#pragma unroll
                    for (int bj = 0; bj < 2; ++bj)
#pragma unroll
                        for (int n = 0; n < 2; ++n) { const size_t off = (size_t)row * 1024 + col0 + bj * HALF + 4 * n; f32x4 r;
                            if (RES) r = *(const f32x4*)(RES + off);
                            else { const u32x2 rb = *(const u32x2*)(RESB + off); r = (f32x4){bflo(rb.x), bfhi(rb.x), bflo(rb.y), bfhi(rb.y)}; }
                            v[bj][n] = v[bj][n] + r; if (F32) *(f32x4*)(F32 + off) = v[bj][n];
                            s += (v[bj][n][0] * v[bj][n][0] + v[bj][n][1] * v[bj][n][1]) + (v[bj][n][2] * v[bj][n][2] + v[bj][n][3] * v[bj][n][3]); }
                    if (ssq) { s += __shfl_xor(s, 16); s += __shfl_xor(s, 32); if (fq == 0) ssq[(size_t)row * 16 + u.pn * 4 + wc] = s; }
                }
                if (O) {
#pragma unroll
                    for (int bj = 0; bj < 2; ++bj) { u32x4 w; w.x = cvt_pk_bf16(v[bj][0][0], v[bj][0][1]); w.y = cvt_pk_bf16(v[bj][0][2], v[bj][0][3]); w.z = cvt_pk_bf16(v[bj][1][0], v[bj][1][1]); w.w = cvt_pk_bf16(v[bj][1][2], v[bj][1][3]);
                        *(u32x4*)(O + (size_t)row * ldo + col0 + bj * HALF) = w; }
                }
            }
    }
};

template <class EpiT, class Sched, bool ALIGN_EPI>
DI void gemm_phase(PG8_LAS unsigned char* lds, const Gemm g, const Sched& S, const EpiT& E) {
    const int tid = threadIdx.x, wid = __builtin_amdgcn_readfirstlane(tid >> 6), lane = tid & 63, wr = wid >> 2, wc = wid & 3, fr = lane & 15, fq = lane >> 4;
    const int K = g.K, nt = K / BK, lda = g.lda;
    unsigned voffA[2], voffB[2];
#pragma unroll
    for (int i = 0; i < 2; ++i) { int R, C; stage_rc(tid * 16 + i * 8192, R, C); const int Rb = EpiT::PERM ? ((R & ~31) + perm32(R & 31)) : R;
        voffA[i] = (unsigned)(R * lda + C) * 2u; voffB[i] = (unsigned)(Rb * K + C) * 2u; }
    const size_t kstep = (size_t)(BK * 2);
    const size_t hstepA = (size_t)HALF * lda * 2, tstepA = 2 * hstepA;
    const size_t hstepB = (size_t)HALF * K * 2, tstepB = 2 * hstepB;
    const unsigned ldsw = (unsigned)wid * 1024u;
    const int aoff = lds_byte(wr * 64 + fr, fq * 8), boff = lds_byte(wc * 32 + fr, fq * 8);
#define PG8_SA(b, h) (((b) * 2 + (h)) * HTB)
#define PG8_SB(b, h) ((4 + (b) * 2 + (h)) * HTB)
#define PG8_STAGE(bufoff, gbase, voff) do { _Pragma("unroll") for (int _i = 0; _i < 2; ++_i) \
        __builtin_amdgcn_global_load_lds((const unsigned*)((const char*)(gbase) + (voff)[_i]), (PG8_LAS unsigned*)(lds + (bufoff) + ldsw + _i * 8192), 16, 0, 0); } while (0)
#define PG8_LDA(dst, b, h) do { _Pragma("unroll") for (int m = 0; m < 4; ++m) _Pragma("unroll") for (int k = 0; k < 2; ++k) dst[m][k] = *(const PG8_LAS bf16x8*)(lds + PG8_SA(b, h) + aoff + m * 2048 + k * 1024); } while (0)
#define PG8_LDB(dst, b, h) do { _Pragma("unroll") for (int n = 0; n < 2; ++n) _Pragma("unroll") for (int k = 0; k < 2; ++k) dst[n][k] = *(const PG8_LAS bf16x8*)(lds + PG8_SB(b, h) + boff + n * 2048 + k * 1024); } while (0)
#define PG8_MMA(ai, bj, At, Bt) do { __builtin_amdgcn_s_setprio(1); _Pragma("unroll") for (int m = 0; m < 4; ++m) _Pragma("unroll") for (int n = 0; n < 2; ++n) _Pragma("unroll") for (int k = 0; k < 2; ++k) \
        acc[ai][bj][m][n] = __builtin_amdgcn_mfma_f32_16x16x32_bf16(Bt[n][k], At[m][k], acc[ai][bj][m][n], 0, 0, 0); __builtin_amdgcn_s_setprio(0); } while (0)
#define PG8_WAIT_V(n) asm volatile("s_waitcnt vmcnt(" #n ")" ::: "memory")
#define PG8_WAIT_L(n) asm volatile("s_waitcnt lgkmcnt(" #n ")" ::: "memory")
#define PG8_BAR __builtin_amdgcn_s_barrier()
#define PG8_SCHED __builtin_amdgcn_sched_barrier(0)
    Unit cur, nxt; int ui = 0;
    if (!S.next(0, cur)) return;
    f32x4 acc[2][2][4][2];
#pragma unroll
    for (int a = 0; a < 2; ++a)
#pragma unroll
        for (int b = 0; b < 2; ++b)
#pragma unroll
            for (int m = 0; m < 4; ++m)
#pragma unroll
                for (int n = 0; n < 2; ++n) acc[a][b][m][n] = (f32x4){0.f, 0.f, 0.f, 0.f};
    bf16x8 At[4][2], B0[2][2], B1[2][2];
    const char* cA = (const char*)g.A + (size_t)cur.pm * tstepA; const char* cB = (const char*)g.Bt + (size_t)cur.pn * tstepB;
    PG8_STAGE(PG8_SB(0, 0), cB, voffB); PG8_STAGE(PG8_SB(0, 1), cB + hstepB, voffB); PG8_STAGE(PG8_SA(0, 0), cA, voffA); PG8_STAGE(PG8_SA(0, 1), cA + hstepA, voffA);
    if (wr == 1) PG8_BAR;
    PG8_WAIT_V(2); PG8_BAR;
    PG8_STAGE(PG8_SB(1, 0), cB + kstep, voffB); PG8_STAGE(PG8_SA(1, 0), cA + kstep, voffA); PG8_STAGE(PG8_SB(1, 1), cB + hstepB + kstep, voffB);
    PG8_WAIT_V(6); PG8_BAR;
    for (;;) {
        const bool has_next = S.next(ui + 1, nxt);
        const char* nA = has_next ? (const char*)g.A + (size_t)nxt.pm * tstepA : cA; const char* nB = has_next ? (const char*)g.Bt + (size_t)nxt.pn * tstepB : cB;
        for (int t = 0; t < nt; t += 2) {
            const bool last = (t == nt - 2);
            const char* a1 = cA + (size_t)(t + 1) * kstep;
            const char* a2 = last ? nA : cA + (size_t)(t + 2) * kstep; const char* b2 = last ? nB : cB + (size_t)(t + 2) * kstep;
            const char* a3 = a2 + kstep; const char* b3 = b2 + kstep;
            PG8_LDB(B0, 0, 0); PG8_LDB(B1, 0, 1); PG8_SCHED; PG8_LDA(At, 0, 0); PG8_STAGE(PG8_SA(1, 1), a1 + hstepA, voffA);
            PG8_WAIT_V(8); PG8_WAIT_L(0); PG8_BAR; PG8_MMA(0, 0, At, B0); PG8_MMA(0, 1, At, B1); PG8_BAR; PG8_SCHED;
            PG8_LDA(At, 0, 1); PG8_STAGE(PG8_SB(0, 0), b2, voffB); PG8_STAGE(PG8_SB(0, 1), b2 + hstepB, voffB); PG8_STAGE(PG8_SA(0, 0), a2, voffA);
            PG8_WAIT_V(8); PG8_WAIT_L(0); PG8_BAR; PG8_MMA(1, 0, At, B0); PG8_MMA(1, 1, At, B1); PG8_BAR; PG8_SCHED;
            PG8_LDB(B0, 1, 0); PG8_LDB(B1, 1, 1); PG8_SCHED; PG8_LDA(At, 1, 0); PG8_STAGE(PG8_SA(0, 1), a2 + hstepA, voffA);
            PG8_WAIT_V(8); PG8_WAIT_L(0); PG8_BAR; PG8_MMA(0, 0, At, B0); PG8_MMA(0, 1, At, B1); PG8_BAR; PG8_SCHED;
            PG8_LDA(At, 1, 1); PG8_STAGE(PG8_SB(1, 0), b3, voffB); PG8_STAGE(PG8_SB(1, 1), b3 + hstepB, voffB); PG8_STAGE(PG8_SA(1, 0), a3, voffA);
            PG8_WAIT_V(8); PG8_WAIT_L(0); PG8_BAR; PG8_MMA(1, 0, At, B0); PG8_MMA(1, 1, At, B1); PG8_BAR; PG8_SCHED;
        }
        if constexpr (ALIGN_EPI) { if (wr == 0) PG8_BAR; }
        E(acc, cur, wr, wc, fr, fq);
        if (!has_next) break;
#pragma unroll
        for (int a = 0; a < 2; ++a)
#pragma unroll
            for (int b = 0; b < 2; ++b)
#pragma unroll
                for (int m = 0; m < 4; ++m)
#pragma unroll
                    for (int n = 0; n < 2; ++n) acc[a][b][m][n] = (f32x4){0.f, 0.f, 0.f, 0.f};
        cur = nxt; cA = nA; cB = nB; ++ui;
        if constexpr (ALIGN_EPI) { if (wr == 1) PG8_BAR; }
    }
    PG8_WAIT_V(0);
    if constexpr (!ALIGN_EPI) { if (wr == 0) PG8_BAR; }
    PG8_BAR;
#undef PG8_SA
#undef PG8_SB
#undef PG8_STAGE
#undef PG8_LDA
#undef PG8_LDB
#undef PG8_MMA
#undef PG8_WAIT_V
#undef PG8_WAIT_L
#undef PG8_BAR
#undef PG8_SCHED
}
}

#define RLX_AGENT __ATOMIC_RELAXED, __HIP_MEMORY_SCOPE_AGENT
#define XB_TMO      128
#define XB_XCNT(j)  (256  + 64 * (j))
#define XB_XSUB(j)  (1280 + 64 * (j))
#define XB_XGEN(j)  (2304 + 64 * (j))
#define XB_TOP      3328
#define XB_TOPGEN   3392
#define XCD_BAR_WORDS 3456
#define XB_SPIN_CAP (1u << 18)
DI unsigned xb_ld(unsigned* p)              { return __hip_atomic_load(p, __ATOMIC_RELAXED, __HIP_MEMORY_SCOPE_AGENT); }
DI unsigned xb_add(unsigned* p, unsigned v) { return __hip_atomic_fetch_add(p, v, __ATOMIC_RELAXED, __HIP_MEMORY_SCOPE_AGENT); }
DI unsigned xb_xcc_id() { return (unsigned)__builtin_amdgcn_s_getreg((3 << 11) | 20) & 0xFu; }
#define XB_SPIN(cond, bar) do { unsigned _sp = 0; while (cond) { __builtin_amdgcn_s_sleep(1); \
    if ((++_sp & 255u) == 0u) { if (xb_ld(&(bar)[XB_TMO])) break; if (_sp > XB_SPIN_CAP) { atomicAdd(&(bar)[XB_TMO], 1u); break; } } } } while (0)
struct XcdBarrier { unsigned* bar; unsigned x; volatile LAS unsigned* st; };
DI XcdBarrier xcd_barrier_post(unsigned* bar, volatile LAS unsigned* st) {
    XcdBarrier b; b.bar = bar; b.x = xb_xcc_id(); b.st = st;
    if (threadIdx.x == 0) (void)xb_add(&bar[XB_XCNT(b.x)], 1u);
    return b;
}
DI void xcd_barrier_complete(unsigned* bar, unsigned x, unsigned& nloc, unsigned& nx) {
    const unsigned G = gridDim.x * gridDim.y * gridDim.z;
    unsigned sum, cnt, mine, sp = 0u;
    for (;;) {
        sum = 0u; cnt = 0u; mine = 0u;
#pragma unroll
        for (unsigned j = 0; j < 16; ++j) { const unsigned c = xb_ld(&bar[XB_XCNT(j)]); sum += c; cnt += (c > 0u) ? 1u : 0u; mine = (j == x) ? c : mine; }
        if (sum == G) break;
        __builtin_amdgcn_s_sleep(1);
        if ((++sp & 255u) == 0u) { if (xb_ld(&bar[XB_TMO])) break; if (sp > XB_SPIN_CAP) { atomicAdd(&bar[XB_TMO], 1u); break; } }
    }
    nloc = mine > 0u ? mine : 1u; nx = cnt > 0u ? cnt : 1u;
}
DI void xcd_barrier(const XcdBarrier& b, bool local = false) {
    asm volatile("s_waitcnt vmcnt(0)" ::: "memory");
    __syncthreads();
    if (threadIdx.x == 0) {
        unsigned* bar = b.bar;
        __builtin_amdgcn_s_waitcnt(0);
        unsigned nloc = b.st[0], nx = b.st[1];
        if (nloc == 0u) { xcd_barrier_complete(bar, b.x, nloc, nx); b.st[0] = nloc; b.st[1] = nx; }
        const unsigned old = xb_add(&bar[XB_XSUB(b.x)], 1u);
        const unsigned gen = old / nloc;
        if (old + 1u == (gen + 1u) * nloc) {
            __builtin_amdgcn_fence(__ATOMIC_RELEASE, "agent");
            asm volatile("s_waitcnt vmcnt(0)" ::: "memory");
            if (!local) {
            const unsigned og = xb_add(&bar[XB_TOP], 1u);
            const unsigned tg = og / nx;
            if (og + 1u == (tg + 1u) * nx) xb_add(&bar[XB_TOPGEN], 1u);
            else XB_SPIN(xb_ld(&bar[XB_TOPGEN]) == tg, bar);
            }
            __builtin_amdgcn_fence(__ATOMIC_ACQUIRE, "agent");
            xb_add(&bar[XB_XGEN(b.x)], 1u);
            asm volatile("s_waitcnt vmcnt(0)" ::: "memory");
        } else {
            XB_SPIN(xb_ld(&bar[XB_XGEN(b.x)]) == gen, bar);
            __builtin_amdgcn_fence(__ATOMIC_ACQUIRE, "agent");
            asm volatile("s_waitcnt vmcnt(0)" ::: "memory");
        }
    }
    __syncthreads();
}

struct Args { const float* in[25]; float* out; unsigned char* ws; int ph_lo, ph_hi; };
struct Frame {
    LAS unsigned char* lds;
    int tid, lane, wave, vcu, G, gw, NGW;
    const float* const* in;
    float* out; unsigned char* ws;
};
#define WSP(type, off) ((type*)(F.ws + (off)))

DI void p0_transpose_item(const float* W, int K, int N, bf16_t* WT, int out_row0, int n0, int k0, const float* gain, LAS float* scr, int lane) {
#pragma unroll
    for (int hb = 0; hb < 2; ++hb) {
        float wv[16];
#pragma unroll
        for (int i = 0; i < 16; ++i) { const int kk = 2 * (16 * hb + i) + (lane >> 5); wv[i] = W[(size_t)(k0 + kk) * N + n0 + (lane & 31)]; }
        asm volatile("" ::: "memory");
#pragma unroll
        for (int i = 0; i < 16; ++i) { const int kk = 2 * (16 * hb + i) + (lane >> 5); float w = wv[i]; if (gain) w *= gain[k0 + kk]; scr[kk * 33 + (lane & 31)] = w; }
    }
    asm volatile("s_waitcnt lgkmcnt(0)" ::: "memory");
    const int c = lane & 7;
#pragma unroll
    for (int j = 0; j < 4; ++j) { const int n = (lane >> 3) + 8 * j; const LAS float* s = scr + (8 * c) * 33 + n;
        u32x4 o; o.x = pk2(s[0 * 33], s[1 * 33]); o.y = pk2(s[2 * 33], s[3 * 33]); o.z = pk2(s[4 * 33], s[5 * 33]); o.w = pk2(s[6 * 33], s[7 * 33]);
        *(u32x4*)(WT + (size_t)(out_row0 + n) * K + k0 + 8 * c) = o; }
    asm volatile("s_waitcnt lgkmcnt(0)" ::: "memory");
}
DI void row_cvt(const float* src, bf16_t* dst, const float* gain, float* rstd_out, int lane) {
    const f32x4* s4 = (const f32x4*)src + lane;
    f32x4 v[4]; float ss = 0.f;
#pragma unroll
    for (int j = 0; j < 4; ++j) { v[j] = s4[64 * j]; ss += (v[j][0] * v[j][0] + v[j][1] * v[j][1]) + (v[j][2] * v[j][2] + v[j][3] * v[j][3]); }
    if (rstd_out) { const float tot = wave_sum(ss); if (lane == 0) *rstd_out = rsqrtf(tot * (1.f / 1024.f) + EPS); }
    if (gain) {
#pragma unroll
        for (int j = 0; j < 4; ++j) v[j] = v[j] * ((const f32x4*)gain + lane)[64 * j];
    }
    u32x2* o8 = (u32x2*)dst + lane;
#pragma unroll
    for (int j = 0; j < 4; ++j) { u32x2 w; w.x = pk2(v[j][0], v[j][1]); w.y = pk2(v[j][2], v[j][3]); o8[64 * j] = w; }
}
DI void row_cvt8(const float* src, unsigned char* dst, const float* gain, float scale, int lane) {
    const f32x4* s4 = (const f32x4*)src + lane; unsigned* d4 = (unsigned*)dst + lane;
#pragma unroll
    for (int j = 0; j < 4; ++j) { f32x4 v = s4[64 * j] * scale; if (gain) v = v * ((const f32x4*)gain + lane)[64 * j];
        int w = 0; w = __builtin_amdgcn_cvt_pk_fp8_f32(v[0], v[1], w, false); w = __builtin_amdgcn_cvt_pk_fp8_f32(v[2], v[3], w, true); d4[64 * j] = (unsigned)w; }
}
template <bool SLICED = false>
DI void row_cvt4(const float* src, unsigned char* dst, const float* gain, float scale, int lane, int e = 0) {
    const f32x4* s4 = (const f32x4*)src + 2 * lane; unsigned* d4 = SLICED ? (unsigned*)(dst + (size_t)(lane >> 5) * (16384 * 128) + (size_t)e * 128 + 4 * (lane & 31)) : (unsigned*)dst + lane;
#pragma unroll
    for (int j = 0; j < 2; ++j) { f32x4 a = s4[128 * j] * scale, b = s4[128 * j + 1] * scale;
        if (gain) { a = a * ((const f32x4*)gain + 2 * lane)[128 * j]; b = b * ((const f32x4*)gain + 2 * lane)[128 * j + 1]; }
        unsigned w = 0;
        w = __builtin_amdgcn_cvt_scalef32_pk_fp4_f32(w, a[0], a[1], 1.0f, 0); w = __builtin_amdgcn_cvt_scalef32_pk_fp4_f32(w, a[2], a[3], 1.0f, 1);
        w = __builtin_amdgcn_cvt_scalef32_pk_fp4_f32(w, b[0], b[1], 1.0f, 2); w = __builtin_amdgcn_cvt_scalef32_pk_fp4_f32(w, b[2], b[3], 1.0f, 3);
        d4[SLICED ? j * (2 * 16384 * 32) : 64 * j] = w; }
}
#ifndef PEER_FP4
#define PEER_FP4 1
#endif
constexpr float PEER_SU = PEER_FP4 ? 64.f : 256.f, PEER_SV = PEER_FP4 ? 22.63f : 64.f;
DI void convert_tables(const Frame& F, int layer) {
    const float* u = F.in[23] + (size_t)layer * 16384 * 1024; const float* v = F.in[24] + (size_t)layer * 16384 * 1024; const float* g = F.in[2] + layer * 1024;
    unsigned char* UB = WSP(unsigned char, WS_UB); unsigned char* VB = WSP(unsigned char, WS_VB);
    for (int r = F.gw; r < 32768; r += F.NGW) {
        if (PEER_FP4) { if (r < 16384) { if (PEER_SPLIT) row_cvt4<true>(u + (size_t)r * 1024, UB, g, PEER_SU, F.lane, r); else row_cvt4(u + (size_t)r * 1024, UB + (size_t)r * 512, g, PEER_SU, F.lane); }
                        else { if (PEER_SPLIT && PEER_VSLICE && (layer == 0 || T == 8 * F.NGW)) row_cvt4<true>(v + (size_t)(r - 16384) * 1024, VB, nullptr, PEER_SV, F.lane, r - 16384); else row_cvt4(v + (size_t)(r - 16384) * 1024, VB + (size_t)(r - 16384) * 512, nullptr, PEER_SV, F.lane); } }
        else { if (r < 16384) row_cvt8(u + (size_t)r * 1024, UB + (size_t)r * 1024, g, PEER_SU, F.lane);
               else row_cvt8(v + (size_t)(r - 16384) * 1024, VB + (size_t)(r - 16384) * 1024, nullptr, PEER_SV, F.lane); }
    }
}
DI void p0_prologue(const Frame& F) {
    LAS float* scr = (LAS float*)(F.lds + F.wave * 16384);
    constexpr int I_IN0 = 16 * 192, I_OUT = 32 * 32, I_IN1 = 16 * 161, I_Q = 16 * 32;
    constexpr int NIT = I_IN0 + I_OUT + I_IN1 + I_OUT + 2 * I_Q;
    for (int it = F.gw; it < NIT; it += F.NGW) {
        int r = it;
        if (r < I_IN0) { const int kb = r / 192, nb = r % 192, n0 = nb * 32, seg = n0 >> 10;
            const int omap = (seg == 0) ? 0 : (seg == 5 ? 1 : seg + 1);
            p0_transpose_item(F.in[4], 1024, EVEN_IN, WSP(bf16_t, WS_WIN0), omap * 1024 + (n0 & 1023) , n0, kb * 64, F.in[1], scr, F.lane); continue; }
        r -= I_IN0;
        if (r < I_OUT) { const int kb = r / 32, nb = r % 32; p0_transpose_item(F.in[12], 2048, 1024, WSP(bf16_t, WS_WOUT0), nb * 32, nb * 32, kb * 64, nullptr, scr, F.lane); continue; }
        r -= I_OUT;
        if (r < I_IN1) { const int kb = r / 161, nb = r % 161, n0 = nb * 32;
            if (n0 < SSM_N) p0_transpose_item(F.in[13], 1024, SSM_IN, WSP(bf16_t, WS_WIN1), n0, n0, kb * 64, F.in[1] + 1024, scr, F.lane);
            else p0_transpose_item(F.in[13], 1024, SSM_IN, WSP(bf16_t, WS_WDT), 0, n0, kb * 64, F.in[1] + 1024, scr, F.lane);
            continue; }
        r -= I_IN1;
        if (r < I_OUT) { const int kb = r / 32, nb = r % 32; p0_transpose_item(F.in[20], 2048, 1024, WSP(bf16_t, WS_WOUT1), nb * 32, nb * 32, kb * 64, F.in[19], scr, F.lane); continue; }
        r -= I_OUT;
        { const int l = r / I_Q; r -= l * I_Q; const int kb = r / 32, nb = r % 32;
          p0_transpose_item(F.in[21] + (size_t)l * 1024 * 1024, 1024, 1024, WSP(bf16_t, l ? WS_WQ1 : WS_WQ0), nb * 32, nb * 32, kb * 64, F.in[2] + l * 1024, scr, F.lane); }
    }
    for (int r = F.gw; r < T; r += F.NGW) row_cvt(F.in[0] + (size_t)r * 1024, WSP(bf16_t, WS_XB) + (size_t)r * 1024, nullptr, WSP(float, WS_RSTD) + r, F.lane);
    if (!(TCONV0_IN_TOPK && F.G == 256 && !(DBG_REF & 8))) convert_tables(F, 0);
    const int gt = F.gw * 64 + F.lane, NGT = F.NGW * 64;
    for (int i = gt; i < 2048 * 128; i += NGT) { const int pos = i >> 7, d = i & 127;
        const float inv = __builtin_amdgcn_exp2f(-(float)d * (13.287712379549449f / 128.f));
        const float rev = __builtin_amdgcn_fractf((float)pos * inv * 0.15915494309189535f); const float sn = __builtin_amdgcn_sinf(rev), cs = __builtin_amdgcn_cosf(rev);
        WSP(f32x2, WS_ROPE)[i] = (f32x2){cs, sn}; }
    for (int i = gt; i < 16 * 128 * 64; i += NGT) { const int blk = i >> 13, jj = (i >> 6) & 127, ii = i & 63;
        const float w = (jj < 64) ? F.in[7][(blk * 64 + ii) * 64 + jj] : F.in[9][(blk * 64 + ii) * 64 + (jj - 64)];
        WSP(bf16_t, WS_LRUW)[i] = (bf16_t)f2bf(w); }
    for (int i = gt; i < 2 * 8 * 2 * 128 * 64; i += NGT) WSP(bf16_t, WS_KEYS)[i] = (bf16_t)f2bf(F.in[22][i]);
}

constexpr int P0_GA = 0, P0_GB = 1024, P0_XA = 2048, P0_Q = 3072, P0_K = 4096, P0_V = 5120;
constexpr int LDQ = 264;
DI float ret_lg(int h) { return log1pf(-exp2f(-5.f - (float)h)); }

DI void stage_128x256(LAS short* img, const bf16_t* src, int ldg, int tid, const LAS float* rowscale) {
    u32x4 v[8];
#pragma unroll
    for (int i = 0; i < 8; ++i) { const unsigned c = (unsigned)tid + 512u * i, row = c >> 5, ch = c & 31u; v[i] = *(const u32x4*)(src + (row * (unsigned)ldg + ch * 8u)); }
#pragma unroll
    for (int i = 0; i < 8; ++i) { const unsigned c = (unsigned)tid + 512u * i, row = c >> 5, ch = c & 31u;
        u32x4 w = v[i];
        if (rowscale) { const float s = rowscale[row];
            w.x = pk2(bflo(w.x) * s, bfhi(w.x) * s); w.y = pk2(bflo(w.y) * s, bfhi(w.y) * s); w.z = pk2(bflo(w.z) * s, bfhi(w.z) * s); w.w = pk2(bflo(w.w) * s, bfhi(w.w) * s); }
        *(LAS u32x4*)(img + row * LDQ + ch * 8) = w; }
    asm volatile("" ::: "memory");
}
DI void ret_kv_unit(const Frame& F, int unit) {
    const int b = unit >> 6, h = (unit >> 4) & 3, n = unit & 15;
    const int tok0 = b * SEQ + n * CH;
    const bf16_t* proj = WSP(bf16_t, WS_PROJ);
    LAS short* Kimg = (LAS short*)F.lds; LAS short* Vimg = Kimg + 128 * LDQ;
    LAS float* kdec = (LAS float*)(F.lds + 2 * 128 * LDQ * 2);
    const float lg = ret_lg(h);
    if (F.tid < 128) kdec[F.tid] = expf(lg * (float)(127 - F.tid));
    __syncthreads();
    stage_128x256(Kimg, proj + (size_t)tok0 * EVEN_IN + P0_K + h * 256, EVEN_IN, F.tid, nullptr);
    stage_128x256(Vimg, proj + (size_t)tok0 * EVEN_IN + P0_V + h * 256, EVEN_IN, F.tid, kdec);
    __syncthreads();
    const int w = F.wave, lane = F.lane, dm = w >> 2, en = w & 3, fr = lane & 15, fq = lane >> 4;
    float* st = WSP(float, WS_STATES) + (size_t)unit * 65536;
#pragma unroll 1
    for (int mh = 0; mh < 2; ++mh) {
        f32x4 acc[4][4];
#pragma unroll
        for (int m = 0; m < 4; ++m)
#pragma unroll
            for (int nn = 0; nn < 4; ++nn) acc[m][nn] = (f32x4){0.f, 0.f, 0.f, 0.f};
#pragma unroll
        for (int ks = 0; ks < 4; ++ks) {
            bf16x8 bfr[4];
#pragma unroll
            for (int nn = 0; nn < 4; ++nn) bfr[nn] = frag_tr(Vimg, LDQ, 64 * en + 16 * nn, 32 * ks, lane);
#pragma unroll
            for (int m = 0; m < 4; ++m) { const bf16x8 a = frag_tr(Kimg, LDQ, 128 * dm + 64 * mh + 16 * m, 32 * ks, lane);
#pragma unroll
                for (int nn = 0; nn < 4; ++nn) acc[m][nn] = MFMA16(a, bfr[nn], acc[m][nn]); }
        }
#pragma unroll
        for (int m = 0; m < 4; ++m)
#pragma unroll
            for (int nn = 0; nn < 4; ++nn)
#pragma unroll
                for (int r = 0; r < 4; ++r) st[(128 * dm + 64 * mh + 16 * m + 4 * fq + r) * 256 + 64 * en + 16 * nn + fr] = acc[m][nn][r];
    }
    __syncthreads();
}

template <bool DRY = false>
DI void lru_unit(const Frame& F, int unit) {
    const int b = unit >> 4, blk = unit & 15, c = F.lane, s = F.wave, ch = blk * 64 + c, lane = F.lane, fr = lane & 15, fq = lane >> 4;
    bf16_t* proj = WSP(bf16_t, WS_PROJ);
    LAS short* Aimg = (LAS short*)(F.lds + s * 12288);
    LAS float* PRE = (LAS float*)(F.lds + s * 12288 + 2560);
    LAS float* EXCH = (LAS float*)(F.lds + 8 * 12288);
    const float* cw = F.in[5]; const float cw0 = cw[ch], cw1 = cw[1024 + ch], cw2 = cw[2048 + ch], cw3 = cw[3072 + ch], cb = F.in[6][ch];
    const float ba = F.in[8][ch], bi = F.in[10][ch], sp = softplusf_(-F.in[11][ch]);
    bf16x8 bw[8][2];
    const bf16_t* Bt = WSP(bf16_t, WS_LRUW) + blk * 128 * 64;
#pragma unroll
    for (int nf = 0; nf < 8; ++nf)
#pragma unroll
        for (int ks = 0; ks < 2; ++ks) bw[nf][ks] = *(const bf16x8*)(Bt + (16 * nf + fr) * 64 + 32 * ks + 8 * fq);
    float hchunk = 0.f;
    for (int n = 0; n < NCH; ++n) {
        const int t0 = b * SEQ + n * CH + 16 * s;
        float xr[19];
#pragma unroll
        for (int i = 0; i < 19; ++i) { const int tt = t0 - 3 + i; const bool ok = (i >= 3) || (n > 0) || (s > 0);
            xr[i] = ok ? bf2f(proj[(size_t)tt * EVEN_IN + P0_XA + ch]) : 0.f; }
        float xc[16];
#pragma unroll
        for (int t = 0; t < 16; ++t) { xc[t] = cb + cw0 * xr[t] + cw1 * xr[t + 1] + cw2 * xr[t + 2] + cw3 * xr[t + 3]; Aimg[t * 72 + c] = (short)f2bf(xc[t]); }
        f32x4 acc[8];
#pragma unroll
        for (int nf = 0; nf < 8; ++nf) acc[nf] = (f32x4){0.f, 0.f, 0.f, 0.f};
#pragma unroll
        for (int ks = 0; ks < 2; ++ks) { const bf16x8 a = *(const LAS bf16x8*)(Aimg + fr * 72 + 32 * ks + 8 * fq);
#pragma unroll
            for (int nf = 0; nf < 8; ++nf) acc[nf] = MFMA16(a, bw[nf][ks], acc[nf]); }
#pragma unroll
        for (int nf = 0; nf < 8; ++nf)
#pragma unroll
            for (int r = 0; r < 4; ++r) PRE[((nf >> 2) * 16 + 4 * fq + r) * 65 + 16 * (nf & 3) + fr] = acc[nf][r];
        float hl[16], pp[16]; float P = 1.f, hh = 0.f;
#pragma unroll
        for (int t = 0; t < 16; ++t) {
            const float rg = sigmoidf_(PRE[t * 65 + c] + ba), ig = sigmoidf_(PRE[(16 + t) * 65 + c] + bi);
            const float la = -8.f * rg * sp, a = expf(la), mult = sqrtf(-expm1f(2.f * la)), u = mult * (ig * xc[t]);
            hh = a * hh + u; P = P * a; hl[t] = hh; pp[t] = P;
        }
        LAS float* ex = EXCH + (n & 1) * 1024;
        ex[(s * 64 + c) * 2] = P; ex[(s * 64 + c) * 2 + 1] = hh;
        __syncthreads();
        float carry = hchunk, run = hchunk;
#pragma unroll
        for (int s2 = 0; s2 < 8; ++s2) { const float A2 = ex[(s2 * 64 + c) * 2], H2 = ex[(s2 * 64 + c) * 2 + 1]; run = A2 * run + H2; if (s2 + 1 == s) carry = run; }
        if (s == 0) carry = hchunk;
        hchunk = run;
#pragma unroll
        for (int t = 0; t < 16; ++t) { const float hv = hl[t] + pp[t] * carry; bf16_t* gp = proj + (size_t)(t0 + t) * EVEN_IN + P0_GA + ch;
            const float ga = bf2f(*gp); const float yv = gelu_tanh(ga) * hv; if (!DRY || yv == 1.2345e30f) *gp = (bf16_t)f2bf(yv); }
    }
    __syncthreads();
}

template <bool DRY = false>
DI void lru2_unit(const Frame& F, int unit) {
    const int half = unit & 1, blk = (unit >> 1) & 15, b = unit >> 5;
    const int lane = F.lane, c32 = lane & 31, th = lane >> 5, s = F.wave, fr = lane & 15, fq = lane >> 4, seg = 2 * s + th;
    const int chA = blk * 64 + c32, chB = chA + 32, cho = blk * 64 + half * 32 + c32;
    bf16_t* proj = WSP(bf16_t, WS_PROJ);
    LAS short* Aimg = (LAS short*)(F.lds + s * 16384);
    LAS float* PRE = (LAS float*)(F.lds + s * 16384 + 4608);
    LAS float* EXCH = (LAS float*)(F.lds + 8 * 16384);
    const float* cw = F.in[5];
    const float wA0 = cw[chA], wA1 = cw[1024 + chA], wA2 = cw[2048 + chA], wA3 = cw[3072 + chA], bA = F.in[6][chA];
    const float wB0 = cw[chB], wB1 = cw[1024 + chB], wB2 = cw[2048 + chB], wB3 = cw[3072 + chB], bB = F.in[6][chB];
    const float L2E = 1.4426950408889634f; const float nba = -L2E * F.in[8][cho], nbi = -L2E * F.in[10][cho], sp8 = -8.f * L2E * softplusf_(-F.in[11][cho]);
    bf16x8 bw[4][2];
    const bf16_t* Bt = WSP(bf16_t, WS_LRUW) + blk * 128 * 64;
#pragma unroll
    for (int nf = 0; nf < 4; ++nf)
#pragma unroll
        for (int ks = 0; ks < 2; ++ks) bw[nf][ks] = *(const bf16x8*)(Bt + ((nf >> 1) * 64 + half * 32 + 16 * (nf & 1) + fr) * 64 + 32 * ks + 8 * fq);
    unsigned short rA[19], rB[19], rG[16];
    const unsigned char* pb = (const unsigned char*)proj;
#define LRU2_LOAD(n_) do { const int t0_ = b * SEQ + (n_) * 256 + 32 * s + 16 * th; const bool first_ = ((n_) == 0) && (seg == 0); \
        const unsigned oa_ = (unsigned)(((t0_ - 3) * EVEN_IN + P0_XA + chA) * 2), og_ = (unsigned)((t0_ * EVEN_IN + P0_GA + cho) * 2); \
        _Pragma("unroll") for (int i = 0; i < 19; ++i) { const unsigned oi_ = (i < 3 && first_) ? oa_ + 3u * (EVEN_IN * 2u) : oa_ + (unsigned)i * (EVEN_IN * 2u);     \
            rA[i] = *(const unsigned short*)(pb + oi_); rB[i] = *(const unsigned short*)(pb + (oi_ + 64u)); } \
        if (first_) { rA[0] = rA[1] = rA[2] = (unsigned short)0; rB[0] = rB[1] = rB[2] = (unsigned short)0; } \
        _Pragma("unroll") for (int t = 0; t < 16; ++t) rG[t] = *(const unsigned short*)(pb + (og_ + (unsigned)t * (EVEN_IN * 2u))); } while (0)
    LRU2_LOAD(0);
    float hchunk = 0.f;
#pragma unroll 1
    for (int n = 0; n < 8; ++n) {
        const int t0 = b * SEQ + n * 256 + 32 * s + 16 * th;
        float xa[19], xb[19], ga[16];
#pragma unroll
        for (int i = 0; i < 19; ++i) { xa[i] = bf2f(rA[i]); xb[i] = bf2f(rB[i]); }
#pragma unroll
        for (int t = 0; t < 16; ++t) ga[t] = bf2f(rG[t]);
        if (n + 1 < 8) LRU2_LOAD(n + 1);
        float xc[16];
#pragma unroll
        for (int t = 0; t < 16; ++t) { const float ca = bA + wA0 * xa[t] + wA1 * xa[t + 1] + wA2 * xa[t + 2] + wA3 * xa[t + 3], cb2 = bB + wB0 * xb[t] + wB1 * xb[t + 1] + wB2 * xb[t + 2] + wB3 * xb[t + 3];
            { const unsigned w2 = pk2(ca, cb2); Aimg[(th * 16 + t) * 72 + c32] = (short)(w2 & 0xffffu); Aimg[(th * 16 + t) * 72 + 32 + c32] = (short)(w2 >> 16); }
            xc[t] = half ? cb2 : ca; }
#pragma unroll
        for (int tile = 0; tile < 2; ++tile) {
            f32x4 acc[4];
#pragma unroll
            for (int nf = 0; nf < 4; ++nf) acc[nf] = (f32x4){0.f, 0.f, 0.f, 0.f};
#pragma unroll
            for (int ks = 0; ks < 2; ++ks) { const bf16x8 a = *(const LAS bf16x8*)(Aimg + (tile * 16 + fr) * 72 + 32 * ks + 8 * fq);
#pragma unroll
                for (int nf = 0; nf < 4; ++nf) acc[nf] = MFMA16(a, bw[nf][ks], acc[nf]); }
#pragma unroll
            for (int nf = 0; nf < 4; ++nf)
#pragma unroll
                for (int r = 0; r < 4; ++r) PRE[((tile * 2 + (nf >> 1)) * 16 + 4 * fq + r) * 33 + 16 * (nf & 1) + fr] = acc[nf][r];
        }
        float hl[16], pp[16]; float P = 1.f, hh = 0.f;
#pragma unroll
        for (int t = 0; t < 16; ++t) {
            const float rg = frcp(1.f + __builtin_amdgcn_exp2f(PRE[((th * 2 + 0) * 16 + t) * 33 + c32] * (-L2E) + nba)), ig = frcp(1.f + __builtin_amdgcn_exp2f(PRE[((th * 2 + 1) * 16 + t) * 33 + c32] * (-L2E) + nbi));
            const float a = __builtin_amdgcn_exp2f(rg * sp8), mult = __builtin_amdgcn_sqrtf(fmaxf(1.f - a * a, 0.f)), u = mult * (ig * xc[t]);
            hh = a * hh + u; P = P * a; hl[t] = hh; pp[t] = P;
        }
        LAS float* ex = EXCH + (n & 1) * 1024;
        ex[(seg * 32 + c32) * 2] = P; ex[(seg * 32 + c32) * 2 + 1] = hh;
        __syncthreads();
        float carry = hchunk, run = hchunk;
#pragma unroll
        for (int s2 = 0; s2 < 16; ++s2) { const float A2 = ex[(s2 * 32 + c32) * 2], H2 = ex[(s2 * 32 + c32) * 2 + 1]; carry = (s2 == seg) ? run : carry; run = A2 * run + H2; }
        hchunk = run;
#pragma unroll
        for (int t = 0; t < 16; ++t) { const float hv = hl[t] + pp[t] * carry; const float yv = gelu_tanh(ga[t]) * hv;
            if (!DRY || yv == 1.2345e30f) *(unsigned short*)((unsigned char*)proj + ((unsigned)((t0 * EVEN_IN + P0_GA + cho) * 2) + (unsigned)t * (EVEN_IN * 2u))) = (bf16_t)f2bf(yv); }
    }
#undef LRU2_LOAD
    __syncthreads();
}

template <bool DRY = false>
DI void ret_scan(const Frame& F) {
    f32x4* st = WSP(f32x4, WS_STATES);
    const int gt = F.gw * 64 + F.lane, NGT = F.NGW * 64;
    for (int i = gt; i < 32 * 16384; i += NGT) {
        const int bh = i >> 14, e = i & 16383, h = bh & 3;
        const float cd = expf(ret_lg(h) * 128.f);
        f32x4 run = (f32x4){0.f, 0.f, 0.f, 0.f};
        f32x4* p = st + (size_t)bh * 16 * 16384 + e;
        f32x4 tmp[16];
#pragma unroll
        for (int n = 0; n < 16; ++n) tmp[n] = p[(size_t)n * 16384];
#pragma unroll
        for (int n = 0; n < 16; ++n) { if (!DRY || run[0] == 1.2345e30f) p[(size_t)n * 16384] = run; run = run * cd + tmp[n]; }
    }
}

template <bool DRY = false>
DI void ret_out_unit(const Frame& F, int unit) {
    const int b = unit >> 6, h = (unit >> 4) & 3, n = unit & 15;
    const int tok0 = b * SEQ + n * CH;
    bf16_t* proj = WSP(bf16_t, WS_PROJ);
    LAS short* R0 = (LAS short*)F.lds; LAS short* R1 = R0 + 128 * LDQ;
    int tid = F.tid; asm volatile("" : "+v"(tid));
    const int w = F.wave, lane = tid & 63, fr = lane & 15, fq = lane >> 4;
    const float lg = ret_lg(h);
    stage_128x256(R0, proj + (size_t)tok0 * EVEN_IN + P0_Q + h * 256, EVEN_IN, tid, nullptr);
    stage_128x256(R1, proj + (size_t)tok0 * EVEN_IN + P0_K + h * 256, EVEN_IN, tid, nullptr);
    __syncthreads();
    f32x4 accS[8];
#pragma unroll
    for (int nf = 0; nf < 8; ++nf) accS[nf] = (f32x4){0.f, 0.f, 0.f, 0.f};
#pragma unroll
    for (int ks = 0; ks < 8; ++ks) { const bf16x8 a = frag_row(R0, LDQ, 16 * w, 32 * ks, lane);
#pragma unroll
        for (int nf = 0; nf < 8; ++nf) { const bf16x8 bb = frag_row(R1, LDQ, 16 * nf, 32 * ks, lane); accS[nf] = MFMA16(a, bb, accS[nf]); }
        pin(accS); }
    __syncthreads();
    f32x4 accY[16];
#pragma unroll
    for (int nf = 0; nf < 16; ++nf) accY[nf] = (f32x4){0.f, 0.f, 0.f, 0.f};
    const float* prev = WSP(float, WS_STATES) + (size_t)unit * 65536;
    for (int half = 0; half < 2; ++half) {
#pragma unroll
        for (int i = 0; i < 16; ++i) { const int cidx = tid + 512 * i, row = cidx >> 6, c4 = cidx & 63;
            const f32x4 v = *(const f32x4*)(prev + (size_t)(128 * half + row) * 256 + c4 * 4);
            u32x2 o; o.x = pk2(v[0], v[1]); o.y = pk2(v[2], v[3]); *(LAS u32x2*)(R1 + row * LDQ + c4 * 4) = o;
            if ((i & 7) == 7) asm volatile("" ::: "memory"); }
        __syncthreads();
#pragma unroll
        for (int ks = 0; ks < 4; ++ks) { const bf16x8 a = frag_row(R0, LDQ, 16 * w, 128 * half + 32 * ks, lane);
#pragma unroll
            for (int nf = 0; nf < 16; ++nf) { const bf16x8 bb = frag_tr(R1, LDQ, 16 * nf, 32 * ks, lane); accY[nf] = MFMA16(a, bb, accY[nf]); }
            pin(accY); }
        __syncthreads();
    }
    LAS short* Simg = R0;
#pragma unroll
    for (int nf = 0; nf < 8; ++nf) { const int j = 16 * nf + fr; const float dj = expf(-lg * (float)(j + 1));
#pragma unroll
        for (int r = 0; r < 4; ++r) { const int i = 16 * w + 4 * fq + r; const float v = (j <= i) ? accS[nf][r] * dj : 0.f; Simg[i * 136 + j] = (short)f2bf(v); } }
    stage_128x256(R1, proj + (size_t)tok0 * EVEN_IN + P0_V + h * 256, EVEN_IN, tid, nullptr);
    __syncthreads();
#pragma unroll
    for (int ks = 0; ks < 4; ++ks) { const bf16x8 a = frag_row(Simg, 136, 16 * w, 32 * ks, lane);
#pragma unroll
        for (int nf = 0; nf < 16; ++nf) { const bf16x8 bb = frag_tr(R1, LDQ, 16 * nf, 32 * ks, lane); accY[nf] = MFMA16(a, bb, accY[nf]); }
        pin(accY); }
#pragma unroll
    for (int r = 0; r < 4; ++r) { const int i = 16 * w + 4 * fq + r; const float di = expf(lg * (float)(i + 1));
        float ss = 0.f;
#pragma unroll
        for (int nf = 0; nf < 16; ++nf) { const float v = accY[nf][r] * di; accY[nf][r] = v; ss += v * v; }
        ss = row16_sum(ss);
        const float rn = rsqrtf(ss * (1.f / 256.f) + EPS);
        bf16_t* gp = proj + (size_t)(tok0 + i) * EVEN_IN + P0_GB + h * 256 + fr;
#pragma unroll
        for (int nf = 0; nf < 16; ++nf) { const float gb = bf2f(gp[16 * nf]); const float yv = siluf_(gb) * accY[nf][r] * rn; if (!DRY || yv == 1.2345e30f) gp[16 * nf] = (bf16_t)f2bf(yv); } }
    __syncthreads();
}


#define LBAR() do { asm volatile("s_waitcnt lgkmcnt(0)" ::: "memory"); __builtin_amdgcn_s_barrier(); asm volatile("" ::: "memory"); } while (0)
struct Tile { u32x4 v[8]; };
DI void tile_issue(Tile& T, const bf16_t* src, unsigned ldg, int tid) {
#pragma unroll
    for (int i = 0; i < 8; ++i) { const unsigned c = (unsigned)tid + 512u * i; T.v[i] = *(const u32x4*)(src + ((c >> 5) * ldg + (c & 31u) * 8u)); }
}
DI void tile_commit(LAS short* img, const Tile& T, int tid) {
#pragma unroll
    for (int i = 0; i < 8; ++i) { const unsigned c = (unsigned)tid + 512u * i; *(LAS u32x4*)(img + (c >> 5) * LDQ + (c & 31u) * 8) = T.v[i]; }
}
DI void tile_commit_scaled(LAS short* img, const Tile& T, int tid, float lg) {
#pragma unroll
    for (int i = 0; i < 8; ++i) { const unsigned c = (unsigned)tid + 512u * i; const float s = __expf(lg * (float)(127 - (int)(c >> 5))); u32x4 w = T.v[i];
        w.x = pk2(bflo(w.x) * s, bfhi(w.x) * s); w.y = pk2(bflo(w.y) * s, bfhi(w.y) * s); w.z = pk2(bflo(w.z) * s, bfhi(w.z) * s); w.w = pk2(bflo(w.w) * s, bfhi(w.w) * s);
        *(LAS u32x4*)(img + (c >> 5) * LDQ + (c & 31u) * 8) = w; }
}
constexpr size_t WS_KV16 = WS_STATES, WS_PREV16 = WS_STATES + 64 * MiB;
DI void ret_kv2_phase(const Frame& F) {
    const bf16_t* proj = WSP(bf16_t, WS_PROJ);
    LAS short* Kimg = (LAS short*)F.lds; LAS short* Vimg = Kimg + 128 * LDQ;
    int tid = F.tid; asm volatile("" : "+v"(tid));
    const int w = F.wave, lane = tid & 63, dm = w >> 2, en = w & 3, fr = lane & 15, fq = lane >> 4;
    Tile TK, TV;
    const bool al = (F.G == 256); int rnd = 0;
#define RKV_UNIT(r_) (al ? ((F.vcu >> 5) * 64 + (F.vcu & 31) + 32 * (r_)) : (F.vcu + F.G * (r_)))
#define RKV_MORE(r_) (al ? ((r_) < 2) : (F.vcu + F.G * (r_) < 512))
    int unit = RKV_UNIT(0);
    if (!RKV_MORE(0)) return;
    { const int b = unit >> 6, h = (unit >> 4) & 3, n = unit & 15; const bf16_t* base = proj + (size_t)(b * SEQ + n * CH) * EVEN_IN + h * 256;
      tile_issue(TK, base + P0_K, EVEN_IN, tid); tile_issue(TV, base + P0_V, EVEN_IN, tid); }
    for (;;) {
        const int h = (unit >> 4) & 3;
        tile_commit(Kimg, TK, tid); tile_commit_scaled(Vimg, TV, tid, ret_lg(h));
        LBAR();
        const bool more = RKV_MORE(rnd + 1); const int nxt = RKV_UNIT(rnd + 1);
        if (more) { const int b = nxt >> 6, h2 = (nxt >> 4) & 3, n = nxt & 15; const bf16_t* base = proj + (size_t)(b * SEQ + n * CH) * EVEN_IN + h2 * 256;
            tile_issue(TK, base + P0_K, EVEN_IN, tid); tile_issue(TV, base + P0_V, EVEN_IN, tid); }
        bf16_t* st = WSP(bf16_t, WS_KV16) + (size_t)unit * 65536;
#pragma unroll 1
        for (int mh = 0; mh < 2; ++mh) {
            f32x4 acc[4][4];
#pragma unroll
            for (int m = 0; m < 4; ++m)
#pragma unroll
                for (int nn = 0; nn < 4; ++nn) acc[m][nn] = (f32x4){0.f, 0.f, 0.f, 0.f};
#pragma unroll
            for (int ks = 0; ks < 4; ++ks) {
                bf16x8 bfr[4];
#pragma unroll
                for (int nn = 0; nn < 4; ++nn) bfr[nn] = frag_tr(Vimg, LDQ, 64 * en + 16 * nn, 32 * ks, lane);
#pragma unroll
                for (int m = 0; m < 4; ++m) { const bf16x8 a = frag_tr(Kimg, LDQ, 128 * dm + 64 * mh + 16 * m, 32 * ks, lane);
#pragma unroll
                    for (int nn = 0; nn < 4; ++nn) acc[m][nn] = MFMA16(a, bfr[nn], acc[m][nn]); }
            }
#pragma unroll
            for (int m = 0; m < 4; ++m)
#pragma unroll
                for (int nn = 0; nn < 4; ++nn) { u32x2 o; o.x = pk2(acc[m][nn][0], acc[m][nn][1]); o.y = pk2(acc[m][nn][2], acc[m][nn][3]);
                    *(u32x2*)(st + (64 * en + 16 * nn + fr) * 256 + 128 * dm + 64 * mh + 16 * m + 4 * fq) = o; }
        }
        if (!more) break;
        unit = nxt; ++rnd;
        LBAR();
    }
    LBAR();
#undef RKV_UNIT
#undef RKV_MORE
}
template <bool DRY = false>
DI void ret_scan2(const Frame& F) {
    const u32x4* kv = WSP(u32x4, WS_KV16); u32x4* pv = WSP(u32x4, WS_PREV16);
    const bool al = (F.G == 256);
    const int gt = al ? (F.vcu >> 5) * 32768 + ((F.vcu & 31) * NWAVES + F.wave) * 64 + F.lane : F.gw * 64 + F.lane, NGT = al ? 16384 : F.NGW * 64, iend = al ? ((F.vcu >> 5) + 1) * 32768 : 32 * 8192;
    for (int i = gt; i < iend; i += NGT) {
        const int bh = i >> 13, e = i & 8191, h = bh & 3;
        const float cd = expf(ret_lg(h) * 128.f);
        float run[8];
#pragma unroll
        for (int k = 0; k < 8; ++k) run[k] = 0.f;
        const size_t base = (size_t)bh * 16 * 8192 + e;
        u32x4 tmp[16];
#pragma unroll
        for (int n = 0; n < 16; ++n) tmp[n] = kv[base + (size_t)n * 8192];
#pragma unroll
        for (int n = 0; n < 16; ++n) { u32x4 o; o.x = pk2(run[0], run[1]); o.y = pk2(run[2], run[3]); o.z = pk2(run[4], run[5]); o.w = pk2(run[6], run[7]);
            if (!DRY || run[0] == 1.2345e30f) pv[base + (size_t)n * 8192] = o;
            const u32x4 t = tmp[n];
            run[0] = run[0] * cd + bflo(t.x); run[1] = run[1] * cd + bfhi(t.x); run[2] = run[2] * cd + bflo(t.y); run[3] = run[3] * cd + bfhi(t.y);
            run[4] = run[4] * cd + bflo(t.z); run[5] = run[5] * cd + bfhi(t.z); run[6] = run[6] * cd + bflo(t.w); run[7] = run[7] * cd + bfhi(t.w); }
    }
}
template <bool DRY = false>
DI void ret_out2_unit(const Frame& F, int unit) {
    const int b = unit >> 6, h = (unit >> 4) & 3, n = unit & 15;
    const int tok0 = b * SEQ + n * CH;
    bf16_t* proj = WSP(bf16_t, WS_PROJ);
    LAS short* R0 = (LAS short*)F.lds; LAS short* R1 = R0 + 128 * LDQ;
    int tid = F.tid; asm volatile("" : "+v"(tid));
    const int w = F.wave, lane = tid & 63, fr = lane & 15, fq = lane >> 4;
    const float lg = ret_lg(h);
    const bf16_t* pbase = proj + (size_t)tok0 * EVEN_IN + h * 256;
    const bf16_t* prevT = WSP(bf16_t, WS_PREV16) + (size_t)unit * 65536;
    Tile TA, TB;
    tile_issue(TA, pbase + P0_Q, EVEN_IN, tid); tile_issue(TB, pbase + P0_K, EVEN_IN, tid);
    tile_commit(R0, TA, tid); tile_commit(R1, TB, tid);
    LBAR();
    tile_issue(TA, prevT, 256, tid);
    f32x4 accS[8];
#pragma unroll
    for (int nf = 0; nf < 8; ++nf) accS[nf] = (f32x4){0.f, 0.f, 0.f, 0.f};
#pragma unroll
    for (int ks = 0; ks < 8; ++ks) { const bf16x8 a = frag_row(R0, LDQ, 16 * w, 32 * ks, lane);
#pragma unroll
        for (int nf = 0; nf < 8; ++nf) { const bf16x8 bb = frag_row(R1, LDQ, 16 * nf, 32 * ks, lane); accS[nf] = MFMA16(a, bb, accS[nf]); }
        pin(accS); }
    LBAR();
    tile_commit(R1, TA, tid);
    LBAR();
    tile_issue(TA, prevT + 128 * 256, 256, tid);
    f32x4 accY[16];
#pragma unroll
    for (int nf = 0; nf < 16; ++nf) accY[nf] = (f32x4){0.f, 0.f, 0.f, 0.f};
#pragma unroll
    for (int ks = 0; ks < 8; ++ks) { const bf16x8 a = frag_row(R0, LDQ, 16 * w, 32 * ks, lane);
#pragma unroll
        for (int nf = 0; nf < 8; ++nf) { const bf16x8 bb = frag_row(R1, LDQ, 16 * nf, 32 * ks, lane); accY[nf] = MFMA16(a, bb, accY[nf]); }
        pin(accY); }
    LBAR();
    tile_commit(R1, TA, tid);
    LBAR();
    tile_issue(TA, pbase + P0_V, EVEN_IN, tid);
#pragma unroll
    for (int ks = 0; ks < 8; ++ks) { const bf16x8 a = frag_row(R0, LDQ, 16 * w, 32 * ks, lane);
#pragma unroll
        for (int nf = 0; nf < 8; ++nf) { const bf16x8 bb = frag_row(R1, LDQ, 16 * nf, 32 * ks, lane); accY[8 + nf] = MFMA16(a, bb, accY[8 + nf]); }
        pin(accY); }
    LBAR();
    LAS short* Simg = R0;
#pragma unroll
    for (int nf = 0; nf < 8; ++nf) { const int j = 16 * nf + fr; const float dj = __expf(-lg * (float)(j + 1));
#pragma unroll
        for (int r = 0; r < 4; ++r) { const int i = 16 * w + 4 * fq + r; const float v = (j <= i) ? accS[nf][r] * dj : 0.f; Simg[i * 136 + j] = (short)f2bf(v); } }
    tile_commit(R1, TA, tid);
    LBAR();
    tile_issue(TA, pbase + P0_GB, EVEN_IN, tid);
#pragma unroll
    for (int ks = 0; ks < 4; ++ks) { const bf16x8 a = frag_row(Simg, 136, 16 * w, 32 * ks, lane);
#pragma unroll
        for (int nf = 0; nf < 16; ++nf) { const bf16x8 bb = frag_tr(R1, LDQ, 16 * nf, 32 * ks, lane); accY[nf] = MFMA16(a, bb, accY[nf]); }
        pin(accY); }
    LBAR();
#pragma unroll
    for (int r = 0; r < 4; ++r) { const int i = 16 * w + 4 * fq + r; const float di = __expf(lg * (float)(i + 1));
        float ss = 0.f;
#pragma unroll
        for (int nf = 0; nf < 16; ++nf) { const float v = accY[nf][r] * di; accY[nf][r] = v; ss += v * v; }
        ss = row16_sum(ss);
        const float rn = rsqrtf(ss * (1.f / 256.f) + EPS);
#pragma unroll
        for (int nf = 0; nf < 16; ++nf) R1[i * LDQ + 16 * nf + fr] = (short)f2bf(accY[nf][r] * rn); }
    LBAR();
#pragma unroll
    for (int i = 0; i < 8; ++i) { const unsigned c = (unsigned)tid + 512u * i, row = c >> 5, ch = c & 31u;
        const u32x4 g = TA.v[i]; const u32x4 y = *(const LAS u32x4*)(R1 + row * LDQ + ch * 8);
        u32x4 o; o.x = pk2(siluf_(bflo(g.x)) * bflo(y.x), siluf_(bfhi(g.x)) * bfhi(y.x)); o.y = pk2(siluf_(bflo(g.y)) * bflo(y.y), siluf_(bfhi(g.y)) * bfhi(y.y));
        o.z = pk2(siluf_(bflo(g.z)) * bflo(y.z), siluf_(bfhi(g.z)) * bfhi(y.z)); o.w = pk2(siluf_(bflo(g.w)) * bflo(y.w), siluf_(bfhi(g.w)) * bfhi(y.w));
        if (!DRY || o.x == 0x12345678u) *(u32x4*)(proj + (size_t)(tok0 + row) * EVEN_IN + P0_GB + h * 256 + ch * 8) = o; }
    LBAR();
}

DI void peer_topk_unit(const Frame& F, int layer, int wu) {
    const int t0 = wu * 16, lane = F.lane, fr = lane & 15, fq = lane >> 4, tl = lane >> 2, qq = lane & 3;
    const bf16_t* Q = WSP(bf16_t, WS_Q); const bf16_t* KEYS = WSP(bf16_t, WS_KEYS) + (size_t)layer * 8 * 2 * 128 * 64;
    LAS float* SC = (LAS float*)(F.lds + F.wave * 16384);
    LAS float* TV = SC + 16 * 132;
    LAS int* TI = (LAS int*)(TV + 512);
    int* EIDX = WSP(int, WS_EIDX); float* GATE = WSP(float, WS_GATE);
    for (int hp = 0; hp < 16; ++hp) {
        f32x4 acc[8];
#pragma unroll
        for (int nf = 0; nf < 8; ++nf) acc[nf] = (f32x4){0.f, 0.f, 0.f, 0.f};
#pragma unroll
        for (int ks = 0; ks < 2; ++ks) { const bf16x8 a = *(const bf16x8*)(Q + (size_t)(t0 + fr) * 1024 + hp * 64 + 32 * ks + 8 * fq);
#pragma unroll
            for (int nf = 0; nf < 8; ++nf) { const bf16x8 bb = *(const bf16x8*)(KEYS + ((size_t)hp * 128 + 16 * nf + fr) * 64 + 32 * ks + 8 * fq); acc[nf] = MFMA16(a, bb, acc[nf]); } }
#pragma unroll
        for (int nf = 0; nf < 8; ++nf)
#pragma unroll
            for (int r = 0; r < 4; ++r) SC[(4 * fq + r) * 132 + 16 * nf + fr] = acc[nf][r];
        float vals[32];
#pragma unroll
        for (int i = 0; i < 32; ++i) vals[i] = SC[tl * 132 + 4 * i + qq];
        const int p = hp & 1;
#pragma unroll 1
        for (int rd = 0; rd < 16; ++rd) {
            float bv = vals[0]; int bi = 0;
#pragma unroll
            for (int i = 1; i < 32; ++i) { if (vals[i] > bv) { bv = vals[i]; bi = i; } }
            int bn = 4 * bi + qq;
#pragma unroll
            for (int o = 1; o < 4; o <<= 1) { const float ov = __shfl_xor(bv, o); const int on = __shfl_xor(bn, o); if (ov > bv || (ov == bv && on < bn)) { bv = ov; bn = on; } }
            const int wi = (bn & 3) == qq ? (bn >> 2) : -1;
#pragma unroll
            for (int i = 0; i < 32; ++i) vals[i] = (i == wi) ? -INFINITY : vals[i];
            if (qq == 0) { TV[(p * 16 + tl) * 16 + rd] = bv; TI[(p * 16 + tl) * 16 + rd] = bn; }
        }
        if (p == 1) {
            float cv[13]; int cij[13];
#pragma unroll
            for (int k = 0; k < 13; ++k) { cv[k] = -INFINITY; cij[k] = 255; }
            {
                int cnt = 0;
#pragma unroll
                for (int i = 0; i < 16; ++i)
#pragma unroll
                    for (int j = 0; j < 16; ++j) if ((i + 1) * (j + 1) <= 16) {
                        const float v = TV[(0 * 16 + tl) * 16 + i] + TV[(1 * 16 + tl) * 16 + j];
                        if (qq == (cnt & 3)) { cv[cnt >> 2] = v; cij[cnt >> 2] = i * 16 + j; }
                        ++cnt; }
            }
            float best[16]; int bidx[16];
#pragma unroll
            for (int rd = 0; rd < 16; ++rd) {
                float bv = cv[0]; int bk = 0;
#pragma unroll
                for (int k = 1; k < 13; ++k) { if (cv[k] > bv || (cv[k] == bv && cij[k] < cij[bk])) { bv = cv[k]; bk = k; } }
                int bc = cij[0];
#pragma unroll
                for (int k = 1; k < 13; ++k) bc = (k == bk) ? cij[k] : bc;
                int own = qq;
#pragma unroll
                for (int o = 1; o < 4; o <<= 1) { const float ov = __shfl_xor(bv, o); const int oc = __shfl_xor(bc, o); const int oo = __shfl_xor(own, o); if (ov > bv || (ov == bv && oc < bc)) { bv = ov; bc = oc; own = oo; } }
#pragma unroll
                for (int k = 0; k < 13; ++k) cv[k] = (own == qq && cij[k] == bc) ? -INFINITY : cv[k];
                best[rd] = bv; bidx[rd] = bc;
            }
            float sum = 0.f; float ex[16];
#pragma unroll
            for (int rd = 0; rd < 16; ++rd) { ex[rd] = __expf(best[rd] - best[0]); sum += ex[rd]; }
            const float inv = 1.f / sum;
            if (qq == 0) {
                const int hh = hp >> 1; const size_t o = (size_t)(t0 + tl) * 128 + hh * 16;
#pragma unroll
                for (int rd = 0; rd < 16; ++rd) { const int i = bidx[rd] >> 4, j = bidx[rd] & 15;
                    EIDX[o + rd] = TI[(0 * 16 + tl) * 16 + i] * 128 + TI[(1 * 16 + tl) * 16 + j]; GATE[o + rd] = ex[rd] * inv; }
            }
        }
    }
}

DI int f2ord(float f) { const int b = __builtin_bit_cast(int, f); return b ^ ((b >> 31) & 0x7fffffff); }
DI float ord2f(int o) { return __builtin_bit_cast(float, o ^ ((o >> 31) & 0x7fffffff)); }
#define CE_DESC(a, b) do { const int mx_ = max((a), (b)), mn_ = min((a), (b)); (a) = mx_; (b) = mn_; } while (0)
template <int N> DI void bitonic_sort_desc(int (&v)[N]) {
#pragma unroll
    for (int k = 2; k <= N; k <<= 1)
#pragma unroll
        for (int j = k >> 1; j > 0; j >>= 1)
#pragma unroll
            for (int i = 0; i < N; ++i) { const int l = i ^ j; if (l > i) { if ((i & k) == 0 || k == N) CE_DESC(v[i], v[l]); else CE_DESC(v[l], v[i]); } }
}
template <int N> DI void batcher_sort_desc(int (&v)[N]) {
#pragma unroll
    for (int p = 1; p < N; p <<= 1)
#pragma unroll
        for (int k = p; k >= 1; k >>= 1)
#pragma unroll
            for (int j = k % p; j <= N - 1 - k; j += 2 * k)
#pragma unroll
                for (int i = 0; i <= ((k - 1 < N - j - k - 1) ? k - 1 : N - j - k - 1); ++i)
                    if ((i + j) / (2 * p) == (i + j + k) / (2 * p)) CE_DESC(v[i + j], v[i + j + k]);
}
template <int N> DI void bitonic_merge_desc(int (&v)[N]) {
#pragma unroll
    for (int j = N >> 1; j > 0; j >>= 1)
#pragma unroll
        for (int i = 0; i < N; ++i) { const int l = i ^ j; if (l > i) CE_DESC(v[i], v[l]); }
}
template <int CTRL> DI void quad_merge16(int (&v)[16]) {
    int z[16];
#pragma unroll
    for (int k = 0; k < 16; ++k) z[k] = max(v[k], __builtin_amdgcn_mov_dpp(v[15 - k], CTRL, 0xf, 0xf, true));
    bitonic_merge_desc<16>(z);
#pragma unroll
    for (int k = 0; k < 16; ++k) v[k] = z[k];
}
DI void peer_topk2_unit(const Frame& F, int layer, int unit) {
    const int t0 = (unit >> 3) * 16, h = unit & 7, lane = F.lane, fr = lane & 15, fq = lane >> 4, tl = lane >> 2, qq = lane & 3;
    const bf16_t* Q = WSP(bf16_t, WS_Q); const bf16_t* KEYS = WSP(bf16_t, WS_KEYS) + (size_t)layer * 8 * 2 * 128 * 64;
    LAS float* SC = (LAS float*)(F.lds + F.wave * 16384);
    LAS int* IDX = (LAS int*)(SC + 16 * 132);
    int* EIDX = WSP(int, WS_EIDX); float* GATE = WSP(float, WS_GATE);
    int L[2][16];
#pragma unroll
    for (int p = 0; p < 2; ++p) {
        const int hp = 2 * h + p;
        f32x4 acc[8];
#pragma unroll
        for (int nf = 0; nf < 8; ++nf) acc[nf] = (f32x4){0.f, 0.f, 0.f, 0.f};
#pragma unroll
        for (int ks = 0; ks < 2; ++ks) { const bf16x8 a = *(const bf16x8*)(Q + (size_t)(t0 + fr) * 1024 + hp * 64 + 32 * ks + 8 * fq);
#pragma unroll
            for (int nf = 0; nf < 8; ++nf) { const bf16x8 bb = *(const bf16x8*)(KEYS + ((size_t)hp * 128 + 16 * nf + fr) * 64 + 32 * ks + 8 * fq); acc[nf] = MFMA16(a, bb, acc[nf]); } }
#pragma unroll
        for (int nf = 0; nf < 8; ++nf)
#pragma unroll
            for (int r = 0; r < 4; ++r) SC[(4 * fq + r) * 132 + 16 * nf + fr] = acc[nf][r];
        int ka[16], kb[16];
#pragma unroll
        for (int i = 0; i < 16; ++i) { ka[i] = (f2ord(SC[tl * 132 + 4 * i + qq]) & ~0x7f) | (127 - (4 * i + qq)); kb[i] = (f2ord(SC[tl * 132 + 4 * (i + 16) + qq]) & ~0x7f) | (127 - (4 * (i + 16) + qq)); }
        bitonic_sort_desc<16>(ka); bitonic_sort_desc<16>(kb);
#pragma unroll
        for (int k = 0; k < 16; ++k) ka[k] = max(ka[k], kb[15 - k]);
        bitonic_merge_desc<16>(ka);
        quad_merge16<0xB1>(ka);
        quad_merge16<0x4E>(ka);
#pragma unroll
        for (int k = 0; k < 16; ++k) L[p][k] = ka[k];
        if (qq == 0) {
#pragma unroll
            for (int k = 0; k < 16; ++k) IDX[(tl * 2 + p) * 16 + k] = 127 - (ka[k] & 0x7f);
        }
    }
    float fa[16], fb[16];
#pragma unroll
    for (int k = 0; k < 16; ++k) { fa[k] = ord2f(L[0][k] & ~0x7f); fb[k] = ord2f(L[1][k] & ~0x7f); }
    int cv[16];
#pragma unroll
    for (int k = 0; k < 16; ++k) cv[k] = (int)0x80000000;
    {
        int cnt = 0;
#pragma unroll
        for (int i = 0; i < 16; ++i)
#pragma unroll
            for (int j = 0; j < 16; ++j) if ((i + 1) * (j + 1) <= 16) {
                const int key = (f2ord(fa[i] + fb[j]) & ~0xff) | (255 - (16 * i + j));
                if (qq == (cnt & 3)) cv[cnt >> 2] = key;
                ++cnt; }
    }
    bitonic_sort_desc<16>(cv);
    quad_merge16<0xB1>(cv);
    quad_merge16<0x4E>(cv);
    const float b0 = ord2f(cv[0] & ~0xff);
    float ex[16]; float sum = 0.f;
#pragma unroll
    for (int k = 0; k < 16; ++k) { ex[k] = __expf(ord2f(cv[k] & ~0xff) - b0); sum += ex[k]; }
    const float inv = 1.f / sum;
#pragma unroll
    for (int m = 0; m < 4; ++m) {
        const int key = (qq == 0) ? cv[4 * m] : (qq == 1) ? cv[4 * m + 1] : (qq == 2) ? cv[4 * m + 2] : cv[4 * m + 3];
        const float g = ((qq == 0) ? ex[4 * m] : (qq == 1) ? ex[4 * m + 1] : (qq == 2) ? ex[4 * m + 2] : ex[4 * m + 3]) * inv;
        const int code = 255 - (key & 0xff), i = code >> 4, j = code & 15;
        const int e = IDX[(tl * 2 + 0) * 16 + i] * 128 + IDX[(tl * 2 + 1) * 16 + j];
        const size_t o = (size_t)(t0 + tl) * 128 + h * 16 + 4 * m + qq;
        EIDX[o] = e; GATE[o] = g;
    }
}

DI void peer_topk3_tile(const Frame& F, int layer, int pm, int pn, bool rider) {
    const int lane = F.lane, fr = lane & 15, fq = lane >> 4, tl = lane >> 2, qq = lane & 3, h = 2 * pn + (F.wave & 1), tg0 = 16 * pm + (F.wave >> 1);
    const bf16_t* Q = WSP(bf16_t, WS_Q); const bf16_t* KEYS = WSP(bf16_t, WS_KEYS) + (size_t)layer * 8 * 2 * 128 * 64;
    LAS float* SC = (LAS float*)(F.lds + F.wave * 16896);
    LAS int* LST = (LAS int*)(SC + 16 * 132);
    int* EIDX = WSP(int, WS_EIDX); float* GATE = WSP(float, WS_GATE);
    const int trow0 = F.vcu * NWAVES + F.wave;
    f32x4 tg[4], tva[4], tvb[4];
#pragma unroll
    for (int i = 0; i < 4; ++i) { tg[i] = (f32x4){1.f, 1.f, 1.f, 1.f}; tva[i] = (f32x4){0.f, 0.f, 0.f, 0.f}; tvb[i] = (f32x4){0.f, 0.f, 0.f, 0.f}; }
    if (rider) { const f32x4* g4 = (const f32x4*)F.in[2] + 2 * lane; tg[0] = g4[0]; tg[1] = g4[1]; tg[2] = g4[128]; tg[3] = g4[129]; }
#define TK_TLOAD(tv_, k_) do { const int tr_ = trow0 + 2048 * (k_); const float* src = (tr_ < 16384) ? F.in[23] + (size_t)tr_ * 1024 : F.in[24] + (size_t)(tr_ - 16384) * 1024; const f32x4* s4 = (const f32x4*)src + 2 * lane; \
        tv_[0] = s4[0]; tv_[1] = s4[1]; tv_[2] = s4[128]; tv_[3] = s4[129]; asm volatile("" ::: "memory"); } while (0)
#define TK_TSTORE(tv_, k_) do { const int tr_ = trow0 + 2048 * (k_); const bool isu = tr_ < 16384; const int e_ = isu ? tr_ : tr_ - 16384; const float scl = isu ? PEER_SU : PEER_SV; \
        unsigned char* dstb = (isu ? WSP(unsigned char, WS_UB) : WSP(unsigned char, WS_VB)) + (size_t)(lane >> 5) * (16384 * 128) + (size_t)e_ * 128 + 4 * (lane & 31); \
        _Pragma("unroll") for (int j = 0; j < 2; ++j) { f32x4 a4 = tv_[2 * j] * scl, b4 = tv_[2 * j + 1] * scl; if (isu) { a4 = a4 * tg[2 * j]; b4 = b4 * tg[2 * j + 1]; } \
            unsigned wq = 0; \
            wq = __builtin_amdgcn_cvt_scalef32_pk_fp4_f32(wq, a4[0], a4[1], 1.0f, 0); wq = __builtin_amdgcn_cvt_scalef32_pk_fp4_f32(wq, a4[2], a4[3], 1.0f, 1); \
            wq = __builtin_amdgcn_cvt_scalef32_pk_fp4_f32(wq, b4[0], b4[1], 1.0f, 2); wq = __builtin_amdgcn_cvt_scalef32_pk_fp4_f32(wq, b4[2], b4[3], 1.0f, 3); \
            *(unsigned*)(dstb + (size_t)j * (2 * 16384 * 128)) = wq; } } while (0)
#pragma unroll 1
    for (int p = 0; p < 2; ++p) {
        const int hp = 2 * h + p;
        bf16x8 kf[2][8];
#pragma unroll
        for (int ks = 0; ks < 2; ++ks)
#pragma unroll
            for (int nf = 0; nf < 8; ++nf) kf[ks][nf] = *(const bf16x8*)(KEYS + ((size_t)hp * 128 + 16 * nf + fr) * 64 + 32 * ks + 8 * fq);
        bf16x8 qa[2], qn[2];
#pragma unroll
        for (int ks = 0; ks < 2; ++ks) qa[ks] = *(const bf16x8*)(Q + (size_t)(tg0 * 16 + fr) * 1024 + hp * 64 + 32 * ks + 8 * fq);
        asm volatile("" ::: "memory");
#pragma unroll 1
        for (int uu = 0; uu < 4; ++uu) {
            const int tgn = tg0 + 4 * ((uu < 3) ? uu + 1 : uu);
#pragma unroll
            for (int ks = 0; ks < 2; ++ks) qn[ks] = *(const bf16x8*)(Q + (size_t)(tgn * 16 + fr) * 1024 + hp * 64 + 32 * ks + 8 * fq);
            asm volatile("" ::: "memory");
            if (rider) { TK_TLOAD(tva, 2 * (4 * p + uu)); TK_TLOAD(tvb, 2 * (4 * p + uu) + 1); }
            f32x4 acc[8];
#pragma unroll
            for (int nf = 0; nf < 8; ++nf) acc[nf] = (f32x4){0.f, 0.f, 0.f, 0.f};
#pragma unroll
            for (int ks = 0; ks < 2; ++ks)
#pragma unroll
                for (int nf = 0; nf < 8; ++nf) acc[nf] = MFMA16(qa[ks], kf[ks][nf], acc[nf]);
#pragma unroll
            for (int nf = 0; nf < 8; ++nf)
#pragma unroll
                for (int r = 0; r < 4; ++r) SC[(4 * fq + r) * 132 + 16 * nf + fr] = acc[nf][r];
            int ka[16], kb[16];
#pragma unroll
            for (int i4 = 0; i4 < 4; ++i4) { const f32x4 sa = *(const LAS f32x4*)(SC + tl * 132 + 32 * qq + 4 * i4), sb = *(const LAS f32x4*)(SC + tl * 132 + 32 * qq + 16 + 4 * i4);
#pragma unroll
                for (int e4 = 0; e4 < 4; ++e4) { const int i = 4 * i4 + e4; const float va = sa[e4], vb = sb[e4]; ka[i] = (f2ord(va) & ~0x7f) | (127 - (32 * qq + i)); kb[i] = (f2ord(vb) & ~0x7f) | (127 - (32 * qq + 16 + i)); } }
            batcher_sort_desc<16>(ka); batcher_sort_desc<16>(kb);
#pragma unroll
            for (int k = 0; k < 16; ++k) ka[k] = max(ka[k], kb[15 - k]);
            bitonic_merge_desc<16>(ka);
            quad_merge16<0xB1>(ka);
            quad_merge16<0x4E>(ka);
            if (qq == 0) { LAS int* dst = LST + ((uu * 2 + p) * 16 + tl) * 16;
#pragma unroll
                for (int k4 = 0; k4 < 4; ++k4) *(LAS u32x4*)(dst + 4 * k4) = (u32x4){(unsigned)ka[4 * k4], (unsigned)ka[4 * k4 + 1], (unsigned)ka[4 * k4 + 2], (unsigned)ka[4 * k4 + 3]}; }
            if (rider) { TK_TSTORE(tva, 2 * (4 * p + uu)); TK_TSTORE(tvb, 2 * (4 * p + uu) + 1); }
            qa[0] = qn[0]; qa[1] = qn[1];
        }
    }
#pragma unroll 1
    for (int uu = 0; uu < 4; ++uu) {
        const int t0 = (tg0 + 4 * uu) * 16;
        const LAS int* l0 = LST + ((uu * 2 + 0) * 16 + tl) * 16; const LAS int* l1 = LST + ((uu * 2 + 1) * 16 + tl) * 16;
        const unsigned tb0 = (qq == 0) ? 0x0c080400u : (qq == 1) ? 0x0d090501u : (qq == 2) ? 0x0e0a0602u : 0x0f0b0703u;
        const unsigned tb1 = (qq == 0) ? 0x24201410u : (qq == 1) ? 0x30211511u : (qq == 2) ? 0x31221612u : 0x32231713u;
        const unsigned tb2 = (qq == 0) ? 0xa0705033u : (qq == 1) ? 0xb0715140u : (qq == 2) ? 0xc0806041u : 0xd0906142u;
        const unsigned tb3 = (qq == 0) ? 0xffffffe0u : (qq == 1) ? 0xfffffff0u : 0xffffffffu;
        int cv[16];
#pragma unroll
        for (int k = 0; k < 16; ++k) cv[k] = (int)0x80000000;
#pragma unroll
        for (int k = 0; k < 13; ++k) { const unsigned tw = (k < 4) ? tb0 : (k < 8) ? tb1 : (k < 12) ? tb2 : tb3; const unsigned bcode = (tw >> (8 * (k & 3))) & 0xffu;
            const unsigned bi = (k < 12 || qq < 2) ? bcode : 0u;
            const float fa_ = ord2f(l0[bi >> 4] & ~0x7f), fb_ = ord2f(l1[bi & 15u] & ~0x7f);
            const int key = (f2ord(fa_ + fb_) & ~0xff) | (int)(255u - bcode);
            cv[k] = (k < 12 || qq < 2) ? key : (int)0x80000000; }
        batcher_sort_desc<16>(cv);
        quad_merge16<0xB1>(cv);
        quad_merge16<0x4E>(cv);
        const float b0 = ord2f(cv[0] & ~0xff);
        int kq[4]; float exq[4]; float sum = 0.f;
#pragma unroll
        for (int m = 0; m < 4; ++m) { kq[m] = (qq == 0) ? cv[4 * m] : (qq == 1) ? cv[4 * m + 1] : (qq == 2) ? cv[4 * m + 2] : cv[4 * m + 3]; exq[m] = __expf(ord2f(kq[m] & ~0xff) - b0); sum += exq[m]; }
        sum += __builtin_bit_cast(float, __builtin_amdgcn_update_dpp(0, __builtin_bit_cast(int, sum), 0xB1, 0xf, 0xf, false));
        sum += __builtin_bit_cast(float, __builtin_amdgcn_update_dpp(0, __builtin_bit_cast(int, sum), 0x4E, 0xf, 0xf, false));
        const float inv = frcp(sum);
#pragma unroll
        for (int m = 0; m < 4; ++m) {
            const int key = kq[m];
            const float g = exq[m] * inv;
            const int code = 255 - (key & 0xff), i = code >> 4, j = code & 15;
            const int e = (127 - (l0[i] & 0x7f)) * 128 + (127 - (l1[j] & 0x7f));
            const size_t o = (size_t)(t0 + tl) * 128 + h * 16 + 4 * m + qq;
            EIDX[o] = e; GATE[o] = g;
        }
    }
}
#undef TK_TLOAD
#undef TK_TSTORE

template <bool FINAL, bool DRY = false>
DI void peer_token(const Frame& F, int t) {
    const int lane = F.lane, qd = lane >> 4, li = lane & 15;
    const bf16_t* UB = WSP(bf16_t, WS_UB); const bf16_t* VB = WSP(bf16_t, WS_VB); bf16_t* XB = WSP(bf16_t, WS_XB);
    const int* EIDX = WSP(int, WS_EIDX); const float* GATE = WSP(float, WS_GATE);
    float sl = (lane < 16) ? WSP(float, WS_SLOTS)[(size_t)t * 16 + lane] : 0.f;
    const float rstd = rsqrtf(wave_sum(sl) * (1.f / 1024.f) + EPS);
    const int e0 = EIDX[(size_t)t * 128 + lane], e1 = EIDX[(size_t)t * 128 + 64 + lane];
    const float g0 = GATE[(size_t)t * 128 + lane], g1 = GATE[(size_t)t * 128 + 64 + lane];
    u32x4 xq[8];
#pragma unroll
    for (int c = 0; c < 8; ++c) xq[c] = *(const u32x4*)(XB + (size_t)t * 1024 + (c * 16 + li) * 8);
    float act[32];
#pragma unroll
    for (int g = 0; g < 32; ++g) {
        const int src = (4 * g + qd) & 63;
        const int e = __shfl((g < 16) ? e0 : e1, src);
        const float gt = __shfl((g < 16) ? g0 : g1, src);
        const bf16_t* row = UB + (size_t)e * 1024;
        float d = 0.f;
#pragma unroll
        for (int c = 0; c < 8; ++c) { const u32x4 u = *(const u32x4*)(row + (c * 16 + li) * 8);
            d = dot2bf(u.x, xq[c].x, d); d = dot2bf(u.y, xq[c].y, d); d = dot2bf(u.z, xq[c].z, d); d = dot2bf(u.w, xq[c].w, d); }
        d += __shfl_xor(d, 1); d += __shfl_xor(d, 2); d += __shfl_xor(d, 4); d += __shfl_xor(d, 8);
        act[g] = (DBG_SKIP & 1) ? 0.f : gelu_tanh(d * rstd) * gt;
    }
    float o[16];
#pragma unroll
    for (int i = 0; i < 16; ++i) o[i] = 0.f;
#pragma unroll
    for (int g = 0; g < 32; ++g) {
#pragma unroll
        for (int q4 = 0; q4 < 4; ++q4) {
            const int k = 4 * g + q4;
            const int e = __builtin_amdgcn_readlane((g < 16) ? e0 : e1, k & 63);
            const float a = __builtin_bit_cast(float, __builtin_amdgcn_readlane(__builtin_bit_cast(int, act[g]), 16 * q4));
            const bf16_t* row = VB + (size_t)e * 1024;
            const u32x4 v0 = *(const u32x4*)(row + 8 * lane), v1 = *(const u32x4*)(row + 512 + 8 * lane);
            o[0] += a * bflo(v0.x); o[1] += a * bfhi(v0.x); o[2] += a * bflo(v0.y); o[3] += a * bfhi(v0.y); o[4] += a * bflo(v0.z); o[5] += a * bfhi(v0.z); o[6] += a * bflo(v0.w); o[7] += a * bfhi(v0.w);
            o[8] += a * bflo(v1.x); o[9] += a * bfhi(v1.x); o[10] += a * bflo(v1.y); o[11] += a * bfhi(v1.y); o[12] += a * bflo(v1.z); o[13] += a * bfhi(v1.z); o[14] += a * bflo(v1.w); o[15] += a * bfhi(v1.w);
        }
    }
    float* xo = F.out + (size_t)t * 1024;
    float ss = 0.f;
#pragma unroll
    for (int hlf = 0; hlf < 2; ++hlf)
#pragma unroll
        for (int q = 0; q < 2; ++q) { const f32x4 r = *(const f32x4*)(xo + hlf * 512 + 8 * lane + 4 * q);
#pragma unroll
            for (int j = 0; j < 4; ++j) { o[hlf * 8 + q * 4 + j] += r[j]; ss += o[hlf * 8 + q * 4 + j] * o[hlf * 8 + q * 4 + j]; } }
    const float rs2 = rsqrtf(wave_sum(ss) * (1.f / 1024.f) + EPS);
    if (DRY && rs2 != -1.f) return;
    if (FINAL) {
        const float* fg = F.in[3];
#pragma unroll
        for (int hlf = 0; hlf < 2; ++hlf)
#pragma unroll
            for (int q = 0; q < 2; ++q) { const f32x4 g = *(const f32x4*)(fg + hlf * 512 + 8 * lane + 4 * q); f32x4 w;
#pragma unroll
                for (int j = 0; j < 4; ++j) w[j] = o[hlf * 8 + q * 4 + j] * rs2 * g[j];
                *(f32x4*)(xo + hlf * 512 + 8 * lane + 4 * q) = w; }
    } else {
        if (lane == 0) WSP(float, WS_RSTD)[t] = rs2;
#pragma unroll
        for (int hlf = 0; hlf < 2; ++hlf) {
#pragma unroll
            for (int q = 0; q < 2; ++q) { f32x4 w;
#pragma unroll
                for (int j = 0; j < 4; ++j) w[j] = o[hlf * 8 + q * 4 + j];
                *(f32x4*)(xo + hlf * 512 + 8 * lane + 4 * q) = w; }
            u32x4 w; w.x = pk2(o[hlf * 8 + 0], o[hlf * 8 + 1]); w.y = pk2(o[hlf * 8 + 2], o[hlf * 8 + 3]); w.z = pk2(o[hlf * 8 + 4], o[hlf * 8 + 5]); w.w = pk2(o[hlf * 8 + 6], o[hlf * 8 + 7]);
            *(u32x4*)(XB + (size_t)t * 1024 + hlf * 512 + 8 * lane) = w;
        }
    }
}

DI f32x2 fp8lo(unsigned w) { return __builtin_amdgcn_cvt_pk_f32_fp8((int)w, false); }
DI f32x2 fp8hi(unsigned w) { return __builtin_amdgcn_cvt_pk_f32_fp8((int)w, true); }
template <bool FINAL, bool DRY = false>
DI void peer_token8(const Frame& F, int t) {
    const int lane = F.lane, qd = lane >> 4, li = lane & 15;
    const unsigned char* UB = WSP(unsigned char, WS_UB); const unsigned char* VB = WSP(unsigned char, WS_VB); bf16_t* XB = WSP(bf16_t, WS_XB);
    const int* EIDX = WSP(int, WS_EIDX); const float* GATE = WSP(float, WS_GATE);
    float sl = (lane < 16) ? WSP(float, WS_SLOTS)[(size_t)t * 16 + lane] : 0.f;
    const float rstd = rsqrtf(wave_sum(sl) * (1.f / 1024.f) + EPS);
    const int e0 = EIDX[(size_t)t * 128 + lane], e1 = EIDX[(size_t)t * 128 + 64 + lane];
    const float g0 = GATE[(size_t)t * 128 + lane], g1 = GATE[(size_t)t * 128 + 64 + lane];
    f32x2 xq[4][8];
#pragma unroll
    for (int c = 0; c < 4; ++c)
#pragma unroll
        for (int hf = 0; hf < 2; ++hf) { const u32x4 w = *(const u32x4*)(XB + (size_t)t * 1024 + (c * 16 + li) * 16 + 8 * hf);
            xq[c][4 * hf + 0] = (f32x2){bflo(w.x), bfhi(w.x)}; xq[c][4 * hf + 1] = (f32x2){bflo(w.y), bfhi(w.y)}; xq[c][4 * hf + 2] = (f32x2){bflo(w.z), bfhi(w.z)}; xq[c][4 * hf + 3] = (f32x2){bflo(w.w), bfhi(w.w)}; }
    const float zs = rstd * (1.f / PEER_SU);
    float act[32];
#pragma unroll
    for (int g = 0; g < 32; ++g) {
        const int src = (4 * g + qd) & 63;
        const int e = __shfl((g < 16) ? e0 : e1, src);
        const float gt = __shfl((g < 16) ? g0 : g1, src);
        const unsigned char* row = UB + (size_t)e * 1024;
        f32x2 d2 = (f32x2){0.f, 0.f};
#pragma unroll
        for (int c = 0; c < 4; ++c) { const u32x4 u = *(const u32x4*)(row + (c * 16 + li) * 16);
            d2 += fp8lo(u.x) * xq[c][0]; d2 += fp8hi(u.x) * xq[c][1]; d2 += fp8lo(u.y) * xq[c][2]; d2 += fp8hi(u.y) * xq[c][3];
            d2 += fp8lo(u.z) * xq[c][4]; d2 += fp8hi(u.z) * xq[c][5]; d2 += fp8lo(u.w) * xq[c][6]; d2 += fp8hi(u.w) * xq[c][7]; }
        float d = d2.x + d2.y;
        d += __shfl_xor(d, 1); d += __shfl_xor(d, 2); d += __shfl_xor(d, 4); d += __shfl_xor(d, 8);
        act[g] = gelu_tanh(d * zs) * gt * (1.f / PEER_SV);
    }
    f32x2 o2[8];
#pragma unroll
    for (int i = 0; i < 8; ++i) o2[i] = (f32x2){0.f, 0.f};
#pragma unroll
    for (int g = 0; g < 32; ++g) {
#pragma unroll
        for (int q4 = 0; q4 < 4; ++q4) {
            const int k = 4 * g + q4;
            const int e = __builtin_amdgcn_readlane((g < 16) ? e0 : e1, k & 63);
            const float a = __builtin_bit_cast(float, __builtin_amdgcn_readlane(__builtin_bit_cast(int, act[g]), 16 * q4));
            const u32x4 v = *(const u32x4*)(VB + (size_t)e * 1024 + 16 * lane);
            o2[0] += fp8lo(v.x) * a; o2[1] += fp8hi(v.x) * a; o2[2] += fp8lo(v.y) * a; o2[3] += fp8hi(v.y) * a;
            o2[4] += fp8lo(v.z) * a; o2[5] += fp8hi(v.z) * a; o2[6] += fp8lo(v.w) * a; o2[7] += fp8hi(v.w) * a;
        }
    }
    float* xo = F.out + (size_t)t * 1024 + 16 * lane;
    float o[16]; float ss = 0.f;
#pragma unroll
    for (int q = 0; q < 4; ++q) { const f32x4 r = *(const f32x4*)(xo + 4 * q);
        o[4 * q + 0] = o2[2 * q].x + r[0]; o[4 * q + 1] = o2[2 * q].y + r[1]; o[4 * q + 2] = o2[2 * q + 1].x + r[2]; o[4 * q + 3] = o2[2 * q + 1].y + r[3];
#pragma unroll
        for (int j = 0; j < 4; ++j) ss += o[4 * q + j] * o[4 * q + j]; }
    const float rs2 = rsqrtf(wave_sum(ss) * (1.f / 1024.f) + EPS);
    if (DRY && rs2 != -1.f) return;
    if (FINAL) {
        const float* fg = F.in[3] + 16 * lane;
#pragma unroll
        for (int q = 0; q < 4; ++q) { const f32x4 gq = *(const f32x4*)(fg + 4 * q); f32x4 w;
#pragma unroll
            for (int j = 0; j < 4; ++j) w[j] = o[4 * q + j] * rs2 * gq[j];
            *(f32x4*)(xo + 4 * q) = w; }
    } else {
        if (lane == 0) WSP(float, WS_RSTD)[t] = rs2;
#pragma unroll
        for (int q = 0; q < 4; ++q) { f32x4 w;
#pragma unroll
            for (int j = 0; j < 4; ++j) w[j] = o[4 * q + j];
            *(f32x4*)(xo + 4 * q) = w; }
#pragma unroll
        for (int hf = 0; hf < 2; ++hf) { u32x4 w; w.x = pk2(o[8 * hf + 0], o[8 * hf + 1]); w.y = pk2(o[8 * hf + 2], o[8 * hf + 3]); w.z = pk2(o[8 * hf + 4], o[8 * hf + 5]); w.w = pk2(o[8 * hf + 6], o[8 * hf + 7]);
            *(u32x4*)(XB + (size_t)t * 1024 + 16 * lane + 8 * hf) = w; }
    }
}

template <int SEL> DI f32x2 fp4p(unsigned w) { return __builtin_amdgcn_cvt_scalef32_pk_f32_fp4(w, 1.0f, SEL); }
template <int SEL> DI bf2_t fp4b(unsigned w) { return __builtin_amdgcn_cvt_scalef32_pk_bf16_fp4(w, 1.0f, SEL); }
template <bool FINAL, bool DRY = false>
DI void peer_token4(const Frame& F, int t) {
    const int lane = F.lane, qd = lane >> 4, li = lane & 15;
    const unsigned char* UB = WSP(unsigned char, WS_UB); const unsigned char* VB = WSP(unsigned char, WS_VB); bf16_t* XB = WSP(bf16_t, WS_XB);
    const int* EIDX = WSP(int, WS_EIDX); const float* GATE = WSP(float, WS_GATE);
    float sl = (lane < 16) ? WSP(float, WS_SLOTS)[(size_t)t * 16 + lane] : 0.f;
    const float rstd = rsqrtf(wave_sum(sl) * (1.f / 1024.f) + EPS);
    const int e0 = EIDX[(size_t)t * 128 + lane], e1 = EIDX[(size_t)t * 128 + 64 + lane];
    unsigned xq[2][16];
#pragma unroll
    for (int c = 0; c < 2; ++c)
#pragma unroll
        for (int hf = 0; hf < 4; ++hf) { const u32x4 w = *(const u32x4*)(XB + (size_t)t * 1024 + (c * 16 + li) * 32 + 8 * hf);
            xq[c][4 * hf + 0] = w.x; xq[c][4 * hf + 1] = w.y; xq[c][4 * hf + 2] = w.z; xq[c][4 * hf + 3] = w.w; }
    const float zs = rstd * (1.f / PEER_SU);
    float zlo = 0.f, zhi = 0.f;
    u32x4 uA[4][2], uB[4][2];
#define PT4_ULOAD(buf, bt_) do { _Pragma("unroll") for (int gg = 0; gg < 4; ++gg) { const int g = 4 * (bt_) + gg; const int src = (4 * g + qd) & 63; \
        const int e = __shfl((g < 16) ? e0 : e1, src); const unsigned char* row = UB + (size_t)e * 512; \
        buf[gg][0] = *(const u32x4*)(row + li * 16); buf[gg][1] = *(const u32x4*)(row + (16 + li) * 16); } asm volatile("" ::: "memory"); } while (0)
#define PT4_DOT4(w_, c_, m_) do { d0 = __builtin_amdgcn_fdot2_f32_bf16(fp4b<0>(w_), __builtin_bit_cast(bf2_t, xq[c_][m_]), d0, false); d1 = __builtin_amdgcn_fdot2_f32_bf16(fp4b<1>(w_), __builtin_bit_cast(bf2_t, xq[c_][(m_) + 1]), d1, false); \
        d2 = __builtin_amdgcn_fdot2_f32_bf16(fp4b<2>(w_), __builtin_bit_cast(bf2_t, xq[c_][(m_) + 2]), d2, false); d3 = __builtin_amdgcn_fdot2_f32_bf16(fp4b<3>(w_), __builtin_bit_cast(bf2_t, xq[c_][(m_) + 3]), d3, false); } while (0)
#define PT4_UCOMP(buf, bt_) do { _Pragma("unroll") for (int gg = 0; gg < 4; ++gg) { const int g = 4 * (bt_) + gg; float d0 = 0.f, d1 = 0.f, d2 = 0.f, d3 = 0.f; \
        _Pragma("unroll") for (int c = 0; c < 2; ++c) { const unsigned ux = buf[gg][c].x, uy = buf[gg][c].y, uz = buf[gg][c].z, uw = buf[gg][c].w; \
            PT4_DOT4(ux, c, 0); PT4_DOT4(uy, c, 4); PT4_DOT4(uz, c, 8); PT4_DOT4(uw, c, 12); } \
        const float d = row16_sum((d0 + d1) + (d2 + d3)); \
        if (g < 16) zlo = (li == g) ? d : zlo; else zhi = (li == g - 16) ? d : zhi; } } while (0)
    u32x2 vA[16], vB[16];
#define PT4_VLOAD(buf, bt_) do { _Pragma("unroll") for (int kk = 0; kk < 16; ++kk) { const int k = 16 * (bt_) + kk; const int e = __builtin_amdgcn_readlane((k < 64) ? e0 : e1, k & 63); \
        buf[kk] = *(const u32x2*)(VB + (size_t)e * 512 + 8 * lane); } asm volatile("" ::: "memory"); } while (0)
#define PT4_VCOMP(buf, bt_) do { _Pragma("unroll") for (int kk = 0; kk < 16; ++kk) { const int k = 16 * (bt_) + kk; const int g = k >> 2, q4 = k & 3; \
        const float a = __builtin_bit_cast(float, __builtin_amdgcn_readlane(__builtin_bit_cast(int, (g < 16) ? actlo : acthi), 16 * q4 + (g & 15))); const u32x2 v = buf[kk]; \
        o2[0] += fp4p<0>(v.x) * a; o2[1] += fp4p<1>(v.x) * a; o2[2] += fp4p<2>(v.x) * a; o2[3] += fp4p<3>(v.x) * a; \
        o2[4] += fp4p<0>(v.y) * a; o2[5] += fp4p<1>(v.y) * a; o2[6] += fp4p<2>(v.y) * a; o2[7] += fp4p<3>(v.y) * a; } } while (0)
    PT4_ULOAD(uA, 0);
    PT4_ULOAD(uB, 1); PT4_UCOMP(uA, 0);
    PT4_ULOAD(uA, 2); PT4_UCOMP(uB, 1);
    PT4_ULOAD(uB, 3); PT4_UCOMP(uA, 2);
    PT4_ULOAD(uA, 4); PT4_UCOMP(uB, 3);
    PT4_ULOAD(uB, 5); PT4_UCOMP(uA, 4);
    PT4_ULOAD(uA, 6); PT4_UCOMP(uB, 5);
    PT4_ULOAD(uB, 7); PT4_UCOMP(uA, 6);
    PT4_VLOAD(vA, 0);     PT4_UCOMP(uB, 7);
    const float actlo = gelu_tanh(zlo * zs) * GATE[(size_t)t * 128 + 4 * li + qd] * (1.f / PEER_SV);
    const float acthi = gelu_tanh(zhi * zs) * GATE[(size_t)t * 128 + 64 + 4 * li + qd] * (1.f / PEER_SV);
    f32x2 o2[8];
#pragma unroll
    for (int i = 0; i < 8; ++i) o2[i] = (f32x2){0.f, 0.f};
    PT4_VLOAD(vB, 1); PT4_VCOMP(vA, 0);
    PT4_VLOAD(vA, 2); PT4_VCOMP(vB, 1);
    PT4_VLOAD(vB, 3); PT4_VCOMP(vA, 2);
    PT4_VLOAD(vA, 4); PT4_VCOMP(vB, 3);
    PT4_VLOAD(vB, 5); PT4_VCOMP(vA, 4);
    PT4_VLOAD(vA, 6); PT4_VCOMP(vB, 5);
    PT4_VLOAD(vB, 7); PT4_VCOMP(vA, 6);
    PT4_VCOMP(vB, 7);
#undef PT4_ULOAD
#undef PT4_UCOMP
#undef PT4_DOT4
#undef PT4_VLOAD
#undef PT4_VCOMP
    float* xo = F.out + (size_t)t * 1024 + 16 * lane;
    float o[16]; float ss = 0.f;
    { const u32x4 r0 = *(const u32x4*)(XB + (size_t)t * 1024 + 16 * lane), r1 = *(const u32x4*)(XB + (size_t)t * 1024 + 16 * lane + 8);
      const unsigned rw[8] = {r0.x, r0.y, r0.z, r0.w, r1.x, r1.y, r1.z, r1.w};
#pragma unroll
      for (int m = 0; m < 8; ++m) { o[2 * m] = o2[m].x + bflo(rw[m]); o[2 * m + 1] = o2[m].y + bfhi(rw[m]); ss += o[2 * m] * o[2 * m] + o[2 * m + 1] * o[2 * m + 1]; } }
    const float rs2 = rsqrtf(wave_sum(ss) * (1.f / 1024.f) + EPS);
    if (DRY && rs2 != -1.f) return;
    if (FINAL) {
        const float* fg = F.in[3] + 16 * lane;
#pragma unroll
        for (int q = 0; q < 4; ++q) { const f32x4 gq = *(const f32x4*)(fg + 4 * q); f32x4 w;
#pragma unroll
            for (int j = 0; j < 4; ++j) w[j] = o[4 * q + j] * rs2 * gq[j];
            *(f32x4*)(xo + 4 * q) = w; }
    } else {
        if (lane == 0) WSP(float, WS_RSTD)[t] = rs2;
#pragma unroll
        for (int hf = 0; hf < 2; ++hf) { u32x4 w; w.x = pk2(o[8 * hf + 0], o[8 * hf + 1]); w.y = pk2(o[8 * hf + 2], o[8 * hf + 3]); w.z = pk2(o[8 * hf + 4], o[8 * hf + 5]); w.w = pk2(o[8 * hf + 6], o[8 * hf + 7]);
            *(u32x4*)(XB + (size_t)t * 1024 + 16 * lane + 8 * hf) = w; }
    }
}
typedef int v8i_t __attribute__((ext_vector_type(8)));
constexpr size_t WS_ZP = 200 * MiB;
constexpr float PEER_XL = 8.f;
#define PM_X4(hw, lw, word, SEL) do { const float a = bflo(word), b2 = bfhi(word); hw = __builtin_amdgcn_cvt_scalef32_pk_fp4_f32(hw, a, b2, 1.0f, SEL); \
          const f32x2 hv = fp4p<SEL>(hw); lw = __builtin_amdgcn_cvt_scalef32_pk_fp4_f32(lw, (a - hv.x) * PEER_XL, (b2 - hv.y) * PEER_XL, 1.0f, SEL); } while (0)
DI void peer_u_phase(const Frame& F) {
    const int lane = F.lane, r16 = lane & 15, kq = lane >> 4, rho = lane >> 3, c8 = lane & 7;
    const unsigned char* UB = WSP(unsigned char, WS_UB); const bf16_t* XB = WSP(bf16_t, WS_XB);
    const int* EIDX = WSP(int, WS_EIDX); float* ZP = WSP(float, WS_ZP);
    LAS unsigned char* rowsL = F.lds + F.wave * 16640; LAS unsigned char* x8 = rowsL + 16384;
    const bool sliced = (F.G % 4) == 0;
    const int q = sliced ? F.G / 4 : F.G;
    const int wi = (sliced ? F.vcu % q : F.vcu) * NWAVES + F.wave, nw = q * NWAVES;
    const int s0 = sliced ? F.vcu / q : 0, s1 = sliced ? s0 + 1 : 4;
    const int goff0 = 16 * (c8 ^ (rho >> 1)), goff1 = 16 * (c8 ^ (4 + (rho >> 1)));
    const int aoff0 = r16 * 128 + 16 * (kq ^ ((r16 >> 1) & 7)), aoff1 = r16 * 128 + 16 * ((4 + kq) ^ ((r16 >> 1) & 7));
    for (int s = s0; s < s1; ++s) {
        const unsigned char* UBs = UB + (size_t)s * (16384 * 128);
        int e0A, e1A, e0B, e1B; u32x4 rr[16]; u32x2 xA, xC;
#define PU_IDX(e0b, e1b, xb, t_) do { const int tt = min((t_), T - 1); xb = *(const u32x2*)(XB + (size_t)tt * 1024 + 256 * s + 4 * lane); \
            e0b = EIDX[(size_t)tt * 128 + lane]; e1b = EIDX[(size_t)tt * 128 + 64 + lane]; asm volatile("" ::: "memory"); } while (0)
#define PU_ROWS(e0b, e1b) do { _Pragma("unroll") for (int j = 0; j < 16; ++j) { const int e = __shfl((j < 8) ? e0b : e1b, (8 * j + rho) & 63); \
            rr[j] = *(const u32x4*)(UBs + (size_t)e * 128 + ((j & 1) ? goff1 : goff0)); } asm volatile("" ::: "memory"); } while (0)
#define PU_STAGE(xb) do { unsigned hw = 0u, lw = 0u; const unsigned x0_ = xb.x, x1_ = xb.y; PM_X4(hw, lw, x0_, 0); PM_X4(hw, lw, x1_, 1); \
            *(LAS unsigned short*)(x8 + 2 * lane) = (unsigned short)hw; *(LAS unsigned short*)(x8 + 128 + 2 * lane) = (unsigned short)lw; \
            _Pragma("unroll") for (int j = 0; j < 16; ++j) *(LAS u32x4*)(rowsL + j * 1024 + 16 * lane) = rr[j]; asm volatile("" ::: "memory"); } while (0)
#define PU_MMA(t_) do { \
            const u32x4 b0 = *(const LAS u32x4*)(x8 + 128 * (r16 & 1) + 16 * kq), b1 = *(const LAS u32x4*)(x8 + 128 * (r16 & 1) + 64 + 16 * kq); \
            const v8i_t B0 = {(int)b0.x, (int)b0.y, (int)b0.z, (int)b0.w, 0, 0, 0, 0}, B1 = {(int)b1.x, (int)b1.y, (int)b1.z, (int)b1.w, 0, 0, 0, 0}; \
            f32x4 zz[8]; \
            _Pragma("unroll") for (int TT = 0; TT < 8; ++TT) { f32x4 acc = {0.f, 0.f, 0.f, 0.f}; \
                const u32x4 a0 = *(const LAS u32x4*)(rowsL + TT * 2048 + aoff0), a1 = *(const LAS u32x4*)(rowsL + TT * 2048 + aoff1); \
                const v8i_t A0 = {(int)a0.x, (int)a0.y, (int)a0.z, (int)a0.w, 0, 0, 0, 0}, A1 = {(int)a1.x, (int)a1.y, (int)a1.z, (int)a1.w, 0, 0, 0, 0}; \
                acc = __builtin_amdgcn_mfma_scale_f32_16x16x128_f8f6f4(A0, B0, acc, 4, 4, 0, 0x7f7f7f7f, 0, 0x7f7f7f7f); \
                acc = __builtin_amdgcn_mfma_scale_f32_16x16x128_f8f6f4(A1, B1, acc, 4, 4, 0, 0x7f7f7f7f, 0, 0x7f7f7f7f); \
                _Pragma("unroll") for (int r = 0; r < 4; ++r) { const float v = acc[r]; \
                    const float o = __builtin_bit_cast(float, __builtin_amdgcn_update_dpp(0, __builtin_bit_cast(int, v), 0xB1, 0xf, 0xf, false)); zz[TT][r] = v + o * (1.f / PEER_XL); } } \
            asm volatile("" ::: "memory"); \
            if (r16 == 0 && (t_) < T) { float* zo = ZP + ((size_t)(t_) * 4 + s) * 128 + 4 * kq; _Pragma("unroll") for (int TT = 0; TT < 8; ++TT) *(f32x4*)(zo + 16 * TT) = zz[TT]; } } while (0)
        int t = wi;
        PU_IDX(e0A, e1A, xA, t); PU_IDX(e0B, e1B, xC, t + nw); PU_ROWS(e0A, e1A);
        for (; t < T; t += 2 * nw) {
            PU_STAGE(xA); PU_IDX(e0A, e1A, xA, t + 2 * nw); PU_ROWS(e0B, e1B); PU_MMA(t);
            PU_STAGE(xC); PU_IDX(e0B, e1B, xC, t + 3 * nw); PU_ROWS(e0A, e1A); PU_MMA(t + nw);
        }
#undef PU_IDX
#undef PU_ROWS
#undef PU_STAGE
#undef PU_MMA
    }
}
DI void peer_u_owned(const Frame& F) {
    const int lane = F.lane, r16 = lane & 15, kq = lane >> 4, rho = lane >> 3, c8 = lane & 7;
    const unsigned char* UB = WSP(unsigned char, WS_UB); const bf16_t* XB = WSP(bf16_t, WS_XB);
    const int* EIDX = WSP(int, WS_EIDX); float* ZP = WSP(float, WS_ZP);
    LAS unsigned char* rowsL = F.lds + F.wave * 18400;     LAS unsigned char* x8 = rowsL + 16384;
    const int goff0 = 16 * (c8 ^ (rho >> 1)), goff1 = 16 * (c8 ^ (4 + (rho >> 1)));
    const int aoff0 = r16 * 128 + 16 * (kq ^ ((r16 >> 1) & 7)), aoff1 = r16 * 128 + 16 * ((4 + kq) ^ ((r16 >> 1) & 7));
    {
        int e0A, e1A, e0B, e1B; u32x4 rr[16]; u32x2 xA, xC;
#define PU_IDX(e0b, e1b, xb, i_) do { const int ii = min((i_), 31), s = ii >> 3, tt = F.gw + F.NGW * (ii & 7); xb = *(const u32x2*)(XB + (size_t)tt * 1024 + 256 * s + 4 * lane); \
            e0b = EIDX[(size_t)tt * 128 + lane]; e1b = EIDX[(size_t)tt * 128 + 64 + lane]; asm volatile("" ::: "memory"); } while (0)
#define PU_ROWS(e0b, e1b, i_) do { const unsigned char* UBs = UB + (size_t)(min((i_), 31) >> 3) * (16384 * 128); _Pragma("unroll") for (int j = 0; j < 16; ++j) { const int e = __shfl((j < 8) ? e0b : e1b, (8 * j + rho) & 63); \
            rr[j] = *(const u32x4*)(UBs + (size_t)e * 128 + ((j & 1) ? goff1 : goff0)); } asm volatile("" ::: "memory"); } while (0)
#define PU_STAGE(xb) do { unsigned hw = 0u, lw = 0u; const unsigned x0_ = xb.x, x1_ = xb.y; PM_X4(hw, lw, x0_, 0); PM_X4(hw, lw, x1_, 1); \
            *(LAS unsigned short*)(x8 + 2 * lane) = (unsigned short)hw; *(LAS unsigned short*)(x8 + 128 + 2 * lane) = (unsigned short)lw; \
            _Pragma("unroll") for (int j = 0; j < 16; ++j) *(LAS u32x4*)(rowsL + j * 1024 + 16 * lane) = rr[j]; asm volatile("" ::: "memory"); } while (0)
#define PU_MMA(i_) do { const int s = (i_) >> 3, t_ = F.gw + F.NGW * ((i_) & 7); \
            const u32x4 b0 = *(const LAS u32x4*)(x8 + 128 * (r16 & 1) + 16 * kq), b1 = *(const LAS u32x4*)(x8 + 128 * (r16 & 1) + 64 + 16 * kq); \
            const v8i_t B0 = {(int)b0.x, (int)b0.y, (int)b0.z, (int)b0.w, 0, 0, 0, 0}, B1 = {(int)b1.x, (int)b1.y, (int)b1.z, (int)b1.w, 0, 0, 0, 0}; \
            f32x4 zz[8]; \
            _Pragma("unroll") for (int TT = 0; TT < 8; ++TT) { f32x4 acc = {0.f, 0.f, 0.f, 0.f}; \
                const u32x4 a0 = *(const LAS u32x4*)(rowsL + TT * 2048 + aoff0), a1 = *(const LAS u32x4*)(rowsL + TT * 2048 + aoff1); \
                const v8i_t A0 = {(int)a0.x, (int)a0.y, (int)a0.z, (int)a0.w, 0, 0, 0, 0}, A1 = {(int)a1.x, (int)a1.y, (int)a1.z, (int)a1.w, 0, 0, 0, 0}; \
                acc = __builtin_amdgcn_mfma_scale_f32_16x16x128_f8f6f4(A0, B0, acc, 4, 4, 0, 0x7f7f7f7f, 0, 0x7f7f7f7f); \
                acc = __builtin_amdgcn_mfma_scale_f32_16x16x128_f8f6f4(A1, B1, acc, 4, 4, 0, 0x7f7f7f7f, 0, 0x7f7f7f7f); \
                _Pragma("unroll") for (int r = 0; r < 4; ++r) { const float v = acc[r]; \
                    const float o = __builtin_bit_cast(float, __builtin_amdgcn_update_dpp(0, __builtin_bit_cast(int, v), 0xB1, 0xf, 0xf, false)); zz[TT][r] = v + o * (1.f / PEER_XL); } } \
            asm volatile("" ::: "memory"); \
            if (r16 == 0 && (t_) < T) { float* zo = ZP + ((size_t)(t_) * 4 + s) * 128 + 4 * kq; _Pragma("unroll") for (int TT = 0; TT < 8; ++TT) *(f32x4*)(zo + 16 * TT) = zz[TT]; } } while (0)
        PU_IDX(e0A, e1A, xA, 0); PU_IDX(e0B, e1B, xC, 1); PU_ROWS(e0A, e1A, 0);
        for (int i = 0; i < 32; i += 2) {
            PU_STAGE(xA); PU_IDX(e0A, e1A, xA, i + 2); PU_ROWS(e0B, e1B, i + 1); PU_MMA(i);
            PU_STAGE(xC); PU_IDX(e0B, e1B, xC, i + 3); PU_ROWS(e0A, e1A, i + 2); PU_MMA(i + 1);
        }
#undef PU_IDX
#undef PU_ROWS
#undef PU_STAGE
#undef PU_MMA
    }
}
typedef int v2i_t __attribute__((ext_vector_type(2)));
constexpr size_t WS_SLOTS2 = WS_YSLOTS;
DI float row16_max(float v) {
    v = fmaxf(v, __builtin_bit_cast(float, __builtin_amdgcn_update_dpp(0, __builtin_bit_cast(int, v), 0xB1, 0xf, 0xf, false)));
    v = fmaxf(v, __builtin_bit_cast(float, __builtin_amdgcn_update_dpp(0, __builtin_bit_cast(int, v), 0x4E, 0xf, 0xf, false)));
    v = fmaxf(v, __builtin_bit_cast(float, __builtin_amdgcn_update_dpp(0, __builtin_bit_cast(int, v), 0x141, 0xf, 0xf, false)));
    v = fmaxf(v, __builtin_bit_cast(float, __builtin_amdgcn_update_dpp(0, __builtin_bit_cast(int, v), 0x140, 0xf, 0xf, false)));
    return v;
}
template <bool DRY = false>
DI void peer_v_mfma_phase(const Frame& F) {
    const int lane = F.lane, r16 = lane & 15, kq = lane >> 4, rho = lane >> 3, c8 = lane & 7;
    const unsigned char* VB = WSP(unsigned char, WS_VB); bf16_t* XB = WSP(bf16_t, WS_XB);
    const int* EIDX = WSP(int, WS_EIDX); const float* GATE = WSP(float, WS_GATE); const float* ZP = WSP(float, WS_ZP);
    const float* SLOTS = WSP(float, WS_SLOTS); float* SLOTS2 = WSP(float, WS_SLOTS2);
    LAS unsigned char* rowsL = F.lds + F.wave * 17664; LAS unsigned char* actL = rowsL + 16384; LAS float* outL = (LAS float*)(rowsL + 16640);
    const bool sliced = (F.G % 4) == 0;
    const int q = sliced ? F.G / 4 : F.G;
    const int wi = (sliced ? F.vcu % q : F.vcu) * NWAVES + F.wave, nw = q * NWAVES;
    const int s0 = sliced ? F.vcu / q : 0, s1 = sliced ? s0 + 1 : 4;
    const int goff0 = 16 * (c8 ^ (rho >> 1)), goff1 = 16 * (c8 ^ (4 + (rho >> 1)));
    int tra[8];
#pragma unroll
    for (int c = 0; c < 8; ++c) tra[c] = (32 * kq + r16) * 128 + 16 * (c ^ ((r16 >> 1) & 7));
    unsigned amask[4];
#pragma unroll
    for (int g = 0; g < 4; ++g) amask[g] = ((r16 >> 2) == g && (r16 & 3) < 3) ? 0xffffffffu : 0u;
    const int aoff = (((r16 & 3) < 3) ? (r16 & 3) : 0) * 64 + 16 * kq;
    for (int s = s0; s < s1; ++s) {
        const unsigned char* VBs = VB + (size_t)s * (16384 * 128);
        int e0A, e1A, e0B, e1B; float g0A, g1A, g0B, g1B, slA, slB; float zA[8], zB[8]; u32x2 rrA, rrB; u32x4 rr[16];
#define PV_IDX(e0b, e1b, g0b, g1b, zb, slb, rrb, t_) do { const int tt = min((t_), T - 1); \
            e0b = EIDX[(size_t)tt * 128 + lane]; e1b = EIDX[(size_t)tt * 128 + 64 + lane]; g0b = GATE[(size_t)tt * 128 + lane]; g1b = GATE[(size_t)tt * 128 + 64 + lane]; \
            _Pragma("unroll") for (int sp = 0; sp < 4; ++sp) { zb[sp] = ZP[((size_t)tt * 4 + sp) * 128 + lane]; zb[4 + sp] = ZP[((size_t)tt * 4 + sp) * 128 + 64 + lane]; } \
            slb = SLOTS[(size_t)tt * 16 + r16]; rrb = *(const u32x2*)(XB + (size_t)tt * 1024 + 256 * s + 4 * lane); asm volatile("" ::: "memory"); } while (0)
#define PV_ROWS(e0b, e1b) do { _Pragma("unroll") for (int j = 0; j < 16; ++j) { const int e = __shfl((j < 8) ? e0b : e1b, (8 * j + rho) & 63); \
            rr[j] = *(const u32x4*)(VBs + (size_t)e * 128 + ((j & 1) ? goff1 : goff0)); } asm volatile("" ::: "memory"); } while (0)
#define PV_PACK3(pa_, pb_, idx_) do { unsigned hb = __builtin_amdgcn_cvt_scalef32_pk_fp4_f32(0u, pa_, pb_, 1.0f, 0); const f32x2 hv = fp4p<0>(hb); const float ra = (pa_ - hv.x) * 8.f, rb = (pb_ - hv.y) * 8.f; \
            unsigned mb = __builtin_amdgcn_cvt_scalef32_pk_fp4_f32(0u, ra, rb, 1.0f, 0); const f32x2 mv = fp4p<0>(mb); const float ra2 = (ra - mv.x) * 8.f, rb2 = (rb - mv.y) * 8.f; \
            unsigned lb = __builtin_amdgcn_cvt_scalef32_pk_fp4_f32(0u, ra2, rb2, 1.0f, 0); \
            if (!(lane & 1)) { actL[(idx_)] = (unsigned char)hb; actL[64 + (idx_)] = (unsigned char)mb; actL[128 + (idx_)] = (unsigned char)lb; } } while (0)
#define PV_ACT(g0b, g1b, zb, slb, rrb) do { const float zs = rsqrtf(row16_sum(slb) * (1.f / 1024.f) + EPS) * (1.f / PEER_SU); \
            const float a0 = gelu_tanh(((zb[0] + zb[1]) + (zb[2] + zb[3])) * zs) * g0b * (1.f / PEER_SV), a1 = gelu_tanh(((zb[4] + zb[5]) + (zb[6] + zb[7])) * zs) * g1b * (1.f / PEER_SV); \
            float am = row16_max(fmaxf(fabsf(a0), fabsf(a1))); { const int ai = __builtin_bit_cast(int, am); am = fmaxf(fmaxf(__builtin_bit_cast(float, __builtin_amdgcn_readlane(ai, 0)), __builtin_bit_cast(float, __builtin_amdgcn_readlane(ai, 16))), fmaxf(__builtin_bit_cast(float, __builtin_amdgcn_readlane(ai, 32)), __builtin_bit_cast(float, __builtin_amdgcn_readlane(ai, 48)))); } \
            const float S = (am > 0.f) ? 4.f * frcp(am) : 1.f; invS = (am > 0.f) ? am * 0.25f : 1.f; \
            const float t0 = a0 * S, t1 = a1 * S; \
            const float n0 = __builtin_bit_cast(float, __builtin_amdgcn_update_dpp(0, __builtin_bit_cast(int, t0), 0xB1, 0xf, 0xf, false)), n1 = __builtin_bit_cast(float, __builtin_amdgcn_update_dpp(0, __builtin_bit_cast(int, t1), 0xB1, 0xf, 0xf, false)); \
            const bool odd = lane & 1; const float pa0 = odd ? n0 : t0, pb0 = odd ? t0 : n0, pa1 = odd ? n1 : t1, pb1 = odd ? t1 : n1; \
            PV_PACK3(pa0, pb0, lane >> 1); PV_PACK3(pa1, pb1, 32 + (lane >> 1)); rcur = rrb; asm volatile("" ::: "memory"); } while (0)
#define PV_STAGE() do { _Pragma("unroll") for (int j = 0; j < 16; ++j) *(LAS u32x4*)(rowsL + j * 1024 + 16 * lane) = rr[j]; asm volatile("" ::: "memory"); } while (0)
#define PV_MMA(t_) do { const u32x4 av = *(const LAS u32x4*)(actL + aoff); v8i_t Aop[4]; \
            _Pragma("unroll") for (int g = 0; g < 4; ++g) Aop[g] = (v8i_t){(int)(av.x & amask[g]), (int)(av.y & amask[g]), (int)(av.z & amask[g]), (int)(av.w & amask[g]), 0, 0, 0, 0}; \
            v2i_t bl[16], bh[16]; \
            _Pragma("unroll") for (int cb = 0; cb < 16; ++cb) { bl[cb] = __builtin_amdgcn_ds_read_tr4_b64_v2i32((LAS v2i_t*)(rowsL + tra[cb >> 1] + 8 * (cb & 1))); bh[cb] = __builtin_amdgcn_ds_read_tr4_b64_v2i32((LAS v2i_t*)(rowsL + tra[cb >> 1] + 8 * (cb & 1) + 2048)); } \
            f32x4 acc[4]; \
            _Pragma("unroll") for (int c = 0; c < 4; ++c) acc[c] = (f32x4){0.f, 0.f, 0.f, 0.f}; \
            _Pragma("unroll") for (int g = 0; g < 4; ++g) _Pragma("unroll") for (int c = 0; c < 4; ++c) { const v8i_t Bop = {bl[4 * c + g].x, bl[4 * c + g].y, bh[4 * c + g].x, bh[4 * c + g].y, 0, 0, 0, 0}; \
                acc[c] = __builtin_amdgcn_mfma_scale_f32_16x16x128_f8f6f4(Aop[g], Bop, acc[c], 4, 4, 0, 0x7f7f7f7f, 0, 0x7f7f7f7f); } \
            _Pragma("unroll") for (int c = 0; c < 4; ++c) { const float c0 = acc[c][0], c1 = acc[c][1], c2 = acc[c][2]; outL[64 * c + lane] = (c0 + c1 * 0.125f + c2 * 0.015625f) * invS; } \
            asm volatile("" ::: "memory"); \
            const f32x4 ov4 = *(const LAS f32x4*)(outL + 4 * lane); const unsigned rw0 = rcur.x, rw1 = rcur.y; \
            const float o0 = ov4[0] + bflo(rw0), o1 = ov4[1] + bfhi(rw0), o2_ = ov4[2] + bflo(rw1), o3 = ov4[3] + bfhi(rw1); \
            const int ssi = __builtin_bit_cast(int, row16_sum((o0 * o0 + o1 * o1) + (o2_ * o2_ + o3 * o3))); \
            const float ss = (__builtin_bit_cast(float, __builtin_amdgcn_readlane(ssi, 0)) + __builtin_bit_cast(float, __builtin_amdgcn_readlane(ssi, 16))) + (__builtin_bit_cast(float, __builtin_amdgcn_readlane(ssi, 32)) + __builtin_bit_cast(float, __builtin_amdgcn_readlane(ssi, 48))); \
            if ((t_) < T && !(DRY && ss != -1.f)) { if (lane == 0) *(f32x4*)(SLOTS2 + (size_t)(t_) * 16 + 4 * s) = (f32x4){ss, 0.f, 0.f, 0.f}; \
                u32x2 w; w.x = pk2(o0, o1); w.y = pk2(o2_, o3); *(u32x2*)(XB + (size_t)(t_) * 1024 + 256 * s + 4 * lane) = w; } } while (0)
        float invS = 1.f; u32x2 rcur = {0u, 0u};
        int t = wi;
        PV_IDX(e0A, e1A, g0A, g1A, zA, slA, rrA, t); PV_IDX(e0B, e1B, g0B, g1B, zB, slB, rrB, t + nw); PV_ROWS(e0A, e1A);
        for (; t < T; t += 2 * nw) {
            PV_ACT(g0A, g1A, zA, slA, rrA); PV_STAGE(); PV_IDX(e0A, e1A, g0A, g1A, zA, slA, rrA, t + 2 * nw); PV_ROWS(e0B, e1B); PV_MMA(t);
            PV_ACT(g0B, g1B, zB, slB, rrB); PV_STAGE(); PV_IDX(e0B, e1B, g0B, g1B, zB, slB, rrB, t + 3 * nw); PV_ROWS(e0A, e1A); PV_MMA(t + nw);
        }
#undef PV_IDX
#undef PV_ROWS
#undef PV_PACK3
#undef PV_ACT
#undef PV_STAGE
#undef PV_MMA
    }
}
template <bool FINAL>
DI void peer_v_mfma_final(const Frame& F) {
    const int lane = F.lane, r16 = lane & 15, kq = lane >> 4, rho = lane >> 3, c8 = lane & 7;
    const unsigned char* VB = WSP(unsigned char, WS_VB); bf16_t* XB = WSP(bf16_t, WS_XB);
    const int* EIDX = WSP(int, WS_EIDX); const float* GATE = WSP(float, WS_GATE); const float* ZP = WSP(float, WS_ZP);
    const float* SLOTS = WSP(float, WS_SLOTS);
    LAS unsigned char* rowsL = F.lds + F.wave * 18400; LAS unsigned char* tactL = rowsL + 16640; LAS float* outL = (LAS float*)rowsL;
    const int goff0 = 16 * (c8 ^ (rho >> 1)), goff1 = 16 * (c8 ^ (4 + (rho >> 1)));
    int tra[8];
#pragma unroll
    for (int c = 0; c < 8; ++c) tra[c] = (32 * kq + r16) * 128 + 16 * (c ^ ((r16 >> 1) & 7));
    unsigned amask[4];
#pragma unroll
    for (int g = 0; g < 4; ++g) amask[g] = ((r16 >> 2) == g && (r16 & 3) < 3) ? 0xffffffffu : 0u;
    const int aoff = (((r16 & 3) < 3) ? (r16 & 3) : 0) * 64 + 16 * kq;
    {
        int e0A, e1A, e0B, e1B; u32x2 rrA, rrB; u32x4 rr[16];
#define PV_IDX(e0b, e1b, rrb, i_) do { const int ii = min((i_), 31), s = ii >> 3, tt = F.gw + F.NGW * (ii & 7); \
            e0b = EIDX[(size_t)tt * 128 + lane]; e1b = EIDX[(size_t)tt * 128 + 64 + lane]; rrb = *(const u32x2*)(XB + (size_t)tt * 1024 + 256 * s + 4 * lane); asm volatile("" ::: "memory"); } while (0)
#define PV_ROWS(e0b, e1b, i_) do { const unsigned char* VBs = VB + (size_t)(min((i_), 31) >> 3) * (16384 * 128); _Pragma("unroll") for (int j = 0; j < 16; ++j) { const int e = __shfl((j < 8) ? e0b : e1b, (8 * j + rho) & 63); \
            rr[j] = *(const u32x4*)(VBs + (size_t)e * 128 + ((j & 1) ? goff1 : goff0)); } asm volatile("" ::: "memory"); } while (0)
#define PV_PACK3(pa_, pb_, idx_) do { unsigned hb = __builtin_amdgcn_cvt_scalef32_pk_fp4_f32(0u, pa_, pb_, 1.0f, 0); const f32x2 hv = fp4p<0>(hb); const float ra = (pa_ - hv.x) * 8.f, rb = (pb_ - hv.y) * 8.f; \
            unsigned mb = __builtin_amdgcn_cvt_scalef32_pk_fp4_f32(0u, ra, rb, 1.0f, 0); const f32x2 mv = fp4p<0>(mb); const float ra2 = (ra - mv.x) * 8.f, rb2 = (rb - mv.y) * 8.f; \
            unsigned lb = __builtin_amdgcn_cvt_scalef32_pk_fp4_f32(0u, ra2, rb2, 1.0f, 0); \
            if (!(lane & 1)) { tj[(idx_)] = (unsigned char)hb; tj[64 + (idx_)] = (unsigned char)mb; tj[128 + (idx_)] = (unsigned char)lb; } } while (0)
#define PV_STAGE() do { _Pragma("unroll") for (int j = 0; j < 16; ++j) *(LAS u32x4*)(rowsL + j * 1024 + 16 * lane) = rr[j]; asm volatile("" ::: "memory"); } while (0)
#define PV_MMA(i_, rrb) do { const int s = (i_) >> 3, jt = (i_) & 7, t_ = F.gw + F.NGW * jt; const u32x4 av = *(const LAS u32x4*)(tactL + jt * 192 + aoff); const u32x2 rcur = rrb; v8i_t Aop[4]; \
            const float invS = __builtin_bit_cast(float, __builtin_amdgcn_readlane(__builtin_bit_cast(int, invSv), jt)); \
            _Pragma("unroll") for (int g = 0; g < 4; ++g) Aop[g] = (v8i_t){(int)(av.x & amask[g]), (int)(av.y & amask[g]), (int)(av.z & amask[g]), (int)(av.w & amask[g]), 0, 0, 0, 0}; \
            v2i_t bl[16], bh[16]; \
            _Pragma("unroll") for (int cb = 0; cb < 16; ++cb) { bl[cb] = __builtin_amdgcn_ds_read_tr4_b64_v2i32((LAS v2i_t*)(rowsL + tra[cb >> 1] + 8 * (cb & 1))); bh[cb] = __builtin_amdgcn_ds_read_tr4_b64_v2i32((LAS v2i_t*)(rowsL + tra[cb >> 1] + 8 * (cb & 1) + 2048)); } \
            f32x4 acc[4]; \
            _Pragma("unroll") for (int c = 0; c < 4; ++c) acc[c] = (f32x4){0.f, 0.f, 0.f, 0.f}; \
            _Pragma("unroll") for (int g = 0; g < 4; ++g) _Pragma("unroll") for (int c = 0; c < 4; ++c) { const v8i_t Bop = {bl[4 * c + g].x, bl[4 * c + g].y, bh[4 * c + g].x, bh[4 * c + g].y, 0, 0, 0, 0}; \
                acc[c] = __builtin_amdgcn_mfma_scale_f32_16x16x128_f8f6f4(Aop[g], Bop, acc[c], 4, 4, 0, 0x7f7f7f7f, 0, 0x7f7f7f7f); } \
            _Pragma("unroll") for (int c = 0; c < 4; ++c) { const float c0 = acc[c][0], c1 = acc[c][1], c2 = acc[c][2]; outL[64 * c + lane] = (c0 + c1 * 0.125f + c2 * 0.015625f) * invS; } \
            asm volatile("" ::: "memory"); \
            const f32x4 ov4 = *(const LAS f32x4*)(outL + 4 * lane); const unsigned rw0 = rcur.x, rw1 = rcur.y; \
            const float o0 = ov4[0] + bflo(rw0), o1 = ov4[1] + bfhi(rw0), o2_ = ov4[2] + bflo(rw1), o3 = ov4[3] + bfhi(rw1); \
            const int ssi = __builtin_bit_cast(int, row16_sum((o0 * o0 + o1 * o1) + (o2_ * o2_ + o3 * o3))); \
            const float ss = (__builtin_bit_cast(float, __builtin_amdgcn_readlane(ssi, 0)) + __builtin_bit_cast(float, __builtin_amdgcn_readlane(ssi, 16))) + (__builtin_bit_cast(float, __builtin_amdgcn_readlane(ssi, 32)) + __builtin_bit_cast(float, __builtin_amdgcn_readlane(ssi, 48))); \
            ssqv = (lane == jt) ? ssqv + ss : ssqv; \
            { u32x2 w; w.x = pk2(o0, o1); w.y = pk2(o2_, o3); *(u32x2*)(XB + (size_t)t_ * 1024 + 256 * s + 4 * lane) = w; } } while (0)
        float invSv = 1.f;
        { float zt[8][8], gt[8][2], st[8];
#pragma unroll
          for (int j = 0; j < 8; ++j) { const int tt = F.gw + F.NGW * j;
#pragma unroll
              for (int sp = 0; sp < 4; ++sp) { zt[j][sp] = ZP[((size_t)tt * 4 + sp) * 128 + lane]; zt[j][4 + sp] = ZP[((size_t)tt * 4 + sp) * 128 + 64 + lane]; }
              gt[j][0] = GATE[(size_t)tt * 128 + lane]; gt[j][1] = GATE[(size_t)tt * 128 + 64 + lane]; st[j] = SLOTS[(size_t)tt * 16 + r16]; }
          asm volatile("" ::: "memory");
#pragma unroll
          for (int j = 0; j < 8; ++j) { LAS unsigned char* tj = tactL + j * 192;
              const float zs = rsqrtf(row16_sum(st[j]) * (1.f / 1024.f) + EPS) * (1.f / PEER_SU);
              const float a0 = gelu_tanh(((zt[j][0] + zt[j][1]) + (zt[j][2] + zt[j][3])) * zs) * gt[j][0] * (1.f / PEER_SV), a1 = gelu_tanh(((zt[j][4] + zt[j][5]) + (zt[j][6] + zt[j][7])) * zs) * gt[j][1] * (1.f / PEER_SV);
              float am = row16_max(fmaxf(fabsf(a0), fabsf(a1))); { const int ai = __builtin_bit_cast(int, am); am = fmaxf(fmaxf(__builtin_bit_cast(float, __builtin_amdgcn_readlane(ai, 0)), __builtin_bit_cast(float, __builtin_amdgcn_readlane(ai, 16))), fmaxf(__builtin_bit_cast(float, __builtin_amdgcn_readlane(ai, 32)), __builtin_bit_cast(float, __builtin_amdgcn_readlane(ai, 48)))); }
              const float S = (am > 0.f) ? 4.f * frcp(am) : 1.f; invSv = (lane == j) ? ((am > 0.f) ? am * 0.25f : 1.f) : invSv;
              const float t0 = a0 * S, t1 = a1 * S;
              const float n0 = __builtin_bit_cast(float, __builtin_amdgcn_update_dpp(0, __builtin_bit_cast(int, t0), 0xB1, 0xf, 0xf, false)), n1 = __builtin_bit_cast(float, __builtin_amdgcn_update_dpp(0, __builtin_bit_cast(int, t1), 0xB1, 0xf, 0xf, false));
              const bool odd = lane & 1; const float pa0 = odd ? n0 : t0, pb0 = odd ? t0 : n0, pa1 = odd ? n1 : t1, pb1 = odd ? t1 : n1;
              PV_PACK3(pa0, pb0, lane >> 1); PV_PACK3(pa1, pb1, 32 + (lane >> 1)); }
          asm volatile("" ::: "memory"); }
        float ssqv = 0.f;
        PV_IDX(e0A, e1A, rrA, 0); PV_IDX(e0B, e1B, rrB, 1); PV_ROWS(e0A, e1A, 0);
        for (int i = 0; i < 32; i += 2) {
            { const u32x2 rc = rrA; PV_STAGE(); PV_IDX(e0A, e1A, rrA, i + 2); PV_ROWS(e0B, e1B, i + 1); PV_MMA(i, rc); }
            { const u32x2 rc = rrB; PV_STAGE(); PV_IDX(e0B, e1B, rrB, i + 3); PV_ROWS(e0A, e1A, i + 2); PV_MMA(i + 1, rc); }
        }
        if (!FINAL) { if (lane < 8) WSP(float, WS_RSTD)[F.gw + F.NGW * lane] = rsqrtf(ssqv * (1.f / 1024.f) + EPS); }
        else {
        asm volatile("s_waitcnt vmcnt(0)\n\tbuffer_inv sc0\n\ts_waitcnt vmcnt(0)" ::: "memory");
        const float* fg = F.in[3] + 16 * lane;
        for (int jt = 0; jt < 8; ++jt) { const int t = F.gw + F.NGW * jt;
            const float rs2 = rsqrtf(__builtin_bit_cast(float, __builtin_amdgcn_readlane(__builtin_bit_cast(int, ssqv), jt)) * (1.f / 1024.f) + EPS);
            const u32x4 r0 = *(const u32x4*)(XB + (size_t)t * 1024 + 16 * lane), r1 = *(const u32x4*)(XB + (size_t)t * 1024 + 16 * lane + 8);
            const unsigned rw[8] = {r0.x, r0.y, r0.z, r0.w, r1.x, r1.y, r1.z, r1.w}; float* xo = F.out + (size_t)t * 1024 + 16 * lane;
#pragma unroll
            for (int qq = 0; qq < 4; ++qq) { const f32x4 gq = *(const f32x4*)(fg + 4 * qq); f32x4 w;
                w[0] = bflo(rw[2 * qq]) * rs2 * gq[0]; w[1] = bfhi(rw[2 * qq]) * rs2 * gq[1]; w[2] = bflo(rw[2 * qq + 1]) * rs2 * gq[2]; w[3] = bfhi(rw[2 * qq + 1]) * rs2 * gq[3];
                *(f32x4*)(xo + 4 * qq) = w; } } }
#undef PV_IDX
#undef PV_ROWS
#undef PV_PACK3
#undef PV_STAGE
#undef PV_MMA
    }
}
template <bool FINAL, bool DRY = false>
DI void peer_v_token(const Frame& F, int t) {
    const int lane = F.lane;
    const unsigned char* VB = WSP(unsigned char, WS_VB); bf16_t* XB = WSP(bf16_t, WS_XB);
    const int* EIDX = WSP(int, WS_EIDX); const float* GATE = WSP(float, WS_GATE); const float* zp = WSP(float, WS_ZP) + (size_t)t * 512;
    float sl = (lane < 16) ? WSP(float, WS_SLOTS)[(size_t)t * 16 + lane] : 0.f;
    const int e0 = EIDX[(size_t)t * 128 + lane] & (DRY ? 2047 : 0x7fffffff), e1 = EIDX[(size_t)t * 128 + 64 + lane] & (DRY ? 2047 : 0x7fffffff);
    float zlo = (zp[lane] + zp[128 + lane]) + (zp[256 + lane] + zp[384 + lane]), zhi = (zp[64 + lane] + zp[192 + lane]) + (zp[320 + lane] + zp[448 + lane]);
    const float glo = GATE[(size_t)t * 128 + lane], ghi = GATE[(size_t)t * 128 + 64 + lane];
    u32x2 vA[16], vB[16];
#define PV_VLOAD(buf, bt_) do { _Pragma("unroll") for (int kk = 0; kk < 16; ++kk) { const int k = 16 * (bt_) + kk; const int e = __builtin_amdgcn_readlane((k < 64) ? e0 : e1, k & 63); \
        buf[kk] = *(const u32x2*)(VB + (size_t)e * 512 + 8 * lane); } asm volatile("" ::: "memory"); } while (0)
#define PV_VCOMP(buf, bt_) do { _Pragma("unroll") for (int kk = 0; kk < 16; ++kk) { const int k = 16 * (bt_) + kk; \
        const float a = __builtin_bit_cast(float, __builtin_amdgcn_readlane(__builtin_bit_cast(int, (k < 64) ? actlo : acthi), k & 63)); const u32x2 v = buf[kk]; \
        o2[0] += fp4p<0>(v.x) * a; o2[1] += fp4p<1>(v.x) * a; o2[2] += fp4p<2>(v.x) * a; o2[3] += fp4p<3>(v.x) * a; \
        o2[4] += fp4p<0>(v.y) * a; o2[5] += fp4p<1>(v.y) * a; o2[6] += fp4p<2>(v.y) * a; o2[7] += fp4p<3>(v.y) * a; } } while (0)
    PV_VLOAD(vA, 0);
    const float rstd = rsqrtf(wave_sum(sl) * (1.f / 1024.f) + EPS);
    const float zs = rstd * (1.f / PEER_SU);
    const float actlo = gelu_tanh(zlo * zs) * glo * (1.f / PEER_SV), acthi = gelu_tanh(zhi * zs) * ghi * (1.f / PEER_SV);
    f32x2 o2[8];
#pragma unroll
    for (int i = 0; i < 8; ++i) o2[i] = (f32x2){0.f, 0.f};
    PV_VLOAD(vB, 1); PV_VCOMP(vA, 0);
    PV_VLOAD(vA, 2); PV_VCOMP(vB, 1);
    PV_VLOAD(vB, 3); PV_VCOMP(vA, 2);
    PV_VLOAD(vA, 4); PV_VCOMP(vB, 3);
    PV_VLOAD(vB, 5); PV_VCOMP(vA, 4);
    PV_VLOAD(vA, 6); PV_VCOMP(vB, 5);
    PV_VLOAD(vB, 7); PV_VCOMP(vA, 6);
    PV_VCOMP(vB, 7);
#undef PV_VLOAD
#undef PV_VCOMP
    float* xo = F.out + (size_t)t * 1024 + 16 * lane;
    float o[16]; float ss = 0.f;
    { const u32x4 r0 = *(const u32x4*)(XB + (size_t)t * 1024 + 16 * lane), r1 = *(const u32x4*)(XB + (size_t)t * 1024 + 16 * lane + 8);
      const unsigned rw[8] = {r0.x, r0.y, r0.z, r0.w, r1.x, r1.y, r1.z, r1.w};
#pragma unroll
      for (int m = 0; m < 8; ++m) { o[2 * m] = o2[m].x + bflo(rw[m]); o[2 * m + 1] = o2[m].y + bfhi(rw[m]); ss += o[2 * m] * o[2 * m] + o[2 * m + 1] * o[2 * m + 1]; } }
    const float rs2 = rsqrtf(wave_sum(ss) * (1.f / 1024.f) + EPS);
    if (DRY && rs2 != -1.f) return;
    if (FINAL) {
        const float* fg = F.in[3] + 16 * lane;
#pragma unroll
        for (int q = 0; q < 4; ++q) { const f32x4 gq = *(const f32x4*)(fg + 4 * q); f32x4 w;
#pragma unroll
            for (int j = 0; j < 4; ++j) w[j] = o[4 * q + j] * rs2 * gq[j];
            *(f32x4*)(xo + 4 * q) = w; }
    } else {
        if (lane == 0) WSP(float, WS_RSTD)[t] = rs2;
#pragma unroll
        for (int hf = 0; hf < 2; ++hf) { u32x4 w; w.x = pk2(o[8 * hf + 0], o[8 * hf + 1]); w.y = pk2(o[8 * hf + 2], o[8 * hf + 3]); w.z = pk2(o[8 * hf + 4], o[8 * hf + 5]); w.w = pk2(o[8 * hf + 6], o[8 * hf + 7]);
            *(u32x4*)(XB + (size_t)t * 1024 + 16 * lane + 8 * hf) = w; }
    }
}
DI void conv_dt_unit(const Frame& F, int unit) {
    const int tok0 = unit * 64, tid = F.tid;
    const bf16_t* proj = WSP(bf16_t, WS_PROJ); bf16_t* xbc = WSP(bf16_t, WS_XBC);
    const float* cw = F.in[14]; const float* cb = F.in[15];
    u32x4 rv[11]; f32x4 wv[10];
#define CV_LOAD(it_) do { const int seg_ = (it_) / 128, cg_ = 256 + (it_) % 128, c0_ = cg_ * 8, ts_ = tok0 + seg_ * 8; \
        _Pragma("unroll") for (int k = 0; k < 4; ++k) { wv[2 * k] = *(const f32x4*)(cw + k * 3072 + c0_); wv[2 * k + 1] = *(const f32x4*)(cw + k * 3072 + c0_ + 4); } \
        wv[8] = *(const f32x4*)(cb + c0_); wv[9] = *(const f32x4*)(cb + c0_ + 4); \
        _Pragma("unroll") for (int i = 0; i < 11; ++i) { const int tt_ = ts_ - 3 + i; const bool ok_ = ((ts_ & (SEQ - 1)) + i - 3) >= 0; \
            rv[i] = (u32x4){0u, 0u, 0u, 0u}; if (ok_) rv[i] = *(const u32x4*)(proj + (size_t)tt_ * SSM_N + 2048 + c0_); } } while (0)
    CV_LOAD(tid);
#pragma unroll 1
    for (int k6 = 0; k6 < (8 * 128) / NTHR; ++k6) {
        const int it = tid + k6 * NTHR;
        const int seg = it / 128, cg = 256 + it % 128, c0 = cg * 8, ts = tok0 + seg * 8;
        float w[4][8], bsv[8];
#pragma unroll
        for (int k = 0; k < 4; ++k)
#pragma unroll
            for (int j = 0; j < 4; ++j) { w[k][j] = wv[2 * k][j]; w[k][4 + j] = wv[2 * k + 1][j]; }
#pragma unroll
        for (int j = 0; j < 4; ++j) { bsv[j] = wv[8][j]; bsv[4 + j] = wv[9][j]; }
        float xr[11][8];
#pragma unroll
        for (int i = 0; i < 11; ++i) { const u32x4 v = rv[i];
            xr[i][0] = bflo(v.x); xr[i][1] = bfhi(v.x); xr[i][2] = bflo(v.y); xr[i][3] = bfhi(v.y); xr[i][4] = bflo(v.z); xr[i][5] = bfhi(v.z); xr[i][6] = bflo(v.w); xr[i][7] = bfhi(v.w); }
        if (k6 + 1 < (8 * 128) / NTHR) CV_LOAD(it + NTHR);
#pragma unroll
        for (int t = 0; t < 8; ++t) { float y[8];
#pragma unroll
            for (int j = 0; j < 8; ++j) { const float v = bsv[j] + w[0][j] * xr[t][j] + w[1][j] * xr[t + 1][j] + w[2][j] * xr[t + 2][j] + w[3][j] * xr[t + 3][j]; y[j] = siluf_(v); }
            u32x4 o; o.x = pk2(y[0], y[1]); o.y = pk2(y[2], y[3]); o.z = pk2(y[4], y[5]); o.w = pk2(y[6], y[7]);
            *(u32x4*)(xbc + (size_t)(ts + t) * 3072 + c0) = o; }
    }
#undef CV_LOAD
}
DI void dt_unit(const Frame& F, int wu) {
    {
        const int lane = F.lane, fr = lane & 15, fq = lane >> 4, tw = 16 * wu;
        const bf16_t* XB = WSP(bf16_t, WS_XB); const bf16_t* WDT = WSP(bf16_t, WS_WDT);
        f32x4 acc[2] = {(f32x4){0.f, 0.f, 0.f, 0.f}, (f32x4){0.f, 0.f, 0.f, 0.f}};
        bf16x8 a[2][8], b0[2][8], b1[2][8];
#define DT_LOAD(kb_) do { _Pragma("unroll") for (int k2 = 0; k2 < 8; ++k2) { const int ks = 8 * (kb_) + k2; \
                a[(kb_) & 1][k2] = *(const bf16x8*)(XB + (size_t)(tw + fr) * 1024 + 32 * ks + 8 * fq); \
                b0[(kb_) & 1][k2] = *(const bf16x8*)(WDT + (size_t)fr * 1024 + 32 * ks + 8 * fq); b1[(kb_) & 1][k2] = *(const bf16x8*)(WDT + (size_t)(16 + fr) * 1024 + 32 * ks + 8 * fq); } \
            asm volatile("" ::: "memory"); } while (0)
        DT_LOAD(0);
#pragma unroll
        for (int kb = 0; kb < 4; ++kb) {
            if (kb + 1 < 4) DT_LOAD(kb + 1);
#pragma unroll
            for (int k2 = 0; k2 < 8; ++k2) { acc[0] = MFMA16(a[kb & 1][k2], b0[kb & 1][k2], acc[0]); acc[1] = MFMA16(a[kb & 1][k2], b1[kb & 1][k2], acc[1]); }
            asm volatile("" ::: "memory");
        }
#undef DT_LOAD
        const float* rstd = WSP(float, WS_RSTD); float* DT = WSP(float, WS_DT);
#pragma unroll
        for (int nf = 0; nf < 2; ++nf)
#pragma unroll
            for (int r = 0; r < 4; ++r) { const int tt = tw + 4 * fq + r, hh = 16 * nf + fr; float rsv;
                if (PEER_SPLIT && PEER_VSLICE && !PEER_OWNED) { const f32x4* sp = (const f32x4*)(WSP(float, WS_SLOTS2) + (size_t)tt * 16); rsv = rsqrtf(((sp[0][0] + sp[1][0]) + (sp[2][0] + sp[3][0])) * (1.f / 1024.f) + EPS); } else rsv = rstd[tt];
                DT[(size_t)tt * 32 + hh] = softplusf_(acc[nf][r] * rsv + F.in[16][hh]); }
    }
}

DI void ssd_dt_acum(const Frame& F, int tok0, int g, LAS float* dtl, LAS float* acl) {
    const int hh = F.wave, lane = F.lane, head = 8 * g + hh;
    const float* DT = WSP(float, WS_DT);
    const float an = -expf(F.in[17][head]);
    const float d0 = DT[(size_t)(tok0 + 2 * lane) * 32 + head], d1 = DT[(size_t)(tok0 + 2 * lane + 1) * 32 + head];
    const float a0 = d0 * an, a1 = d1 * an;
    float s = a0 + a1;
#pragma unroll
    for (int o = 1; o < 64; o <<= 1) { const float v = __shfl_up(s, o); if (lane >= o) s += v; }
    dtl[(2 * lane) * 8 + hh] = d0; dtl[(2 * lane + 1) * 8 + hh] = d1;
    acl[(2 * lane) * 8 + hh] = s - a1; acl[(2 * lane + 1) * 8 + hh] = s;
}

DI void ssd_state_unit(const Frame& F, int unit) {
    const int g = unit & 3, bn = unit >> 2, tok0 = bn * CH, tid = F.tid, lane = F.lane, w = F.wave, fr = lane & 15, fq = lane >> 4;
    const bf16_t* xbc = WSP(bf16_t, WS_XBC);
    LAS short* Bimg = (LAS short*)F.lds;
    LAS short* Ximg = Bimg + 128 * 136;
    LAS float* dtl = (LAS float*)(F.lds + (128 * 136 + 128 * LDQ) * 2);
    LAS float* acl = dtl + 1024;
    LAS float* wsc = acl + 1024;
    ssd_dt_acum(F, tok0, g, dtl, acl);
#pragma unroll
    for (int i = 0; i < 4; ++i) { const int c = tid + 512 * i, row = c >> 4, ch8 = c & 15;
        *(LAS u32x4*)(Bimg + row * 136 + ch8 * 8) = *(const u32x4*)(xbc + (size_t)(tok0 + row) * 3072 + 2048 + g * 128 + ch8 * 8); }
    __syncthreads();
    for (int i = tid; i < 1024; i += NTHR) { const int s = i >> 3, hh = i & 7; wsc[i] = expf(acl[127 * 8 + hh] - acl[i]) * dtl[i]; (void)s; }
    if (tid < 8) WSP(float, WS_CDEC)[bn * 32 + 8 * g + tid] = expf(acl[127 * 8 + tid]);
    __syncthreads();
    for (int half = 0; half < 2; ++half) {
#pragma unroll
        for (int i = 0; i < 8; ++i) { const int c = tid + 512 * i, row = c >> 5, ch8 = c & 31, hl = ch8 >> 3;
            u32x4 v = *(const u32x4*)(xbc + (size_t)(tok0 + row) * 3072 + g * 512 + half * 256 + ch8 * 8);
            const float s = wsc[row * 8 + 4 * half + hl];
            v.x = pk2(bflo(v.x) * s, bfhi(v.x) * s); v.y = pk2(bflo(v.y) * s, bfhi(v.y) * s); v.z = pk2(bflo(v.z) * s, bfhi(v.z) * s); v.w = pk2(bflo(v.w) * s, bfhi(v.w) * s);
            *(LAS u32x4*)(Ximg + row * LDQ + ch8 * 8) = v; }
        __syncthreads();
        const int hl = w >> 1, kn = w & 1;
        f32x4 acc[4][4];
#pragma unroll
        for (int m = 0; m < 4; ++m)
#pragma unroll
            for (int nn = 0; nn < 4; ++nn) acc[m][nn] = (f32x4){0.f, 0.f, 0.f, 0.f};
#pragma unroll
        for (int ks = 0; ks < 4; ++ks) { bf16x8 bb[4];
#pragma unroll
            for (int nn = 0; nn < 4; ++nn) bb[nn] = frag_tr(Bimg, 136, 64 * kn + 16 * nn, 32 * ks, lane);
#pragma unroll
            for (int m = 0; m < 4; ++m) { const bf16x8 a = frag_tr(Ximg, LDQ, hl * 64 + 16 * m, 32 * ks, lane);
#pragma unroll
                for (int nn = 0; nn < 4; ++nn) acc[m][nn] = MFMA16(a, bb[nn], acc[m][nn]); } }
        float* st = WSP(float, WS_STATES) + ((size_t)bn * 32 + 8 * g + 4 * half + hl) * 8192;
#pragma unroll
        for (int m = 0; m < 4; ++m)
#pragma unroll
            for (int nn = 0; nn < 4; ++nn)
#pragma unroll
                for (int r = 0; r < 4; ++r) st[(16 * m + 4 * fq + r) * 128 + 64 * kn + 16 * nn + fr] = acc[m][nn][r];
        __syncthreads();
    }
}
template <bool DRY = false>
DI void ssd_scan(const Frame& F) {
    f32x4* st = WSP(f32x4, WS_STATES); const float* cdec = WSP(float, WS_CDEC);
    const int gt = F.gw * 64 + F.lane, NGT = F.NGW * 64;
    for (int i = gt; i < 8 * 65536; i += NGT) {
        const int b = i >> 16, e = i & 65535, h = e >> 11;
        f32x4 run = (f32x4){0.f, 0.f, 0.f, 0.f};
        f32x4* p = st + (size_t)b * 16 * 65536 + e;
        f32x4 tmp[16];
#pragma unroll
        for (int n = 0; n < 16; ++n) tmp[n] = p[(size_t)n * 65536];
#pragma unroll
        for (int n = 0; n < 16; ++n) { if (!DRY || run[0] == 1.2345e30f) p[(size_t)n * 65536] = run; run = run * cdec[(b * 16 + n) * 32 + h] + tmp[n]; }
    }
}

template <bool DRY = false>
DI void ssd_out_unit(const Frame& F, int unit) {
    const int g = unit & 3, bn = unit >> 2, tok0 = bn * CH, tid = F.tid, lane = F.lane, w = F.wave, fr = lane & 15, fq = lane >> 4;
    const bf16_t* xbc = WSP(bf16_t, WS_XBC); bf16_t* proj = WSP(bf16_t, WS_PROJ);
    LAS short* Cimg = (LAS short*)F.lds;
    LAS short* Bimg = Cimg + 128 * 136;
    LAS short* Ximg = Bimg + 128 * 136;
    LAS short* Pimg = Ximg + 128 * 72;
    LAS float* dtl = (LAS float*)(Pimg + 64 * 136);
    LAS float* acl = dtl + 1024;
    ssd_dt_acum(F, tok0, g, dtl, acl);
#pragma unroll
    for (int i = 0; i < 4; ++i) { const int c = tid + 512 * i, row = c >> 4, ch8 = c & 15;
        *(LAS u32x4*)(Bimg + row * 136 + ch8 * 8) = *(const u32x4*)(xbc + (size_t)(tok0 + row) * 3072 + 2048 + g * 128 + ch8 * 8);
        *(LAS u32x4*)(Cimg + row * 136 + ch8 * 8) = *(const u32x4*)(xbc + (size_t)(tok0 + row) * 3072 + 2560 + g * 128 + ch8 * 8); }
    __syncthreads();
    f32x4 cbm[8];
#pragma unroll
    for (int nf = 0; nf < 8; ++nf) cbm[nf] = (f32x4){0.f, 0.f, 0.f, 0.f};
#pragma unroll
    for (int ks = 0; ks < 4; ++ks) { const bf16x8 a = frag_row(Cimg, 136, 16 * w, 32 * ks, lane);
#pragma unroll
        for (int nf = 0; nf < 8; ++nf) { const bf16x8 bb = frag_row(Bimg, 136, 16 * nf, 32 * ks, lane); cbm[nf] = MFMA16(a, bb, cbm[nf]); } }
    __syncthreads();
    LAS short* Mimg = Bimg;
    for (int hh = 0; hh < 8; ++hh) {
        const int head = 8 * g + hh;
#pragma unroll
        for (int i = 0; i < 2; ++i) { const int c = tid + 512 * i, row = c >> 3, ch8 = c & 7;
            *(LAS u32x4*)(Ximg + row * 72 + ch8 * 8) = *(const u32x4*)(xbc + (size_t)(tok0 + row) * 3072 + head * 64 + ch8 * 8); }
        { const float* prev = WSP(float, WS_STATES) + ((size_t)bn * 32 + head) * 8192;
#pragma unroll
          for (int i = 0; i < 4; ++i) { const int c = tid + 512 * i, row = c >> 5, c4 = c & 31; const f32x4 v = *(const f32x4*)(prev + row * 128 + c4 * 4);
              u32x2 o; o.x = pk2(v[0], v[1]); o.y = pk2(v[2], v[3]); *(LAS u32x2*)(Pimg + row * 136 + c4 * 4) = o; } }
#pragma unroll
        for (int nf = 0; nf < 8; ++nf) { const int s = 16 * nf + fr; const float as = acl[s * 8 + hh], ds = dtl[s * 8 + hh];
#pragma unroll
            for (int r = 0; r < 4; ++r) { const int l = 16 * w + 4 * fq + r; const float v = (s <= l) ? cbm[nf][r] * __expf(acl[l * 8 + hh] - as) * ds : 0.f; Mimg[l * 136 + s] = (short)f2bf(v); } }
        __syncthreads();
        f32x4 a1[4], a2[4];
#pragma unroll
        for (int nn = 0; nn < 4; ++nn) { a1[nn] = (f32x4){0.f, 0.f, 0.f, 0.f}; a2[nn] = (f32x4){0.f, 0.f, 0.f, 0.f}; }
#pragma unroll
        for (int ks = 0; ks < 4; ++ks) { const bf16x8 am = frag_row(Mimg, 136, 16 * w, 32 * ks, lane), ac = frag_row(Cimg, 136, 16 * w, 32 * ks, lane);
#pragma unroll
            for (int nn = 0; nn < 4; ++nn) { const bf16x8 bx = frag_tr(Ximg, 72, 16 * nn, 32 * ks, lane); a1[nn] = MFMA16(am, bx, a1[nn]);
                const bf16x8 bp = frag_row(Pimg, 136, 16 * nn, 32 * ks, lane); a2[nn] = MFMA16(ac, bp, a2[nn]); } }
        const float dsk = F.in[18][head];
#pragma unroll
        for (int r = 0; r < 4; ++r) { const int l = 16 * w + 4 * fq + r; const float el = __expf(acl[l * 8 + hh]);
            bf16_t* zp = proj + (size_t)(tok0 + l) * SSM_N + head * 64 + fr;
            float ss = 0.f;
#pragma unroll
            for (int nn = 0; nn < 4; ++nn) { const float xv = bf2f((unsigned short)Ximg[l * 72 + 16 * nn + fr]); const float y = a1[nn][r] + el * a2[nn][r] + dsk * xv;
                const float z = bf2f(zp[16 * nn]); const float yg = y * siluf_(z); ss += yg * yg; if (!DRY || yg == 1.2345e30f) zp[16 * nn] = (bf16_t)f2bf(yg); }
            ss = row16_sum(ss);
            if (fr == 0) WSP(float, WS_YSLOTS)[(size_t)(tok0 + l) * 32 + head] = ss; }
        __syncthreads();
    }
}


constexpr size_t WS_ST16 = WS_STATES, WS_SP16 = WS_STATES + 64 * MiB;
DI void ssd_state2_unit(const Frame& F, int unit) {
    const int g = unit & 3, bn = unit >> 2, tok0 = bn * CH;
    int tid = F.tid; asm volatile("" : "+v"(tid));
    const int lane = tid & 63, w = F.wave, fr = lane & 15, fq = lane >> 4;
    const bf16_t* xbc = WSP(bf16_t, WS_XBC);
    LAS short* Bimg = (LAS short*)F.lds;
    LAS short* Ximg = Bimg + 128 * 136;
    LAS float* dtl = (LAS float*)(F.lds + (128 * 136 + 128 * LDQ) * 2);
    LAS float* acl = dtl + 1024;
    LAS float* wsc = acl + 1024;
    Tile TX; u32x4 tb[4];
    tile_issue(TX, xbc + (size_t)tok0 * 3072 + g * 512, 3072, tid);
#pragma unroll
    for (int i = 0; i < 4; ++i) { const unsigned c = (unsigned)tid + 512u * i; tb[i] = *(const u32x4*)(xbc + (size_t)(tok0 + (c >> 4)) * 3072 + 2048 + g * 128 + (c & 15u) * 8); }
    ssd_dt_acum(F, tok0, g, dtl, acl);
#pragma unroll
    for (int i = 0; i < 4; ++i) { const unsigned c = (unsigned)tid + 512u * i; *(LAS u32x4*)(Bimg + (c >> 4) * 136 + (c & 15u) * 8) = tb[i]; }
    LBAR();
    for (int i = tid; i < 1024; i += NTHR) wsc[i] = __expf(acl[127 * 8 + (i & 7)] - acl[i]) * dtl[i];
    if (tid < 8) WSP(float, WS_CDEC)[bn * 32 + 8 * g + tid] = __expf(acl[127 * 8 + tid]);
    LBAR();
#pragma unroll 1
    for (int half = 0; half < 2; ++half) {
#pragma unroll
        for (int i = 0; i < 8; ++i) { const unsigned c = (unsigned)tid + 512u * i, row = c >> 5, ch = c & 31u; const float s = wsc[row * 8 + 4 * half + (ch >> 3)]; u32x4 v = TX.v[i];
            v.x = pk2(bflo(v.x) * s, bfhi(v.x) * s); v.y = pk2(bflo(v.y) * s, bfhi(v.y) * s); v.z = pk2(bflo(v.z) * s, bfhi(v.z) * s); v.w = pk2(bflo(v.w) * s, bfhi(v.w) * s);
            *(LAS u32x4*)(Ximg + row * LDQ + ch * 8) = v; }
        LBAR();
        if (half == 0) tile_issue(TX, xbc + (size_t)tok0 * 3072 + g * 512 + 256, 3072, tid);
        const int hl = w >> 1, kn = w & 1;
        f32x4 acc[4][4];
#pragma unroll
        for (int m = 0; m < 4; ++m)
#pragma unroll
            for (int nn = 0; nn < 4; ++nn) acc[m][nn] = (f32x4){0.f, 0.f, 0.f, 0.f};
#pragma unroll
        for (int ks = 0; ks < 4; ++ks) { bf16x8 bb[4];
#pragma unroll
            for (int nn = 0; nn < 4; ++nn) bb[nn] = frag_tr(Bimg, 136, 64 * kn + 16 * nn, 32 * ks, lane);
#pragma unroll
            for (int m = 0; m < 4; ++m) { const bf16x8 a = frag_tr(Ximg, LDQ, hl * 64 + 16 * m, 32 * ks, lane);
#pragma unroll
                for (int nn = 0; nn < 4; ++nn) acc[m][nn] = MFMA16(a, bb[nn], acc[m][nn]); } }
        bf16_t* st = WSP(bf16_t, WS_ST16) + ((size_t)bn * 32 + 8 * g + 4 * half + hl) * 8192;
#pragma unroll
        for (int m = 0; m < 4; ++m)
#pragma unroll
            for (int nn = 0; nn < 4; ++nn) { u32x2 o; o.x = pk2(acc[m][nn][0], acc[m][nn][1]); o.y = pk2(acc[m][nn][2], acc[m][nn][3]);
                *(u32x2*)(st + (64 * kn + 16 * nn + fr) * 64 + 16 * m + 4 * fq) = o; }
        LBAR();
    }
}
template <bool DRY = false>
DI void ssd_scan2(const Frame& F) {
    const u32x4* sv = WSP(u32x4, WS_ST16); u32x4* pv = WSP(u32x4, WS_SP16); const float* cdec = WSP(float, WS_CDEC);
    const int gt = F.gw * 64 + F.lane, NGT = F.NGW * 64;
    for (int i = gt; i < 8 * 32768; i += NGT) {
        const int b = i >> 15, e = i & 32767, h = e >> 10;
        float run[8];
#pragma unroll
        for (int k = 0; k < 8; ++k) run[k] = 0.f;
        const size_t base = (size_t)b * 16 * 32768 + e;
        u32x4 tmp[16];
#pragma unroll
        for (int n = 0; n < 16; ++n) tmp[n] = sv[base + (size_t)n * 32768];
#pragma unroll
        for (int n = 0; n < 16; ++n) { u32x4 o; o.x = pk2(run[0], run[1]); o.y = pk2(run[2], run[3]); o.z = pk2(run[4], run[5]); o.w = pk2(run[6], run[7]);
            if (!DRY || run[0] == 1.2345e30f) pv[base + (size_t)n * 32768] = o;
            const u32x4 t = tmp[n]; const float cd = cdec[(b * 16 + n) * 32 + h];
            run[0] = run[0] * cd + bflo(t.x); run[1] = run[1] * cd + bfhi(t.x); run[2] = run[2] * cd + bflo(t.y); run[3] = run[3] * cd + bfhi(t.y);
            run[4] = run[4] * cd + bflo(t.z); run[5] = run[5] * cd + bfhi(t.z); run[6] = run[6] * cd + bflo(t.w); run[7] = run[7] * cd + bfhi(t.w); }
    }
}
template <bool DRY = false>
DI void ssd_out2_unit(const Frame& F, int unit) {
    const int g = unit & 3, bn = unit >> 2, tok0 = bn * CH;
    int tid = F.tid; asm volatile("" : "+v"(tid));
    const int lane = tid & 63, w = F.wave, fr = lane & 15, fq = lane >> 4;
    const bf16_t* xbc = WSP(bf16_t, WS_XBC); bf16_t* proj = WSP(bf16_t, WS_PROJ);
    LAS short* Cimg = (LAS short*)F.lds;
    LAS short* Mimg = Cimg + 128 * 136;
    LAS short* Ximg = Mimg + 128 * 136;
    LAS short* Pimg = Ximg + 128 * 72;
    LAS short* Zimg = Pimg + 128 * 72;
    LAS float* dtl = (LAS float*)(Zimg + 128 * 72);
    LAS float* acl = dtl + 1024;
    const bf16_t* spbase = WSP(bf16_t, WS_SP16) + ((size_t)bn * 32 + 8 * g) * 8192;
    u32x4 px[2], pp[2], pz[2];
#define SSD2_PREF(hh_) do { const int head_ = 8 * g + (hh_); _Pragma("unroll") for (int i = 0; i < 2; ++i) { const unsigned c = (unsigned)tid + 512u * i, row = c >> 3, ch = c & 7u; \
        px[i] = *(const u32x4*)(xbc + (size_t)(tok0 + row) * 3072 + head_ * 64 + ch * 8); pp[i] = *(const u32x4*)(spbase + (size_t)(hh_) * 8192 + row * 64 + ch * 8); \
        pz[i] = *(const u32x4*)(proj + (size_t)(tok0 + row) * SSM_N + head_ * 64 + ch * 8); } } while (0)
    SSD2_PREF(0);
    ssd_dt_acum(F, tok0, g, dtl, acl);
#pragma unroll
    for (int i = 0; i < 4; ++i) { const unsigned c = (unsigned)tid + 512u * i, row = c >> 4, ch8 = c & 15u;
        *(LAS u32x4*)(Mimg + row * 136 + ch8 * 8) = *(const u32x4*)(xbc + (size_t)(tok0 + row) * 3072 + 2048 + g * 128 + ch8 * 8);
        *(LAS u32x4*)(Cimg + row * 136 + ch8 * 8) = *(const u32x4*)(xbc + (size_t)(tok0 + row) * 3072 + 2560 + g * 128 + ch8 * 8); }
    LBAR();
    f32x4 cbm[8];
#pragma unroll
    for (int nf = 0; nf < 8; ++nf) cbm[nf] = (f32x4){0.f, 0.f, 0.f, 0.f};
#pragma unroll
    for (int ks = 0; ks < 4; ++ks) { const bf16x8 a = frag_row(Cimg, 136, 16 * w, 32 * ks, lane);
#pragma unroll
        for (int nf = 0; nf < 8; ++nf) { const bf16x8 bb = frag_row(Mimg, 136, 16 * nf, 32 * ks, lane); cbm[nf] = MFMA16(a, bb, cbm[nf]); }
        pin(cbm); }
    LBAR();
#pragma unroll 1
    for (int hh = 0; hh < 8; ++hh) {
        const int head = 8 * g + hh;
#pragma unroll
        for (int i = 0; i < 2; ++i) { const unsigned c = (unsigned)tid + 512u * i, row = c >> 3, ch = c & 7u;
            *(LAS u32x4*)(Ximg + row * 72 + ch * 8) = px[i]; *(LAS u32x4*)(Pimg + row * 72 + ch * 8) = pp[i]; *(LAS u32x4*)(Zimg + row * 72 + ch * 8) = pz[i]; }
#pragma unroll
        for (int nf = 0; nf < 8; ++nf) { const int s = 16 * nf + fr; const float as = acl[s * 8 + hh], ds = dtl[s * 8 + hh];
#pragma unroll
            for (int r = 0; r < 4; ++r) { const int l = 16 * w + 4 * fq + r; const float v = (s <= l) ? cbm[nf][r] * __expf(acl[l * 8 + hh] - as) * ds : 0.f; Mimg[l * 136 + s] = (short)f2bf(v); } }
        LBAR();
        if (hh < 7) SSD2_PREF(hh + 1);
        f32x4 a1[4], a2[4];
#pragma unroll
        for (int nn = 0; nn < 4; ++nn) { a1[nn] = (f32x4){0.f, 0.f, 0.f, 0.f}; a2[nn] = (f32x4){0.f, 0.f, 0.f, 0.f}; }
#pragma unroll
        for (int ks = 0; ks < 4; ++ks) { const bf16x8 am = frag_row(Mimg, 136, 16 * w, 32 * ks, lane), ac = frag_row(Cimg, 136, 16 * w, 32 * ks, lane);
#pragma unroll
            for (int nn = 0; nn < 4; ++nn) { const bf16x8 bx = frag_tr(Ximg, 72, 16 * nn, 32 * ks, lane); a1[nn] = MFMA16(am, bx, a1[nn]);
                const bf16x8 bp = frag_tr(Pimg, 72, 16 * nn, 32 * ks, lane); a2[nn] = MFMA16(ac, bp, a2[nn]); }
            pin(a1); pin(a2); }
        const float dsk = F.in[18][head];
#pragma unroll
        for (int r = 0; r < 4; ++r) { const int l = 16 * w + 4 * fq + r; const float el = __expf(acl[l * 8 + hh]);
            float ss = 0.f;
#pragma unroll
            for (int nn = 0; nn < 4; ++nn) { const int p = 16 * nn + fr; const float xv = bf2f((unsigned short)Ximg[l * 72 + p]); const float y = a1[nn][r] + el * a2[nn][r] + dsk * xv;
                const float z = bf2f((unsigned short)Zimg[l * 72 + p]); const float yg = y * siluf_(z); ss += yg * yg; Zimg[l * 72 + p] = (short)f2bf(yg); }
            ss = row16_sum(ss);
            if (fr == 0) WSP(float, WS_YSLOTS)[(size_t)(tok0 + l) * 32 + head] = ss; }
        LBAR();
#pragma unroll
        for (int i = 0; i < 2; ++i) { const unsigned c = (unsigned)tid + 512u * i, row = c >> 3, ch = c & 7u; const u32x4 y = *(const LAS u32x4*)(Zimg + row * 72 + ch * 8);
            if (!DRY || y.x == 0x12345678u) *(u32x4*)(proj + (size_t)(tok0 + row) * SSM_N + head * 64 + ch * 8) = y; }
        LBAR();
    }
#undef SSD2_PREF
}

#ifndef SSD_FUSED
#define SSD_FUSED 1
#endif
template <bool DRY = false>
DI void ssd_fused_unit(const Frame& F, int unit) {
    const int b = unit >> 5, head = unit & 31, g = head >> 3;
    int tid = F.tid; asm volatile("" : "+v"(tid));
    const int lane = tid & 63, w = F.wave, fr = lane & 15, fq = lane >> 4;
    const bf16_t* xbc = WSP(bf16_t, WS_XBC); bf16_t* proj = WSP(bf16_t, WS_PROJ); const float* DT = WSP(float, WS_DT);
    LAS short* Cimg = (LAS short*)F.lds;
    LAS short* Mimg = Cimg + 128 * 136;
    LAS short* Ximg = Mimg + 128 * 136;
    LAS short* Simg = Ximg + 128 * 72;
    LAS short* Pimg = Simg + 128 * 72;
    LAS short* Zimg = Pimg + 128 * 72;
    LAS float* dtl = (LAS float*)(Zimg + 128 * 72);
    LAS float* acl = dtl + 128;
    LAS short* Himg = (LAS short*)(acl + 128);
    LAS float* Wl = (LAS float*)(Himg + 2 * 192);
    const float an = -expf(F.in[17][head]), dsk = F.in[18][head];
    f32x4 st[4];
#pragma unroll
    for (int m = 0; m < 4; ++m) st[m] = (f32x4){0.f, 0.f, 0.f, 0.f};
    u32x4 tb[4], tc[4], px[2], pz[2]; float dn0 = 0.f, dn1 = 0.f;
#define SSD3_PREF(n_) do { const int tk_ = (b * 16 + (n_)) * CH; const unsigned char* xb_ = (const unsigned char*)xbc; const unsigned char* pj_ = (const unsigned char*)proj; unsigned t_ = (unsigned)tid; asm volatile("" : "+v"(t_));     \
        _Pragma("unroll") for (int i = 0; i < 4; ++i) { const unsigned c = t_ + 512u * i, row = c >> 4, ch8 = c & 15u; const unsigned o_ = (((unsigned)tk_ + row) * 3072u + 2048u + (unsigned)g * 128u + ch8 * 8u) * 2u; \
            tb[i] = *(const u32x4*)(xb_ + o_); tc[i] = *(const u32x4*)(xb_ + (o_ + 1024u)); } \
        _Pragma("unroll") for (int i = 0; i < 2; ++i) { const unsigned c = t_ + 512u * i, row = c >> 3, ch = c & 7u; const unsigned o_ = (((unsigned)tk_ + row) * (unsigned)SSM_N + (unsigned)head * 64u + ch * 8u) * 2u; \
            px[i] = *(const u32x4*)(pj_ + (o_ + 4096u)); pz[i] = *(const u32x4*)(pj_ + o_); } \
        if (w == 0) { dn0 = DT[(size_t)(tk_ + 2 * lane) * 32 + head]; dn1 = DT[(size_t)(tk_ + 2 * lane + 1) * 32 + head]; } asm volatile("" ::: "memory"); } while (0)
    if (tid < 24) { unsigned z_ = 0u; asm volatile("" : "+v"(z_)); *(LAS u32x4*)(Himg + tid * 8) = (u32x4){z_, z_, z_, z_}; }
    if (tid < 64) { const float* cw = F.in[14];
#pragma unroll
        for (int k = 0; k < 4; ++k) Wl[k * 64 + tid] = cw[k * 3072 + head * 64 + tid];
        Wl[256 + tid] = F.in[15][head * 64 + tid]; }
    asm volatile("" ::: "memory");
    SSD3_PREF(0);
    const bool tconv = TCONV_IN_SSD && !DRY && F.G == 256;
    const int trow0 = unit * 8 + w;
    f32x4 tg[4]; f32x4 tv[4];
#pragma unroll
    for (int i = 0; i < 4; ++i) { tg[i] = (f32x4){1.f, 1.f, 1.f, 1.f}; tv[i] = (f32x4){0.f, 0.f, 0.f, 0.f}; }
    if (tconv) { const f32x4* g4 = (const f32x4*)(F.in[2] + 1024) + 2 * lane; tg[0] = g4[0]; tg[1] = g4[1]; tg[2] = g4[128]; tg[3] = g4[129]; }
#pragma unroll 1
    for (int n = 0; n < 16; ++n) {
        const int tok0 = (b * 16 + n) * CH;
        const int trow = trow0 + 2048 * n;
#pragma unroll
        for (int i = 0; i < 4; ++i) { const unsigned c = (unsigned)tid + 512u * i, row = c >> 4, ch8 = c & 15u; *(LAS u32x4*)(Mimg + row * 136 + ch8 * 8) = tb[i]; *(LAS u32x4*)(Cimg + row * 136 + ch8 * 8) = tc[i]; }
#pragma unroll
        for (int i = 0; i < 2; ++i) { const unsigned c = (unsigned)tid + 512u * i, row = c >> 3, ch = c & 7u; *(LAS u32x4*)(Pimg + row * 72 + ch * 8) = px[i]; *(LAS u32x4*)(Zimg + row * 72 + ch * 8) = pz[i];
            if (i == 1 && row >= 125u) *(LAS u32x4*)(Himg + ((n + 1) & 1) * 192 + (row - 125u) * 64 + ch * 8) = px[i]; }
#pragma unroll
        for (int m = 0; m < 0; ++m) {}
        if (w == 0) { const float d0 = dn0, d1 = dn1;
            const float a0 = d0 * an, a1 = d1 * an; float sm = a0 + a1;
            sm = wave_scan_incl(sm);
            dtl[2 * lane] = d0; dtl[2 * lane + 1] = d1; acl[2 * lane] = sm - a1; acl[2 * lane + 1] = sm; }
        LBAR();
        if (n < 15) SSD3_PREF(n + 1);
        if (tconv) { const float* src = (trow < 16384) ? F.in[23] + ((size_t)16384 + trow) * 1024 : F.in[24] + ((size_t)16384 + (trow - 16384)) * 1024; const f32x4* s4 = (const f32x4*)src + 2 * lane;
            tv[0] = s4[0]; tv[1] = s4[1]; tv[2] = s4[128]; tv[3] = s4[129]; asm volatile("" ::: "memory"); }
        const float alast = acl[127];
        { const int ch = tid & 7, row0 = tid >> 3; const LAS f32x4* w4 = (const LAS f32x4*)(Wl + ch * 8);
          f32x4 y0[2], y1[2];
          y0[0] = y0[1] = w4[64]; y1[0] = y1[1] = w4[65];
#pragma unroll
          for (int k = 0; k < 4; ++k) { const f32x4 wa = w4[16 * k], wb = w4[16 * k + 1];
#pragma unroll
            for (int i = 0; i < 2; ++i) { const int r_ = row0 + 64 * i - 3 + k; const LAS short* rp = (r_ >= 0) ? Pimg + r_ * 72 : Himg + (n & 1) * 192 + (r_ + 3) * 64;
                const u32x4 v = *(const LAS u32x4*)(rp + ch * 8);
                y0[i][0] += wa[0] * bflo(v.x); y0[i][1] += wa[1] * bfhi(v.x); y0[i][2] += wa[2] * bflo(v.y); y0[i][3] += wa[3] * bfhi(v.y);
                y1[i][0] += wb[0] * bflo(v.z); y1[i][1] += wb[1] * bfhi(v.z); y1[i][2] += wb[2] * bflo(v.w); y1[i][3] += wb[3] * bfhi(v.w); }
            }
#pragma unroll
          for (int i = 0; i < 2; ++i) { const int row = row0 + 64 * i; const float sc = __expf(alast - acl[row]) * dtl[row];
            u32x4 q; q.x = pk2(siluf_(y0[i][0]), siluf_(y0[i][1])); q.y = pk2(siluf_(y0[i][2]), siluf_(y0[i][3])); q.z = pk2(siluf_(y1[i][0]), siluf_(y1[i][1])); q.w = pk2(siluf_(y1[i][2]), siluf_(y1[i][3]));
            *(LAS u32x4*)(Ximg + row * 72 + ch * 8) = q; u32x4 v = q;
            v.x = pk2(bflo(v.x) * sc, bfhi(v.x) * sc); v.y = pk2(bflo(v.y) * sc, bfhi(v.y) * sc); v.z = pk2(bflo(v.z) * sc, bfhi(v.z) * sc); v.w = pk2(bflo(v.w) * sc, bfhi(v.w) * sc);
            *(LAS u32x4*)(Simg + row * 72 + ch * 8) = v; } }
        asm volatile("" ::: "memory");
        f32x4 cbm[8];
#pragma unroll
        for (int nf = 0; nf < 8; ++nf) cbm[nf] = (f32x4){0.f, 0.f, 0.f, 0.f};
#pragma unroll
        for (int ks = 0; ks < 4; ++ks) { const bf16x8 a = frag_row(Mimg, 136, 16 * w, 32 * ks, lane);
#pragma unroll
            for (int nf = 0; nf < 8; ++nf) { const bf16x8 bb = frag_row(Cimg, 136, 16 * nf, 32 * ks, lane); cbm[nf] = MFMA16(a, bb, cbm[nf]); }
            pin(cbm); }
        LBAR();
#pragma unroll
        for (int m = 0; m < 4; ++m) { u32x2 o; o.x = pk2(st[m][0], st[m][1]); o.y = pk2(st[m][2], st[m][3]); *(LAS u32x2*)(Pimg + (16 * w + fr) * 72 + 16 * m + 4 * fq) = o; }
        { f32x4 an4[4];
#pragma unroll
          for (int m = 0; m < 4; ++m) an4[m] = (f32x4){0.f, 0.f, 0.f, 0.f};
#pragma unroll
          for (int ks = 0; ks < 4; ++ks) { const bf16x8 bb = frag_tr(Mimg, 136, 16 * w, 32 * ks, lane);
#pragma unroll
              for (int m = 0; m < 4; ++m) { const bf16x8 a = frag_tr(Simg, 72, 16 * m, 32 * ks, lane); an4[m] = MFMA16(a, bb, an4[m]); }
              pin(an4); }
          const float cd = __expf(alast);
#pragma unroll
          for (int m = 0; m < 4; ++m) st[m] = st[m] * cd + an4[m]; }
        LBAR();
        { const int sb = 16 * w + 4 * fq; const f32x4 as4 = *(const LAS f32x4*)(acl + sb), ds4 = *(const LAS f32x4*)(dtl + sb);
          const float asv[4] = {as4[0], as4[1], as4[2], as4[3]}, dsv[4] = {ds4[0], ds4[1], ds4[2], ds4[3]};
          const float aref = acl[(16 * w + 16 < 128) ? 16 * w + 16 : 127]; float Fr[4];
#pragma unroll
          for (int r = 0; r < 4; ++r) Fr[r] = __expf(aref - asv[r]) * dsv[r];
#pragma unroll
          for (int nf = 0; nf < 8; ++nf) { const int l = 16 * nf + fr; float v[4];
              if (nf < w) {
#pragma unroll
                  for (int r = 0; r < 4; ++r) v[r] = 0.f;
              } else if (nf == w) { const float al = acl[l];
#pragma unroll
                  for (int r = 0; r < 4; ++r) v[r] = (sb + r <= l) ? cbm[nf][r] * __expf(al - asv[r]) * dsv[r] : 0.f;
              } else { const float El = __expf(acl[l] - aref);
#pragma unroll
                  for (int r = 0; r < 4; ++r) v[r] = cbm[nf][r] * El * Fr[r]; }
              u32x2 o; o.x = pk2(v[0], v[1]); o.y = pk2(v[2], v[3]); *(LAS u32x2*)(Mimg + l * 136 + sb) = o; } }
        f32x4 a1[4], a2[4];
#pragma unroll
        for (int np = 0; np < 4; ++np) { a1[np] = (f32x4){0.f, 0.f, 0.f, 0.f}; a2[np] = (f32x4){0.f, 0.f, 0.f, 0.f}; }
#pragma unroll
        for (int ks = 0; ks < 4; ++ks) { const bf16x8 bc = frag_row(Cimg, 136, 16 * w, 32 * ks, lane);
#pragma unroll
            for (int np = 0; np < 4; ++np) { const bf16x8 ap = frag_tr(Pimg, 72, 16 * np, 32 * ks, lane); a2[np] = MFMA16(ap, bc, a2[np]); }
            pin(a2); }
        LBAR();
#pragma unroll
        for (int ks = 0; ks < 4; ++ks) {
            if (32 * ks <= 16 * w + 15) {
                const bf16x8 bm = frag_row(Mimg, 136, 16 * w, 32 * ks, lane);
#pragma unroll
                for (int np = 0; np < 4; ++np) { const bf16x8 ax = frag_tr(Ximg, 72, 16 * np, 32 * ks, lane); a1[np] = MFMA16(ax, bm, a1[np]); } }
            pin(a1); }
        asm volatile("s_nop 15\n\ts_nop 15" ::: "memory");
        { const int l = 16 * w + fr; const float el = __expf(acl[l]); float ss = 0.f;
#pragma unroll
          for (int np = 0; np < 4; ++np) { const int p0 = 16 * np + 4 * fq; const u32x2 xw = *(const LAS u32x2*)(Ximg + l * 72 + p0), zw = *(const LAS u32x2*)(Zimg + l * 72 + p0);
              const unsigned xw0 = xw.x, xw1 = xw.y, zw0 = zw.x, zw1 = zw.y;
              const float xv[4] = {bflo(xw0), bfhi(xw0), bflo(xw1), bfhi(xw1)}, zv[4] = {bflo(zw0), bfhi(zw0), bflo(zw1), bfhi(zw1)}; float yg[4];
#pragma unroll
              for (int r = 0; r < 4; ++r) { const float y = a1[np][r] + el * a2[np][r] + dsk * xv[r]; yg[r] = y * siluf_(zv[r]); ss += yg[r] * yg[r]; }
              u32x2 o; o.x = pk2(yg[0], yg[1]); o.y = pk2(yg[2], yg[3]);
              if (!DRY || o.x == 0x12345678u) *(u32x2*)(proj + (size_t)(tok0 + l) * SSM_N + head * 64 + p0) = o; }
          ss += __shfl_xor(ss, 16); ss += __shfl_xor(ss, 32);
          if (fq == 0) WSP(float, WS_YSLOTS)[(size_t)(tok0 + l) * 32 + head] = ss; }
        if (tconv) { const bool isu = trow < 16384; const int e = isu ? trow : trow - 16384; const float scl = isu ? PEER_SU : PEER_SV;
            unsigned char* dstb = (isu ? WSP(unsigned char, WS_UB) : WSP(unsigned char, WS_VB)) + (size_t)(lane >> 5) * (16384 * 128) + (size_t)e * 128 + 4 * (lane & 31);
#pragma unroll
            for (int j = 0; j < 2; ++j) { f32x4 a4 = tv[2 * j] * scl, b4 = tv[2 * j + 1] * scl; if (isu) { a4 = a4 * tg[2 * j]; b4 = b4 * tg[2 * j + 1]; }
                unsigned wq = 0;
                wq = __builtin_amdgcn_cvt_scalef32_pk_fp4_f32(wq, a4[0], a4[1], 1.0f, 0); wq = __builtin_amdgcn_cvt_scalef32_pk_fp4_f32(wq, a4[2], a4[3], 1.0f, 1);
                wq = __builtin_amdgcn_cvt_scalef32_pk_fp4_f32(wq, b4[0], b4[1], 1.0f, 2); wq = __builtin_amdgcn_cvt_scalef32_pk_fp4_f32(wq, b4[2], b4[3], 1.0f, 3);
                *(unsigned*)(dstb + (size_t)j * (2 * 16384 * 128)) = wq; } }
        LBAR();
    }
#undef SSD3_PREF
}


DI void lru_ref_unit(const Frame& F, int unit) {
    if (F.wave != 0) return;
    const int b = unit >> 4, blk = unit & 15, c = F.lane, ch = blk * 64 + c;
    bf16_t* proj = WSP(bf16_t, WS_PROJ);
    LAS float* xs = (LAS float*)F.lds;
    const float* cw = F.in[5]; const float cw0 = cw[ch], cw1 = cw[1024 + ch], cw2 = cw[2048 + ch], cw3 = cw[3072 + ch], cb = F.in[6][ch];
    const float ba = F.in[8][ch], bi = F.in[10][ch], sp = softplusf_(-F.in[11][ch]);
    const float* wa = F.in[7] + blk * 4096; const float* wi = F.in[9] + blk * 4096;
    float x1 = 0.f, x2 = 0.f, x3 = 0.f, h = 0.f;
    for (int t = 0; t < SEQ; ++t) {
        const size_t tok = (size_t)b * SEQ + t;
        const float x0 = bf2f(proj[tok * EVEN_IN + P0_XA + ch]);
        const float xc = cb + cw0 * x3 + cw1 * x2 + cw2 * x1 + cw3 * x0; x3 = x2; x2 = x1; x1 = x0;
        xs[c] = xc;
        float pr = 0.f, pi = 0.f;
        for (int i = 0; i < 64; ++i) { const float xv = xs[i]; pr += xv * wa[i * 64 + c]; pi += xv * wi[i * 64 + c]; }
        const float rg = 1.f / (1.f + expf(-(pr + ba))), ig = 1.f / (1.f + expf(-(pi + bi)));
        const float la = -8.f * rg * sp, a = expf(la), mult = sqrtf(-expm1f(2.f * la));
        h = a * h + mult * (ig * xc);
        bf16_t* gp = proj + tok * EVEN_IN + P0_GA + ch; const float ga = bf2f(*gp);
        *gp = (bf16_t)f2bf(gelu_tanh(ga) * h);
    }
}
DI void ret_ref_unit(const Frame& F, int wu) {
    const int i = wu & 2047, h = (wu >> 11) & 3, b = wu >> 13, lane = F.lane;
    bf16_t* proj = WSP(bf16_t, WS_PROJ);
    const size_t tok = (size_t)b * SEQ + i;
    const float lg = ret_lg(h);
    const u32x2 qw = *(const u32x2*)(proj + tok * EVEN_IN + P0_Q + h * 256 + 4 * lane);
    const float q0 = bflo(qw.x), q1 = bfhi(qw.x), q2 = bflo(qw.y), q3 = bfhi(qw.y);
    float o0 = 0.f, o1 = 0.f, o2 = 0.f, o3 = 0.f;
    for (int j = 0; j <= i; ++j) {
        const size_t tj = (size_t)b * SEQ + j;
        const u32x2 kw = *(const u32x2*)(proj + tj * EVEN_IN + P0_K + h * 256 + 4 * lane);
        const u32x2 vw = *(const u32x2*)(proj + tj * EVEN_IN + P0_V + h * 256 + 4 * lane);
        float s = q0 * bflo(kw.x) + q1 * bfhi(kw.x) + q2 * bflo(kw.y) + q3 * bfhi(kw.y);
        s = wave_sum(s) * expf(lg * (float)(i - j));
        o0 += s * bflo(vw.x); o1 += s * bfhi(vw.x); o2 += s * bflo(vw.y); o3 += s * bfhi(vw.y);
    }
    const float ss = wave_sum(o0 * o0 + o1 * o1 + o2 * o2 + o3 * o3);
    const float rn = rsqrtf(ss * (1.f / 256.f) + EPS);
    bf16_t* gp = proj + tok * EVEN_IN + P0_GB + h * 256 + 4 * lane;
    const u32x2 gw = *(const u32x2*)gp;
    u32x2 ow; ow.x = pk2(siluf_(bflo(gw.x)) * o0 * rn, siluf_(bfhi(gw.x)) * o1 * rn); ow.y = pk2(siluf_(bflo(gw.y)) * o2 * rn, siluf_(bfhi(gw.y)) * o3 * rn);
    *(u32x2*)gp = ow;
}
DI void ssd_ref_unit(const Frame& F, int unit) {
    const int b = unit >> 5, head = unit & 31, g = head >> 3, tid = F.tid, p = tid >> 3, kq = tid & 7;
    const bf16_t* xbc = WSP(bf16_t, WS_XBC); bf16_t* proj = WSP(bf16_t, WS_PROJ); const float* DT = WSP(float, WS_DT);
    LAS float* red = (LAS float*)F.lds;
    const float an = -expf(F.in[17][head]), dsk = F.in[18][head];
    float st[16];
#pragma unroll
    for (int k = 0; k < 16; ++k) st[k] = 0.f;
    for (int t = 0; t < SEQ; ++t) {
        const size_t tok = (size_t)b * SEQ + t;
        const float dt = DT[tok * 32 + head], a = expf(dt * an);
        const float x = bf2f(xbc[tok * 3072 + head * 64 + p]);
        const bf16_t* Bp = xbc + tok * 3072 + 2048 + g * 128 + kq * 16; const bf16_t* Cp = Bp + 512;
        float y = 0.f;
#pragma unroll
        for (int k = 0; k < 16; ++k) { st[k] = a * st[k] + dt * x * bf2f(Bp[k]); y += bf2f(Cp[k]) * st[k]; }
        y += __shfl_xor(y, 1); y += __shfl_xor(y, 2); y += __shfl_xor(y, 4);
        y += dsk * x;
        bf16_t* zp = proj + tok * SSM_N + head * 64 + p;
        const float yg = y * siluf_(bf2f(*zp));
        if (kq == 0) *zp = (bf16_t)f2bf(yg);
        float sq = (kq == 0) ? yg * yg : 0.f;
        sq = wave_sum(sq);
        if (F.lane == 0) red[(t & 1) * 8 + F.wave] = sq;
        __syncthreads();
        if (tid == 0) { float tot = 0.f; for (int w = 0; w < 8; ++w) tot += red[(t & 1) * 8 + w]; WSP(float, WS_YSLOTS)[tok * 32 + head] = tot; for (int hh = 0; hh < 0; ++hh) {} }
    }
    __syncthreads();
}

DI void peer_sel_ref_a(const Frame& F, int layer) {
    const bf16_t* Q = WSP(bf16_t, WS_Q); const float* keys = F.in[22] + (size_t)layer * 8 * 2 * 128 * 64;
    float* TOPV = WSP(float, WS_STATES); int* TOPI = (int*)(TOPV + (size_t)T * 16 * 16);
    const int gt = F.gw * 64 + F.lane, NGT = F.NGW * 64;
    for (int it = gt; it < T * 16; it += NGT) {
        const int t = it >> 4, hp = it & 15;
        float q[64];
#pragma unroll
        for (int k = 0; k < 64; ++k) q[k] = bf2f(Q[(size_t)t * 1024 + hp * 64 + k]);
        float tv[16]; int ti[16];
#pragma unroll
        for (int k = 0; k < 16; ++k) { tv[k] = -INFINITY; ti[k] = 0; }
        for (int n = 0; n < 128; ++n) {
            const float* kr = keys + ((size_t)hp * 128 + n) * 64; float sc = 0.f;
#pragma unroll
            for (int k = 0; k < 64; ++k) sc += q[k] * kr[k];
            float cv = sc; int ci = n;
#pragma unroll
            for (int k = 0; k < 16; ++k) { if (cv > tv[k]) { const float tvv = tv[k]; const int tii = ti[k]; tv[k] = cv; ti[k] = ci; cv = tvv; ci = tii; } }
        }
#pragma unroll
        for (int k = 0; k < 16; ++k) { TOPV[(size_t)it * 16 + k] = tv[k]; TOPI[(size_t)it * 16 + k] = ti[k]; }
    }
}
DI void peer_sel_ref_b(const Frame& F) {
    const float* TOPV = WSP(float, WS_STATES); const int* TOPI = (const int*)(TOPV + (size_t)T * 16 * 16);
    int* EIDX = WSP(int, WS_EIDX); float* GATE = WSP(float, WS_GATE);
    const int gt = F.gw * 64 + F.lane, NGT = F.NGW * 64;
    for (int it = gt; it < T * 8; it += NGT) {
        const int t = it >> 3, h = it & 7;
        const float* v0 = TOPV + ((size_t)t * 16 + 2 * h) * 16; const float* v1 = v0 + 16; const int* i0 = TOPI + ((size_t)t * 16 + 2 * h) * 16; const int* i1 = i0 + 16;
        float tv[16]; int ti[16];
#pragma unroll
        for (int k = 0; k < 16; ++k) { tv[k] = -INFINITY; ti[k] = 0; }
        for (int a = 0; a < 16; ++a) for (int b2 = 0; b2 < 16; ++b2) {
            float cv = v0[a] + v1[b2]; int ci = i0[a] * 128 + i1[b2];
#pragma unroll
            for (int k = 0; k < 16; ++k) { if (cv > tv[k]) { const float tvv = tv[k]; const int tii = ti[k]; tv[k] = cv; ti[k] = ci; cv = tvv; ci = tii; } }
        }
        float sum = 0.f; float ex[16];
#pragma unroll
        for (int k = 0; k < 16; ++k) { ex[k] = expf(tv[k] - tv[0]); sum += ex[k]; }
#pragma unroll
        for (int k = 0; k < 16; ++k) { EIDX[(size_t)t * 128 + h * 16 + k] = ti[k]; GATE[(size_t)t * 128 + h * 16 + k] = ex[k] / sum; }
    }
}

template <bool FINAL>
DI void peer_token_ref(const Frame& F, int layer, int t) {
    const int lane = F.lane;
    const float* U = F.in[23] + (size_t)layer * 16384 * 1024; const float* V = F.in[24] + (size_t)layer * 16384 * 1024; const float* g = F.in[2] + layer * 1024;
    const int* EIDX = WSP(int, WS_EIDX); const float* GATE = WSP(float, WS_GATE);
    float* xo = F.out + (size_t)t * 1024;
    float xv[16], hn[16], o[16]; float ss = 0.f;
#pragma unroll
    for (int j = 0; j < 16; ++j) { xv[j] = xo[lane + 64 * j]; ss += xv[j] * xv[j]; o[j] = 0.f; }
    float rstd = rsqrtf(wave_sum(ss) * (1.f / 1024.f) + EPS);
    const bf16_t* UBt = WSP(bf16_t, WS_UB); const bf16_t* VBt = WSP(bf16_t, WS_VB);
    if (DBG_REF & 32) { float sl = (lane < 16) ? WSP(float, WS_SLOTS)[(size_t)t * 16 + lane] : 0.f; rstd = rsqrtf(wave_sum(sl) * (1.f / 1024.f) + EPS); }
#pragma unroll
    for (int j = 0; j < 16; ++j) hn[j] = (DBG_REF & 32) ? bf2f(WSP(bf16_t, WS_XB)[(size_t)t * 1024 + lane + 64 * j]) * rstd : xv[j] * rstd * g[lane + 64 * j];
    for (int k = 0; k < 128; ++k) {
        const int e = EIDX[(size_t)t * 128 + k]; const float gt = GATE[(size_t)t * 128 + k];
        float d = 0.f;
#pragma unroll
        for (int j = 0; j < 16; ++j) d += hn[j] * ((DBG_REF & 32) ? bf2f(UBt[(size_t)e * 1024 + lane + 64 * j]) : U[(size_t)e * 1024 + lane + 64 * j]);
        d = wave_sum(d);
        const float a = gelu_tanh(d) * gt;
#pragma unroll
        for (int j = 0; j < 16; ++j) o[j] += a * ((DBG_REF & 32) ? bf2f(VBt[(size_t)e * 1024 + lane + 64 * j]) : V[(size_t)e * 1024 + lane + 64 * j]);
    }
    float s2 = 0.f;
#pragma unroll
    for (int j = 0; j < 16; ++j) { o[j] += xv[j]; s2 += o[j] * o[j]; }
    const float rs2 = rsqrtf(wave_sum(s2) * (1.f / 1024.f) + EPS);
    if (FINAL) {
#pragma unroll
        for (int j = 0; j < 16; ++j) xo[lane + 64 * j] = o[j] * rs2 * F.in[3][lane + 64 * j];
    } else {
        if (lane == 0) WSP(float, WS_RSTD)[t] = rs2;
#pragma unroll
        for (int j = 0; j < 16; ++j) { xo[lane + 64 * j] = o[j]; WSP(bf16_t, WS_XB)[(size_t)t * 1024 + lane + 64 * j] = (bf16_t)f2bf(o[j]); }
    }
}

DI void gemm_p1(const Frame& F, int bx) {
        pg8::Gemm g{WSP(bf16_t, WS_XB), WSP(bf16_t, WS_WIN0), T, EVEN_IN, 1024, 1024}; pg8::StaticOrder S; S.init(T, EVEN_IN, F.G, bx);
        pg8::Epi E{WSP(bf16_t, WS_PROJ), EVEN_IN, nullptr, nullptr, nullptr, WSP(float, WS_RSTD), 1, nullptr, WSP(f32x2, WS_ROPE), 12, 20, 16};
        pg8::gemm_phase<pg8::Epi, pg8::StaticOrder, true>(F.lds, g, S, E);
}
DI void gemm_p5(const Frame& F, int bx) {
        pg8::Gemm g{WSP(bf16_t, WS_PROJ), WSP(bf16_t, WS_WOUT0), T, 1024, 2048, EVEN_IN}; pg8::StaticOrder S; S.init(T, 1024, F.G, bx);
        pg8::Epi E{WSP(bf16_t, WS_XB), 1024, nullptr, F.in[0], nullptr, nullptr, 0, WSP(float, WS_SLOTS), nullptr, 0, 0, 0};
        pg8::gemm_phase<pg8::Epi, pg8::StaticOrder, true>(F.lds, g, S, E);
}
DI void gemm_p6(const Frame& F, int bx) {
        pg8::Gemm g{WSP(bf16_t, WS_XB), WSP(bf16_t, WS_WQ0), T, 1024, 1024, 1024}; pg8::StaticOrder S; S.init(T, 1024, F.G, bx);
        pg8::Epi E{WSP(bf16_t, WS_Q), 1024, nullptr, nullptr, nullptr, WSP(float, WS_SLOTS), 2, nullptr, nullptr, 0, 0, 0};
        pg8::gemm_phase<pg8::Epi, pg8::StaticOrder, true>(F.lds, g, S, E);
}
DI void gemm_p9(const Frame& F, int bx) {
        pg8::Gemm g{WSP(bf16_t, WS_XB), WSP(bf16_t, WS_WIN1), T, SSM_N, 1024, 1024}; pg8::StaticOrder S; S.init(T, SSM_N, F.G, bx);
        pg8::Epi E{WSP(bf16_t, WS_PROJ), SSM_N, nullptr, nullptr, nullptr, (PEER_SPLIT && PEER_VSLICE && !PEER_OWNED) ? WSP(float, WS_SLOTS2) : WSP(float, WS_RSTD), (PEER_SPLIT && PEER_VSLICE && !PEER_OWNED) ? 2 : 1, nullptr, nullptr, 0, 0, 0};
        pg8::gemm_phase<pg8::Epi, pg8::StaticOrder, true>(F.lds, g, S, E);
        if (F.G == 256) { if (F.wave < 4) dt_unit(F, (F.vcu >> 5) * 128 + (F.vcu & 31) * 4 + F.wave); }
        else for (int u = F.wave * F.G + F.vcu; u < T / 16; u += F.NGW) dt_unit(F, u);
}
DI void gemm_p14(const Frame& F, int bx) {
        pg8::Gemm g{WSP(bf16_t, WS_PROJ), WSP(bf16_t, WS_WOUT1), T, 1024, 2048, SSM_N}; pg8::StaticOrder S; S.init(T, 1024, F.G, bx);
        pg8::Epi E{WSP(bf16_t, WS_XB), 1024, nullptr, nullptr, WSP(bf16_t, WS_XB), WSP(float, WS_YSLOTS), 3, WSP(float, WS_SLOTS), nullptr, 0, 0, 0};
        pg8::gemm_phase<pg8::Epi, pg8::StaticOrder, true>(F.lds, g, S, E);
}
DI void gemm_p15(const Frame& F, int bx) {
        pg8::Gemm g{WSP(bf16_t, WS_XB), WSP(bf16_t, WS_WQ1), T, 1024, 1024, 1024}; pg8::StaticOrder S; S.init(T, 1024, F.G, bx);
        pg8::Epi E{WSP(bf16_t, WS_Q), 1024, nullptr, nullptr, nullptr, WSP(float, WS_SLOTS), 2, nullptr, nullptr, 0, 0, 0};
        pg8::gemm_phase<pg8::Epi, pg8::StaticOrder, true>(F.lds, g, S, E);
        if (!(TCONV_IN_SSD && F.G == 256 && !(DBG_REF & 4))) convert_tables(F, 1);
}

static_assert(PEER_FP4 && !(DBG_REF & 16), "the residual stream lives in XB (bf16): only the fp4 gather path reads it from there");
DI void topk_own_tiles(const Frame& F, int layer, int bx) {
    pg8::StaticOrder S; S.init(T, 1024, F.G, bx); pg8::Unit u;
    for (int i = 0; S.next(i, u); ++i)
        peer_topk3_tile(F, layer, u.pm, u.pn, TCONV0_IN_TOPK && layer == 0 && i == 0 && F.G == 256);
}
constexpr int NPHASE = 18;
__global__ void __launch_bounds__(NTHR, 2) fwd_kernel(Args args) {
    extern __shared__ __attribute__((aligned(16))) unsigned char lds_raw[];
    Frame F;
    F.lds = (LAS unsigned char*)lds_raw;
    F.tid = threadIdx.x; F.lane = F.tid & 63; F.wave = __builtin_amdgcn_readfirstlane(F.tid >> 6);
    F.G = gridDim.x; { const int bx = blockIdx.x; F.vcu = (F.G % 8 == 0) ? (bx % 8) * (F.G / 8) + bx / 8 : bx; }
    F.gw = F.vcu * NWAVES + F.wave; F.NGW = F.G * NWAVES;
    F.in = args.in; F.out = args.out; F.ws = args.ws;
    volatile LAS unsigned* MISC = (volatile LAS unsigned*)(F.lds + MISC_OFF);
    if (F.tid < 64) ((LAS unsigned*)(F.lds + MISC_OFF))[F.tid] = 0u;
    __syncthreads();
    unsigned* ctl = (unsigned*)(args.ws + WS_CTL);
    XcdBarrier bar = xcd_barrier_post(ctl + CW_BAR, MISC + 8);
    const int lo = args.ph_lo, hi = args.ph_hi;
    if (LOCAL_SEAMS != 0 && F.tid == 0 && F.G == 256) __hip_atomic_store(ctl + CW_GRPX + F.vcu, xb_xcc_id() + 1u, __ATOMIC_RELAXED, __HIP_MEMORY_SCOPE_AGENT);
#ifndef PHASE_MASK
#define PHASE_MASK 0x3ffff
#endif
#define IN(k) ((((PHASE_MASK) >> (k)) & 1) && lo <= (k) && (k) < hi)
#define SEAM(k) do { if (IN(k) && IN((k) + 1)) { xcd_barrier(bar, (((LOCAL_SEAMS) >> (k)) & 1) && MISC[12] != 0u); if ((REPEAT_MASK >> 21) & 1) xcd_barrier(bar); } } while (0)
    const int bx = (int)blockIdx.x;

    if (IN(0)) { p0_prologue(F); if (REPEAT_MASK & 1) p0_prologue(F); } SEAM(0);
    if (LOCAL_SEAMS != 0 && IN(0) && IN(1)) {
        if (F.tid < 64) { bool bad = false;
#pragma unroll
            for (int k = 0; k < 4; ++k) { const unsigned v = (F.G == 256) ? xb_ld(ctl + CW_GRPX + F.tid + 64 * k) : 0u; const unsigned first = (unsigned)__shfl((int)v, F.tid & 32); bad = bad || (v == 0u) || (v != first); }
            const bool okall = (__ballot(bad) == 0ull) && SSD_FUSED && DBG_REF == 0 && REPEAT_MASK == 0 && F.G == 256;
            if (F.tid == 0) MISC[12] = okall ? 1u : 0u; }
        __syncthreads(); }
    if (IN(1)) { gemm_p1(F, bx); if ((REPEAT_MASK >> 1) & 1) gemm_p1(F, bx); } SEAM(1);
    if (IN(2)) {
        const bool lru_first = (DBG_REF == 0) && (REPEAT_MASK == 0) && F.G == 256 && ((F.vcu >> 5) & 1);
        if (!lru_first) { if (!(DBG_REF & 2)) REP(2) ret_kv2_phase(F); }
        if (DBG_REF & 1) { for (int u = F.vcu; u < 128; u += F.G) lru_ref_unit(F, u); __syncthreads(); }
        else { if ((REPEAT_MASK >> 18) & 1) for (int u = F.vcu; u < 256; u += F.G) lru2_unit<true>(F, u);
               for (int u = F.vcu; u < 256; u += F.G) lru2_unit(F, u); }
        if (lru_first) ret_kv2_phase(F);
    } SEAM(2);
    if (IN(3)) { if (!(DBG_REF & 2)) { if ((REPEAT_MASK >> 3) & 1) ret_scan2<true>(F); ret_scan2(F); } } SEAM(3);
    if (IN(4)) { if (DBG_REF & 2) { for (int u = F.gw; u < 65536; u += F.NGW) ret_ref_unit(F, u); } else { if ((REPEAT_MASK >> 4) & 1) for (int u = F.vcu; u < 512; u += F.G) ret_out2_unit<true>(F, u); if (F.G == 256) { for (int r = 0; r < 2; ++r) ret_out2_unit(F, (F.vcu >> 5) * 64 + (F.vcu & 31) + 32 * r); } else for (int u = F.vcu; u < 512; u += F.G) ret_out2_unit(F, u); } } SEAM(4);
    if (IN(5)) { gemm_p5(F, bx); if ((REPEAT_MASK >> 5) & 1) gemm_p5(F, bx); } SEAM(5);
    if (IN(6)) { gemm_p6(F, bx); if ((REPEAT_MASK >> 6) & 1) gemm_p6(F, bx);
        if (!(DBG_REF & 8)) { topk_own_tiles(F, 0, bx); if ((REPEAT_MASK >> 7) & 1) topk_own_tiles(F, 0, bx); } }
    if (DBG_REF & 8) { SEAM(6); if (IN(7)) { peer_sel_ref_a(F, 0); xcd_barrier(bar); peer_sel_ref_b(F); } }
    SEAM(7);
    if (IN(8)) {
#if PEER_SPLIT
        if (PEER_OWNED && PEER_VSLICE && T == 8 * F.NGW) { peer_u_owned(F); asm volatile("s_waitcnt vmcnt(0)\n\tbuffer_inv sc0\n\ts_waitcnt vmcnt(0)" ::: "memory"); peer_v_mfma_final<false>(F); }
        else {
        peer_u_phase(F); if ((REPEAT_MASK >> 19) & 1) peer_u_phase(F);
        xcd_barrier(bar);
        if (PEER_VSLICE) { if ((REPEAT_MASK >> 8) & 1) peer_v_mfma_phase<true>(F); peer_v_mfma_phase(F); }
        else { if ((REPEAT_MASK >> 8) & 1) for (int t = F.gw; t < T; t += F.NGW) peer_v_token<false, true>(F, t);
               for (int t = F.gw; t < T; t += F.NGW) peer_v_token<false>(F, t); }
        }
#else
        if ((REPEAT_MASK >> 8) & 1) for (int t = F.gw; t < T; t += F.NGW) { if (PEER_FP4) peer_token4<false, true>(F, t); else peer_token8<false, true>(F, t); }
        for (int t = F.gw; t < T; t += F.NGW) { if (DBG_REF & 16) peer_token_ref<false>(F, 0, t); else if (PEER_FP4) peer_token4<false>(F, t); else peer_token8<false>(F, t); }
#endif
    } SEAM(8);
    if (IN(9)) { gemm_p9(F, bx); if ((REPEAT_MASK >> 9) & 1) gemm_p9(F, bx); } SEAM(9);
    if (IN(10)) { REP(10) for (int u = F.vcu; u < T / 64; u += F.G) conv_dt_unit(F, u); } SEAM(10);
    if (SSD_FUSED && !(DBG_REF & 4)) { if (IN(13)) { if ((REPEAT_MASK >> 13) & 1) for (int u = F.vcu; u < 256; u += F.G) ssd_fused_unit<true>(F, u); for (int u = F.vcu; u < 256; u += F.G) ssd_fused_unit(F, u); } if (IN(10) && IN(13)) {} }
    else {
    if (IN(11)) { if (!(DBG_REF & 4)) REP(11) for (int u = F.vcu; u < 512; u += F.G) ssd_state2_unit(F, u); } SEAM(11);
    if (IN(12)) { if (!(DBG_REF & 4)) { if ((REPEAT_MASK >> 12) & 1) ssd_scan2<true>(F); ssd_scan2(F); } } SEAM(12);
    if (IN(13)) { if (DBG_REF & 4) { for (int u = F.vcu; u < 256; u += F.G) ssd_ref_unit(F, u); } else { if ((REPEAT_MASK >> 13) & 1) for (int u = F.vcu; u < 512; u += F.G) ssd_out2_unit<true>(F, u); for (int u = F.vcu; u < 512; u += F.G) ssd_out2_unit(F, u); } } SEAM(13);
    }
    if (SSD_FUSED && !(DBG_REF & 4)) { SEAM(13); }
    if (IN(14)) { gemm_p14(F, bx); } SEAM(14);
    if (IN(15)) { gemm_p15(F, bx); if ((REPEAT_MASK >> 15) & 1) gemm_p15(F, bx);
        if (!(DBG_REF & 8)) { topk_own_tiles(F, 1, bx); if ((REPEAT_MASK >> 16) & 1) topk_own_tiles(F, 1, bx); } }
    if (DBG_REF & 8) { SEAM(15); if (IN(16)) { peer_sel_ref_a(F, 1); xcd_barrier(bar); peer_sel_ref_b(F); } }
    SEAM(16);
    if (IN(17)) {
        const unsigned bad = xb_ld(ctl + CW_BAR + XB_TMO);
#if PEER_SPLIT
        if (PEER_OWNED && PEER_VSLICE && T == 8 * F.NGW) { peer_u_owned(F); asm volatile("s_waitcnt vmcnt(0)\n\tbuffer_inv sc0\n\ts_waitcnt vmcnt(0)" ::: "memory"); peer_v_mfma_final<true>(F); }
        else {
        peer_u_phase(F); if ((REPEAT_MASK >> 19) & 1) peer_u_phase(F);
        xcd_barrier(bar);
        if (PEER_VSLICE && T == 8 * F.NGW) peer_v_mfma_final<true>(F);
        else { if ((REPEAT_MASK >> 17) & 1) for (int t = F.gw; t < T; t += F.NGW) peer_v_token<true, true>(F, t);
               for (int t = F.gw; t < T; t += F.NGW) peer_v_token<true>(F, t); }
        }
#else
        if ((REPEAT_MASK >> 17) & 1) for (int t = F.gw; t < T; t += F.NGW) { if (PEER_FP4) peer_token4<true, true>(F, t); else peer_token8<true, true>(F, t); }
        for (int t = F.gw; t < T; t += F.NGW) { if (DBG_REF & 16) peer_token_ref<true>(F, 1, t); else if (PEER_FP4) peer_token4<true>(F, t); else peer_token8<true>(F, t); }
#endif
        if (bad) { const float q = __builtin_nanf(""); for (int t = F.gw; t < T; t += F.NGW) F.out[(size_t)t * 1024 + F.lane] = q; }
    }
#undef IN
#undef SEAM
}

extern "C" void kernel_launch(void* const* d_in, const int* in_sizes, int n_in, void* d_out, int out_size, void* d_ws, size_t ws_size, hipStream_t stream) {
    static int grid = 0;
    if (grid == 0) {
        if (n_in != 25 || in_sizes[0] != T * D || out_size != T * D || ws_size < WS_END) { fprintf(stderr, "kernel_launch: unexpected shapes (n_in %d, in0 %d, out %d, ws %zu)\n", n_in, n_in > 0 ? in_sizes[0] : -1, out_size, ws_size); grid = -1; return; }
        int dev = 0, cus = 0, per_cu = 0;
        if (hipGetDevice(&dev) != hipSuccess || hipDeviceGetAttribute(&cus, hipDeviceAttributeMultiprocessorCount, dev) != hipSuccess) { grid = -1; return; }
        if (hipFuncSetAttribute((const void*)fwd_kernel, hipFuncAttributeMaxDynamicSharedMemorySize, LDS_BYTES) != hipSuccess) { fprintf(stderr, "kernel_launch: hipFuncSetAttribute failed\n"); grid = -1; return; }
        if (hipOccupancyMaxActiveBlocksPerMultiprocessor(&per_cu, (const void*)fwd_kernel, NTHR, LDS_BYTES) != hipSuccess || per_cu < 1) fprintf(stderr, "kernel_launch: occupancy query reports %d\n", per_cu);
        (void)hipGetLastError();
        grid = cus;
    }
    if (grid < 0) return;
    (void)hipMemsetAsync((char*)d_ws + WS_CTL, 0, CTL_ZERO_BYTES, stream);
    Args a{};
    for (int i = 0; i < 25; ++i) a.in[i] = (const float*)d_in[i];
    a.out = (float*)d_out; a.ws = (unsigned char*)d_ws; a.ph_lo = 0; a.ph_hi = NPHASE;
    hipLaunchKernelGGL(fwd_kernel, dim3(grid), dim3(NTHR), LDS_BYTES, stream, a);
}
```
